# Optimizing an MI355X kernel written in HIP

```python
import math
import jax, jax.numpy as jnp
from jax import lax
import numpy as np

D_MODEL = 2048
BATCH = 2
SEQ = 16384
DEPTH = 4
DEC_BATCH = 16
DEC_SEQ = 16
PAST_LEN = 2048

CHUNK = 64
Q_BLOCK = 128
ROPE_THETA = 500000.0
EPS = 1e-6
NEG = -1e30

A_HEADS = 4
A_QK_DIM = 64
A_V_DIM = 128
A_ROT = A_QK_DIM // 4
B_HEADS = 8
B_Q_LORA = 512
B_KV_LORA = 256
B_NOPE = 128
B_ROPE = 64
B_V_DIM = 128
C_HEADS = 4
C_DIM = 128
C_PAST_CHUNKS = 8
C_WINDOW = C_PAST_CHUNKS * CHUNK
REL_CLIP = 128
D_FF = 4 * D_MODEL

A_WIDTH = A_HEADS * A_V_DIM
B_WIDTH = B_HEADS * B_V_DIM
C_WIDTH = C_HEADS * C_DIM

IN_SPLITS = (
    A_HEADS * 2 * A_QK_DIM,
    A_HEADS * 2 * A_QK_DIM,
    A_WIDTH,
    B_Q_LORA,
    B_KV_LORA + B_ROPE,
    C_WIDTH,
    C_WIDTH,
    C_WIDTH,
    3 * D_MODEL,
)
IN_COLS = sum(IN_SPLITS)
IN_OFFSETS = [int(v) for v in np.cumsum(IN_SPLITS)[:-1]]

kernel_name = 'hybrid_streaming_encoder_step'


def rmsnorm(x, g):
    xf = x.astype(jnp.float32)
    y = xf * lax.rsqrt(jnp.mean(xf * xf, axis=-1, keepdims=True) + EPS)
    return (y * g.astype(jnp.float32)).astype(x.dtype)


def rope(x, pos, rot_dim):
    half = rot_dim // 2
    inv = jnp.power(ROPE_THETA, -jnp.arange(half, dtype=jnp.float32) / half)
    ang = pos.astype(jnp.float32)[:, None] * inv[None, :]
    cos = jnp.cos(ang)[:, None, :]
    sin = jnp.sin(ang)[:, None, :]
    xr = x[..., :rot_dim].astype(jnp.float32)
    x1, x2 = xr[..., :half], xr[..., half:]
    rot = jnp.concatenate([x1 * cos - x2 * sin, x2 * cos + x1 * sin], axis=-1).astype(x.dtype)
    return jnp.concatenate([rot, x[..., rot_dim:]], axis=-1)


def attend(q, k, v, mask=None, bias=None):
    scale = q.shape[-1] ** -0.5
    s = jnp.einsum('bthd,blhd->bhtl', q, k).astype(jnp.float32) * scale
    if bias is not None:
        s = s + bias.astype(jnp.float32)
    if mask is not None:
        s = jnp.where(mask, s, NEG)
    p = jax.nn.softmax(s, axis=-1)
    return jnp.einsum('bhtl,blhd->bthd', p.astype(v.dtype), v)


def chunk_causal_attention(q, k, v):
    bsz, s, h, dk = q.shape
    nb = s // Q_BLOCK
    qb = q.reshape(bsz, nb, Q_BLOCK, h, dk).transpose(1, 0, 2, 3, 4)
    k_chunk = jnp.arange(s) // CHUNK

    def block(args):
        qi, i = args
        q_chunk = (i * Q_BLOCK + jnp.arange(Q_BLOCK)) // CHUNK
        mask = (k_chunk[None, :] <= q_chunk[:, None])[None, None]
        return attend(qi, k, v, mask)

    out = lax.map(block, (qb, jnp.arange(nb)))
    return out.transpose(1, 0, 2, 3, 4).reshape(bsz, s, h, v.shape[-1])


def rel_bias(table, q_pos, k_pos):
    d = jnp.clip(q_pos[:, None] - k_pos[None, :], -REL_CLIP, REL_CLIP) + REL_CLIP
    return table[:, d]


def chunk_band_attention(q, k, v, table):
    bsz, s, h, d = q.shape
    nc = s // CHUNK
    band = (C_PAST_CHUNKS + 1) * CHUNK
    pad = C_PAST_CHUNKS * CHUNK
    kp = jnp.pad(k, ((0, 0), (pad, 0), (0, 0), (0, 0)))
    vp = jnp.pad(v, ((0, 0), (pad, 0), (0, 0), (0, 0)))
    qc = q.reshape(bsz, nc, CHUNK, h, d).transpose(1, 0, 2, 3, 4)
    k_off = jnp.arange(band)
    bias = rel_bias(table, pad + jnp.arange(CHUNK), k_off)[None]

    def one(args):
        qi, n = args
        kb = lax.dynamic_slice_in_dim(kp, n * CHUNK, band, axis=1)
        vb = lax.dynamic_slice_in_dim(vp, n * CHUNK, band, axis=1)
        mask = (n * CHUNK - pad + k_off >= 0)[None, None, None, :]
        return attend(qi, kb, vb, mask, bias)

    out = lax.map(one, (qc, jnp.arange(nc)))
    return out.transpose(1, 0, 2, 3, 4).reshape(bsz, s, h, d)


def branch_inputs(h, pos, w_in_l, b_gate_l, a_q_norm_l, a_k_norm_l, b_qa_norm_l, b_kv_norm_l,
                  w_qb_l, b_q_norm_l, c_q_norm_l, c_k_norm_l):
    bsz, s, _ = h.shape
    z = h @ w_in_l
    za_q, za_k, za_v, zb_q, zb_kv, zc_q, zc_k, zc_v, z_g = jnp.split(z, IN_OFFSETS, axis=-1)
    qa = rope(rmsnorm(za_q.reshape(bsz, s, 2 * A_HEADS, A_QK_DIM), a_q_norm_l), pos, A_ROT)
    ka = rope(rmsnorm(za_k.reshape(bsz, s, 2 * A_HEADS, A_QK_DIM), a_k_norm_l), pos, A_ROT)
    qa = qa.reshape(bsz, s, A_HEADS, 2 * A_QK_DIM)
    ka = ka.reshape(bsz, s, A_HEADS, 2 * A_QK_DIM)
    va = za_v.reshape(bsz, s, A_HEADS, A_V_DIM)
    c_q = rmsnorm(zb_q, b_qa_norm_l)
    qb = (c_q @ w_qb_l).reshape(bsz, s, B_HEADS, B_NOPE + B_ROPE)
    qb = jnp.concatenate([qb[..., :B_NOPE], rope(qb[..., B_NOPE:], pos, B_ROPE)], axis=-1)
    qb = rmsnorm(qb, b_q_norm_l)
    ckv = rmsnorm(zb_kv[..., :B_KV_LORA], b_kv_norm_l)
    kpe = rope(zb_kv[..., B_KV_LORA:][:, :, None, :], pos, B_ROPE)[:, :, 0, :]
    qc = rmsnorm(zc_q.reshape(bsz, s, C_HEADS, C_DIM), c_q_norm_l)
    kc = rmsnorm(zc_k.reshape(bsz, s, C_HEADS, C_DIM), c_k_norm_l)
    vc = zc_v.reshape(bsz, s, C_HEADS, C_DIM)
    gates = jax.nn.sigmoid(z_g + b_gate_l)
    return qa, ka, va, qb, ckv, kpe, qc, kc, vc, gates


def mla_kv(ckv, kpe, w_kvb_l, b_k_norm_l):
    bsz, l = ckv.shape[:2]
    kv = (ckv @ w_kvb_l).reshape(bsz, l, B_HEADS, B_NOPE + B_V_DIM)
    k_rope = jnp.broadcast_to(kpe[:, :, None, :], (bsz, l, B_HEADS, B_ROPE))
    k = rmsnorm(jnp.concatenate([kv[..., :B_NOPE], k_rope], axis=-1), b_k_norm_l)
    return k, kv[..., B_NOPE:]


def diff_out(o1, o2, lam, lam_init, sub_gain):
    o = o1 - lam.astype(o1.dtype) * o2
    return rmsnorm(o, sub_gain) * (1.0 - lam_init)


def merge_out(oa, ob, oc, gates, w_br_a_l, w_br_b_l, w_br_c_l, w_o_l):
    bsz, s = oa.shape[:2]
    ga, gb, gc = jnp.split(gates, 3, axis=-1)
    merged = (ga * (oa.reshape(bsz, s, A_WIDTH) @ w_br_a_l)
              + gb * (ob.reshape(bsz, s, B_WIDTH) @ w_br_b_l)
              + gc * (oc.reshape(bsz, s, C_WIDTH) @ w_br_c_l))
    return merged @ w_o_l


def sq_relu_mlp(h, w_up_l, w_down_l):
    return jnp.square(jax.nn.relu(h @ w_up_l)) @ w_down_l


def setup_inputs(seed: int = 0) -> dict:
    key = jax.random.key(seed)
    ks = iter(jax.random.split(key, 40))

    def nrm(shape, scale=1.0):
        return jax.random.normal(next(ks), shape, jnp.float32) * scale

    def gain(shape):
        return 1.0 + 0.01 * nrm(shape)

    c_past = min(C_WINDOW, PAST_LEN)
    return {
        'x_prompt': nrm((BATCH, SEQ, D_MODEL)),
        'x_sample': nrm((DEC_BATCH, DEC_SEQ, D_MODEL)),
        'cache_a_k': nrm((DEPTH, DEC_BATCH, PAST_LEN, A_HEADS, 2 * A_QK_DIM)),
        'cache_a_v': nrm((DEPTH, DEC_BATCH, PAST_LEN, A_HEADS, A_V_DIM)),
        'cache_b_ckv': nrm((DEPTH, DEC_BATCH, PAST_LEN, B_KV_LORA)),
        'cache_b_kpe': nrm((DEPTH, DEC_BATCH, PAST_LEN, B_ROPE)),
        'cache_c_k': nrm((DEPTH, DEC_BATCH, c_past, C_HEADS, C_DIM)),
        'cache_c_v': nrm((DEPTH, DEC_BATCH, c_past, C_HEADS, C_DIM)),
        'attn_norm': gain((DEPTH, D_MODEL)),
        'w_in': nrm((DEPTH, D_MODEL, IN_COLS), D_MODEL ** -0.5),
        'b_gate': nrm((DEPTH, 3 * D_MODEL), 0.1),
        'a_q_norm': gain((DEPTH, A_QK_DIM)),
        'a_k_norm': gain((DEPTH, A_QK_DIM)),
        'a_lambda': nrm((DEPTH, 4, A_QK_DIM), 0.1),
        'a_sub_norm': gain((DEPTH, A_V_DIM)),
        'b_qa_norm': gain((DEPTH, B_Q_LORA)),
        'b_kv_norm': gain((DEPTH, B_KV_LORA)),
        'w_qb': nrm((DEPTH, B_Q_LORA, B_HEADS * (B_NOPE + B_ROPE)), B_Q_LORA ** -0.5),
        'w_kvb': nrm((DEPTH, B_KV_LORA, B_HEADS * (B_NOPE + B_V_DIM)), B_KV_LORA ** -0.5),
        'b_q_norm': gain((DEPTH, B_NOPE + B_ROPE)),
        'b_k_norm': gain((DEPTH, B_NOPE + B_ROPE)),
        'c_q_norm': gain((DEPTH, C_DIM)),
        'c_k_norm': gain((DEPTH, C_DIM)),
        'c_rel_bias': nrm((DEPTH, C_HEADS, 2 * REL_CLIP + 1), 0.5),
        'w_br_a': nrm((DEPTH, A_WIDTH, D_MODEL), A_WIDTH ** -0.5),
        'w_br_b': nrm((DEPTH, B_WIDTH, D_MODEL), B_WIDTH ** -0.5),
        'w_br_c': nrm((DEPTH, C_WIDTH, D_MODEL), C_WIDTH ** -0.5),
        'w_o': nrm((DEPTH, D_MODEL, D_MODEL), D_MODEL ** -0.5),
        'mlp_norm': gain((DEPTH, D_MODEL)),
        'w_up': nrm((DEPTH, D_MODEL, D_FF), D_MODEL ** -0.5),
        'w_down': nrm((DEPTH, D_FF, D_MODEL), D_FF ** -0.5),
    }


def reference(x_prompt, x_sample, cache_a_k, cache_a_v, cache_b_ckv, cache_b_kpe, cache_c_k, cache_c_v,
              attn_norm, w_in, b_gate, a_q_norm, a_k_norm, a_lambda, a_sub_norm,
              b_qa_norm, b_kv_norm, w_qb, w_kvb, b_q_norm, b_k_norm,
              c_q_norm, c_k_norm, c_rel_bias, w_br_a, w_br_b, w_br_c, w_o,
              mlp_norm, w_up, w_down):
    seq = x_prompt.shape[1]
    dec = x_sample.shape[1]
    past = cache_a_k.shape[2]
    c_past = cache_c_k.shape[2]
    c_keep = min(C_WINDOW, seq)
    pos_p = jnp.arange(seq)
    pos_s = past + jnp.arange(dec)
    kc_pos = jnp.concatenate([past - c_past + jnp.arange(c_past), pos_s])
    q_ch, k_ch = pos_s // CHUNK, kc_pos // CHUNK
    c_mask_s = ((k_ch[None, :] <= q_ch[:, None]) & (k_ch[None, :] >= q_ch[:, None] - C_PAST_CHUNKS))[None, None]

    xp, xs = x_prompt, x_sample
    ak_p, av_p, bc_p, bp_p, ck_p, cv_p = [], [], [], [], [], []
    ak_s, av_s, bc_s, bp_s, ck_s, cv_s = [], [], [], [], [], []
    for l in range(DEPTH):
        lam_init = 0.8 - 0.6 * math.exp(-0.3 * l)
        lf = a_lambda[l].astype(jnp.float32)
        lam = jnp.exp(jnp.sum(lf[0] * lf[1])) - jnp.exp(jnp.sum(lf[2] * lf[3])) + lam_init

        qa, ka, va, qb, ckv, kpe, qc, kc, vc, g = branch_inputs(
            rmsnorm(xp, attn_norm[l]), pos_p, w_in[l], b_gate[l], a_q_norm[l], a_k_norm[l],
            b_qa_norm[l], b_kv_norm[l], w_qb[l], b_q_norm[l], c_q_norm[l], c_k_norm[l])
        oa = diff_out(chunk_causal_attention(qa[..., :A_QK_DIM], ka[..., :A_QK_DIM], va),
                      chunk_causal_attention(qa[..., A_QK_DIM:], ka[..., A_QK_DIM:], va),
                      lam, lam_init, a_sub_norm[l])
        kb, vb = mla_kv(ckv, kpe, w_kvb[l], b_k_norm[l])
        ob = chunk_causal_attention(qb, kb, vb)
        oc = chunk_band_attention(qc, kc, vc, c_rel_bias[l])
        xp = xp + merge_out(oa, ob, oc, g, w_br_a[l], w_br_b[l], w_br_c[l], w_o[l])
        xp = xp + sq_relu_mlp(rmsnorm(xp, mlp_norm[l]), w_up[l], w_down[l])
        ak_p.append(ka); av_p.append(va); bc_p.append(ckv); bp_p.append(kpe)
        ck_p.append(kc[:, seq - c_keep:]); cv_p.append(vc[:, seq - c_keep:])

        qa, ka, va, qb, ckv, kpe, qc, kc, vc, g = branch_inputs(
            rmsnorm(xs, attn_norm[l]), pos_s, w_in[l], b_gate[l], a_q_norm[l], a_k_norm[l],
            b_qa_norm[l], b_kv_norm[l], w_qb[l], b_q_norm[l], c_q_norm[l], c_k_norm[l])
        ka_all = jnp.concatenate([cache_a_k[l].astype(ka.dtype), ka], axis=1)
        va_all = jnp.concatenate([cache_a_v[l].astype(va.dtype), va], axis=1)
        oa = diff_out(attend(qa[..., :A_QK_DIM], ka_all[..., :A_QK_DIM], va_all),
                      attend(qa[..., A_QK_DIM:], ka_all[..., A_QK_DIM:], va_all),
                      lam, lam_init, a_sub_norm[l])
        ckv_all = jnp.concatenate([cache_b_ckv[l].astype(ckv.dtype), ckv], axis=1)
        kpe_all = jnp.concatenate([cache_b_kpe[l].astype(kpe.dtype), kpe], axis=1)
        kb, vb = mla_kv(ckv_all, kpe_all, w_kvb[l], b_k_norm[l])
        ob = attend(qb, kb, vb)
        kc_all = jnp.concatenate([cache_c_k[l].astype(kc.dtype), kc], axis=1)
        vc_all = jnp.concatenate([cache_c_v[l].astype(vc.dtype), vc], axis=1)
        oc = attend(qc, kc_all, vc_all, c_mask_s, rel_bias(c_rel_bias[l], pos_s, kc_pos)[None])
        xs = xs + merge_out(oa, ob, oc, g, w_br_a[l], w_br_b[l], w_br_c[l], w_o[l])
        xs = xs + sq_relu_mlp(rmsnorm(xs, mlp_norm[l]), w_up[l], w_down[l])
        ak_s.append(ka); av_s.append(va); bc_s.append(ckv); bp_s.append(kpe)
        ck_s.append(kc); cv_s.append(vc)

    return (xp, xs,
            jnp.stack(ak_p), jnp.stack(av_p), jnp.stack(bc_p), jnp.stack(bp_p), jnp.stack(ck_p), jnp.stack(cv_p),
            jnp.stack(ak_s), jnp.stack(av_s), jnp.stack(bc_s), jnp.stack(bp_s), jnp.stack(ck_s), jnp.stack(cv_s))
```

```cpp
#include <hip/hip_runtime.h>
#include <cstdio>
#include <cstdint>
#include <cmath>

#ifndef MK_SPLIT
#define MK_SPLIT 0
#endif

#define GAS __attribute__((address_space(1)))
#define LAS __attribute__((address_space(3)))
typedef unsigned short bf16;
typedef short bf16x8 __attribute__((ext_vector_type(8)));
typedef short s16x4 __attribute__((ext_vector_type(4)));
typedef float f32x4 __attribute__((ext_vector_type(4)));
typedef float f32x16 __attribute__((ext_vector_type(16)));
typedef unsigned u32x4 __attribute__((ext_vector_type(4)));
typedef unsigned u32x2 __attribute__((ext_vector_type(2)));

constexpr int DM = 2048, SEQ = 16384, NBATCH = 2, DEPTH = 4, DECB = 16, DECS = 16, PAST = 2048;
constexpr int MP = NBATCH * SEQ, MS = DECB * DECS, M = MP + MS;
constexpr int SROWS = 2176, CROWS = 640, CPAST = 512;
constexpr int M2 = MP + DECB * SROWS;
constexpr int MC = MP + DECB * CROWS;
constexpr int NIN = 10240, NZ = 4096, NGATE = 6144, DFF = 8192, INCOLS = 10048;
constexpr float EPS = 1e-6f;
static_assert(M % 256 == 0 && M2 % 256 == 0, "row counts are whole 256-row panels");

constexpr size_t OUT_Y = 0;
constexpr size_t OUT_AK_P = OUT_Y + (size_t)M * DM;
constexpr size_t OUT_AV_P = OUT_AK_P + (size_t)DEPTH * MP * 512;
constexpr size_t OUT_BC_P = OUT_AV_P + (size_t)DEPTH * MP * 512;
constexpr size_t OUT_BP_P = OUT_BC_P + (size_t)DEPTH * MP * 256;
constexpr size_t OUT_CK_P = OUT_BP_P + (size_t)DEPTH * MP * 64;
constexpr size_t OUT_CV_P = OUT_CK_P + (size_t)DEPTH * NBATCH * 512 * 512;
constexpr size_t OUT_AK_S = OUT_CV_P + (size_t)DEPTH * NBATCH * 512 * 512;
constexpr size_t OUT_AV_S = OUT_AK_S + (size_t)DEPTH * MS * 512;
constexpr size_t OUT_BC_S = OUT_AV_S + (size_t)DEPTH * MS * 512;
constexpr size_t OUT_BP_S = OUT_BC_S + (size_t)DEPTH * MS * 256;
constexpr size_t OUT_CK_S = OUT_BP_S + (size_t)DEPTH * MS * 64;
constexpr size_t OUT_CV_S = OUT_CK_S + (size_t)DEPTH * MS * 512;
constexpr size_t OUT_END = OUT_CV_S + (size_t)DEPTH * MS * 512;
static_assert(OUT_END == 250413056ull, "output size");

constexpr size_t MiB = 1u << 20;
constexpr size_t WS_CTL = 0, CTL_ZERO_BYTES = 1 * MiB;
constexpr size_t WS_WIN = 1 * MiB;
constexpr size_t WS_WQB = 41 * MiB;
constexpr size_t WS_WKVB = 43 * MiB;
constexpr size_t WS_WBR = 44 * MiB;
constexpr size_t WS_WO = 52 * MiB;
constexpr size_t WS_WUP = 60 * MiB;
constexpr size_t WS_WDN = 92 * MiB;
constexpr size_t WS_R3 = 124 * MiB;
constexpr size_t WS_R1 = 322 * MiB;
constexpr size_t WS_GATES = 586 * MiB;
constexpr size_t WS_QA = 973 * MiB;
constexpr size_t WS_KA = 1006 * MiB;
constexpr size_t WS_VA = 1072 * MiB;
constexpr size_t WS_CQ = 1138 * MiB;
constexpr size_t WS_CKV = 1171 * MiB;
constexpr size_t WS_KPE = 1204 * MiB;
constexpr size_t WS_QC = 1221 * MiB;
constexpr size_t WS_KC = 1254 * MiB;
constexpr size_t WS_VC = 1296 * MiB;
constexpr size_t WS_R2 = 1338 * MiB;
constexpr size_t WS_OALL = 1596 * MiB;
constexpr size_t WS_QB = 1727 * MiB;
constexpr size_t WS_END = 1824 * MiB;
static_assert(WS_WIN + (size_t)NIN * DM * 2 <= WS_WQB && WS_WDN + (size_t)DM * DFF * 2 <= WS_R3, "weights");
static_assert(WS_R3 + (size_t)M2 * 1536 * 2 <= WS_R1 && WS_R1 + (size_t)M2 * 2048 * 2 <= WS_GATES && WS_GATES + (size_t)M * NGATE * 2 <= WS_QA, "R3/R1/gates");
static_assert(WS_R1 + (size_t)M * DFF * 2 <= WS_QA, "u overlay");
static_assert(WS_QA + (size_t)M * 512 * 2 <= WS_KA && WS_KA + (size_t)M2 * 512 * 2 <= WS_VA && WS_VA + (size_t)M2 * 512 * 2 <= WS_CQ, "A");
static_assert(WS_CQ + (size_t)M * 512 * 2 <= WS_CKV && WS_CKV + (size_t)M2 * 256 * 2 <= WS_KPE && WS_KPE + (size_t)M2 * 64 * 4 <= WS_QC, "B");
static_assert(WS_QC + (size_t)M * 512 * 2 <= WS_KC && WS_KC + (size_t)MC * 512 * 2 <= WS_VC && WS_VC + (size_t)MC * 512 * 2 <= WS_R2, "C");
static_assert(WS_R2 + (size_t)M * 2048 * 4 <= WS_OALL && WS_OALL + (size_t)M * 2048 * 2 <= WS_QB && WS_QB + (size_t)M * 1536 * 2 <= WS_END, "tail");

constexpr int CW_BAR = 4096;

constexpr int RING_BYTES = 131072;
constexpr int LDSCTL_OFF = RING_BYTES, MISC_OFF = LDSCTL_OFF + 320;
constexpr int LDS_BYTES = 155648;
constexpr int EPI_OFF = RING_BYTES + 8192;
static_assert(EPI_OFF + 8 * 2048 <= LDS_BYTES, "epilogue staging");

#define LDS_WAIT() asm volatile("s_waitcnt lgkmcnt(0)" ::: "memory")
#define VM_WAIT() asm volatile("s_waitcnt vmcnt(0)" ::: "memory")
#define SBAR() __builtin_amdgcn_sched_barrier(0)
__device__ __forceinline__ int fresh_tid() { int t = threadIdx.x; asm volatile("" : "+v"(t)); return t; }
__device__ __forceinline__ unsigned cvtpk(float lo, float hi) { unsigned r; asm volatile("v_cvt_pk_bf16_f32 %0, %1, %2" : "=v"(r) : "v"(lo), "v"(hi)); return r; }
__device__ __forceinline__ float bf_lo(unsigned u) { return __uint_as_float(u << 16); }
__device__ __forceinline__ float bf_hi(unsigned u) { return __uint_as_float(u & 0xffff0000u); }
__device__ __forceinline__ void unpack8(u32x4 w, float (&v)[8]) { v[0] = bf_lo(w.x); v[1] = bf_hi(w.x); v[2] = bf_lo(w.y); v[3] = bf_hi(w.y); v[4] = bf_lo(w.z); v[5] = bf_hi(w.z); v[6] = bf_lo(w.w); v[7] = bf_hi(w.w); }
__device__ __forceinline__ u32x4 pack8(const float (&v)[8]) { u32x4 w; w.x = cvtpk(v[0], v[1]); w.y = cvtpk(v[2], v[3]); w.z = cvtpk(v[4], v[5]); w.w = cvtpk(v[6], v[7]); return w; }
__device__ __forceinline__ void ld8bf(const bf16* p, float (&v)[8]) { unpack8(*(const u32x4*)p, v); }
__device__ __forceinline__ void ld8f(const float* p, float (&v)[8]) { const f32x4 a = *(const f32x4*)p, b = *(const f32x4*)(p + 4); v[0] = a.x; v[1] = a.y; v[2] = a.z; v[3] = a.w; v[4] = b.x; v[5] = b.y; v[6] = b.z; v[7] = b.w; }
__device__ __forceinline__ void st8f(float* p, const float (&v)[8]) { *(f32x4*)p = (f32x4){v[0], v[1], v[2], v[3]}; *(f32x4*)(p + 4) = (f32x4){v[4], v[5], v[6], v[7]}; }
__device__ __forceinline__ void st8f_nt(float* p, const float (&v)[8]) { __builtin_nontemporal_store((f32x4){v[0], v[1], v[2], v[3]}, (f32x4*)p); __builtin_nontemporal_store((f32x4){v[4], v[5], v[6], v[7]}, (f32x4*)(p + 4)); }
__device__ __forceinline__ float wave_sum(float v) {
#pragma unroll
    for (int o = 1; o < 64; o <<= 1) v += __shfl_xor(v, o);
    return v;
}
__device__ __forceinline__ float sumsq8(const float (&v)[8]) { float s = 0.f;
#pragma unroll
    for (int e = 0; e < 8; ++e) s += v[e] * v[e];
    return s; }

#define XB_TMO      128
#define XB_XCNT(j)  (256  + 64 * (j))
#define XB_XSUB(j)  (1280 + 64 * (j))
#define XB_XGEN(j)  (2304 + 64 * (j))
#define XB_TOP      3328
#define XB_TOPGEN   3392
#define XCD_BAR_WORDS 3456
#define XB_SPIN_CAP (1u << 18)
__device__ __forceinline__ unsigned xb_ld(unsigned* p)              { return __hip_atomic_load(p, __ATOMIC_RELAXED, __HIP_MEMORY_SCOPE_AGENT); }
__device__ __forceinline__ unsigned xb_add(unsigned* p, unsigned v) { return __hip_atomic_fetch_add(p, v, __ATOMIC_RELAXED, __HIP_MEMORY_SCOPE_AGENT); }
__device__ __forceinline__ unsigned xb_xcc_id() { return (unsigned)__builtin_amdgcn_s_getreg((3 << 11) | 20) & 0xFu; }
#define XB_SPIN(cond, bar) do { unsigned _sp = 0; while (cond) { __builtin_amdgcn_s_sleep(1); \
    if ((++_sp & 255u) == 0u) { if (xb_ld(&(bar)[XB_TMO])) break; if (_sp > XB_SPIN_CAP) { atomicAdd(&(bar)[XB_TMO], 1u); break; } } } } while (0)
struct XcdBarrier { unsigned* bar; unsigned x; volatile LAS unsigned* st; };
__device__ __forceinline__ XcdBarrier xcd_barrier_post(unsigned* bar, volatile LAS unsigned* st) {
    XcdBarrier b; b.bar = bar; b.x = xb_xcc_id(); b.st = st;
    if (threadIdx.x == 0) (void)xb_add(&bar[XB_XCNT(b.x)], 1u);
    return b;
}
__device__ __forceinline__ void xcd_barrier_complete(unsigned* bar, unsigned x, unsigned& nloc, unsigned& nx) {
    const unsigned G = gridDim.x * gridDim.y * gridDim.z;
    unsigned sum, cnt, mine, sp = 0u;
    for (;;) {
        sum = 0u; cnt = 0u; mine = 0u;
#pragma unroll
        for (unsigned j = 0; j < 16; ++j) { const unsigned c = xb_ld(&bar[XB_XCNT(j)]); sum += c; cnt += (c > 0u) ? 1u : 0u; mine = (j == x) ? c : mine; }
        if (sum == G) break;
        __builtin_amdgcn_s_sleep(1);
        if ((++sp & 255u) == 0u) { if (xb_ld(&bar[XB_TMO])) break; if (sp > XB_SPIN_CAP) { atomicAdd(&bar[XB_TMO], 1u); break; } }
    }
    nloc = mine > 0u ? mine : 1u; nx = cnt > 0u ? cnt : 1u;
}
__device__ __forceinline__ void xcd_barrier(const XcdBarrier& b) {
    asm volatile("s_waitcnt vmcnt(0)" ::: "memory");
    __syncthreads();
    if (threadIdx.x == 0) {
        unsigned* bar = b.bar;
        __builtin_amdgcn_s_waitcnt(0);
        unsigned nloc = b.st[0], nx = b.st[1];
        if (nloc == 0u) { xcd_barrier_complete(bar, b.x, nloc, nx); b.st[0] = nloc; b.st[1] = nx; }
        const unsigned old = xb_add(&bar[XB_XSUB(b.x)], 1u);
        const unsigned gen = old / nloc;
        if (old + 1u == (gen + 1u) * nloc) {
            __builtin_amdgcn_fence(__ATOMIC_RELEASE, "agent");
            asm volatile("s_waitcnt vmcnt(0)" ::: "memory");
            const unsigned og = xb_add(&bar[XB_TOP], 1u);
            const unsigned tg = og / nx;
            if (og + 1u == (tg + 1u) * nx) xb_add(&bar[XB_TOPGEN], 1u);
            else XB_SPIN(xb_ld(&bar[XB_TOPGEN]) == tg, bar);
            __builtin_amdgcn_fence(__ATOMIC_ACQUIRE, "agent");
            xb_add(&bar[XB_XGEN(b.x)], 1u);
            asm volatile("s_waitcnt vmcnt(0)" ::: "memory");
        } else {
            XB_SPIN(xb_ld(&bar[XB_XGEN(b.x)]) == gen, bar);
            __builtin_amdgcn_fence(__ATOMIC_ACQUIRE, "agent");
            asm volatile("s_waitcnt vmcnt(0)" ::: "memory");
        }
    }
    __syncthreads();
}

namespace pg8 {
constexpr int BM = 256, BK = 64, HALF = 128, HTB = HALF * BK * 2, NXCD = 8, WGM = 8;
__host__ __device__ __forceinline__ int lds_byte(int r, int c) { return r * 128 + ((((c >> 3) ^ ((r >> 1) & 7))) << 4) + (c & 7) * 2; }
__host__ __device__ __forceinline__ void stage_rc(int b, int& R, int& C) { R = b >> 7; const int slot = (b & 127) >> 4; C = (slot ^ ((R >> 1) & 7)) * 8; }
__host__ __device__ __forceinline__ int perm32(int rho) { const int n = rho >> 4, i = rho & 15; return 8 * (i >> 2) + 4 * n + (i & 3); }
struct Unit { int pm, pn, koff, nt; };
struct Gemm { const bf16* A; const bf16* Bt; int M, N, K, lda, ldb; };
struct StaticOrder {
    int nM, nN, nwg, G, c, nt, wgm;
    __device__ void init(int M_, int N_, int K_, int G_, int c_, int wgm_ = WGM) { nM = M_ / BM; nN = N_ / BM; nwg = nM * nN; G = G_; c = c_; nt = K_ / BK; wgm = wgm_; }
    __device__ bool next(int i, Unit& u) const {
        const long L = (long)i * G + c; if (L >= nwg) return false;
        int wgid = (int)L; { const int q = nwg / NXCD, r = nwg % NXCD, xcd = wgid % NXCD, off = wgid / NXCD; wgid = (xcd < r ? xcd * (q + 1) : r * (q + 1) + (xcd - r) * q) + off; }
        const int nig = wgm * nN, gid = wgid / nig, fm = gid * wgm, gsz = (nM - fm) < wgm ? (nM - fm) : wgm;
        u.pm = fm + ((wgid % nig) % gsz); u.pn = (wgid % nig) / gsz; u.koff = 0; u.nt = nt; return true;
    }
};
struct CombinedOrder {
    StaticOrder S0; int pmS, nN, np, KS;
    __device__ void init(int Mmain, int N_, int K_, int NS_, int G_, int c_) { S0.init(Mmain, N_, K_, G_, c_, 4); pmS = Mmain / BM; nN = N_ / BM; np = nN * NS_; KS = K_ / NS_; }
    __device__ bool next(int i, Unit& u) const { const long L = (long)i * S0.G + S0.c; if (L < S0.nwg) return S0.next(i, u);
        const int p = (int)(L - S0.nwg); if (p >= np) return false; u.pm = pmS; u.pn = p % nN; u.koff = (p / nN) * KS; u.nt = KS / BK; return true; }
};
template <class Epi, class Order>
__device__ __forceinline__ void gemm_phase(LAS unsigned char* lds, const Gemm g, const Order& S, const Epi& E) {
    const int tid = fresh_tid(), wid = __builtin_amdgcn_readfirstlane(tid >> 6), lane = tid & 63, wr = wid >> 2, wc = wid & 3, fr = lane & 15, fq = lane >> 4;
    unsigned voffA[2], voffB[2];
#pragma unroll
    for (int i = 0; i < 2; ++i) { int R, C; stage_rc(tid * 16 + i * 8192, R, C); const int Rb = 64 * (R >> 5) + perm32(R & 31);
        voffA[i] = (unsigned)(R * g.lda + C) * 2u; voffB[i] = (unsigned)(Rb * g.ldb + C) * 2u; }
    const size_t kstep = (size_t)(BK * 2);
    const size_t hstepA = (size_t)HALF * g.lda * 2, hstepB = (size_t)32 * g.ldb * 2;
    const size_t tstepA = 2 * hstepA, tstepB = (size_t)BM * g.ldb * 2;
    const unsigned ldsw = (unsigned)wid * 1024u;
    const int aoff = lds_byte(wr * 64 + fr, fq * 8), boff = lds_byte(wc * 32 + fr, fq * 8), aoff1 = aoff ^ 64, boff1 = boff ^ 64;
#define PG8_SA(b, h) (((b) * 2 + (h)) * HTB)
#define PG8_SB(b, h) ((4 + (b) * 2 + (h)) * HTB)
#define PG8_STAGE(bufoff, gbase, voff) do { _Pragma("unroll") for (int _i = 0; _i < 2; ++_i) \
        __builtin_amdgcn_global_load_lds((const unsigned*)((const char*)(gbase) + (voff)[_i]), (LAS unsigned*)(lds + (bufoff) + ldsw + _i * 8192), 16, 0, 0); } while (0)
#define PG8_LDA(dst, b, h) do { _Pragma("unroll") for (int m = 0; m < 4; ++m) _Pragma("unroll") for (int k = 0; k < 2; ++k) dst[m][k] = *(const LAS bf16x8*)(lds + PG8_SA(b, h) + (k ? aoff1 : aoff) + m * 2048); } while (0)
#define PG8_LDB(dst, b, h) do { _Pragma("unroll") for (int n = 0; n < 2; ++n) _Pragma("unroll") for (int k = 0; k < 2; ++k) dst[n][k] = *(const LAS bf16x8*)(lds + PG8_SB(b, h) + (k ? boff1 : boff) + n * 2048); } while (0)
#define PG8_MMA(ai, bj, At, Bt) do { __builtin_amdgcn_s_setprio(1); _Pragma("unroll") for (int m = 0; m < 4; ++m) _Pragma("unroll") for (int n = 0; n < 2; ++n) _Pragma("unroll") for (int k = 0; k < 2; ++k) \
        acc[ai][bj][m][n] = __builtin_amdgcn_mfma_f32_16x16x32_bf16(Bt[n][k], At[m][k], acc[ai][bj][m][n], 0, 0, 0); __builtin_amdgcn_s_setprio(0); } while (0)
#define PG8_WAIT_V(n) asm volatile("s_waitcnt vmcnt(" #n ")" ::: "memory")
#define PG8_WAIT_L(n) asm volatile("s_waitcnt lgkmcnt(" #n ")" ::: "memory")
#define PG8_BAR __builtin_amdgcn_s_barrier()
#define PG8_SCHED __builtin_amdgcn_sched_barrier(0)
    Unit cur, nxt; int ui = 0;
    if (!S.next(0, cur)) return;
    f32x4 acc[2][2][4][2];
#pragma unroll
    for (int a = 0; a < 2; ++a)
#pragma unroll
        for (int b = 0; b < 2; ++b)
#pragma unroll
            for (int m = 0; m < 4; ++m)
#pragma unroll
                for (int n = 0; n < 2; ++n) acc[a][b][m][n] = (f32x4){0.f, 0.f, 0.f, 0.f};
    bf16x8 At[4][2], B0[2][2], B1[2][2];
    const char* cA = (const char*)g.A + (size_t)cur.pm * tstepA + (size_t)cur.koff * 2; const char* cB = (const char*)g.Bt + (size_t)cur.pn * tstepB + (size_t)cur.koff * 2;
    PG8_STAGE(PG8_SB(0, 0), cB, voffB); PG8_STAGE(PG8_SB(0, 1), cB + hstepB, voffB); PG8_STAGE(PG8_SA(0, 0), cA, voffA); PG8_STAGE(PG8_SA(0, 1), cA + hstepA, voffA);
    if (wr == 1) PG8_BAR;
    PG8_WAIT_V(2); PG8_BAR;
    PG8_STAGE(PG8_SB(1, 0), cB + kstep, voffB); PG8_STAGE(PG8_SA(1, 0), cA + kstep, voffA); PG8_STAGE(PG8_SB(1, 1), cB + hstepB + kstep, voffB);
    PG8_WAIT_V(6); PG8_BAR;
    for (;;) {
        const bool has_next = S.next(ui + 1, nxt);
        const char* nA = has_next ? (const char*)g.A + (size_t)nxt.pm * tstepA + (size_t)nxt.koff * 2 : cA; const char* nB = has_next ? (const char*)g.Bt + (size_t)nxt.pn * tstepB + (size_t)nxt.koff * 2 : cB;
        const int nt = cur.nt;
        for (int t = 0; t < nt; t += 2) {
            if constexpr (Epi::HOOK) { if (t == 8 || t == 24) E.mid(acc, cur, wr, wc, fr, fq, t); }
            const bool last = (t == nt - 2);
            const char* a1 = cA + (size_t)(t + 1) * kstep;
            const char* a2 = last ? nA : cA + (size_t)(t + 2) * kstep; const char* b2 = last ? nB : cB + (size_t)(t + 2) * kstep;
            const char* a3 = a2 + kstep; const char* b3 = b2 + kstep;
            PG8_LDB(B0, 0, 0); PG8_LDB(B1, 0, 1); PG8_SCHED; PG8_LDA(At, 0, 0); PG8_STAGE(PG8_SA(1, 1), a1 + hstepA, voffA);
            PG8_WAIT_V(8); PG8_WAIT_L(0); PG8_BAR; PG8_MMA(0, 0, At, B0); PG8_MMA(0, 1, At, B1); PG8_BAR; PG8_SCHED;
            PG8_LDA(At, 0, 1); PG8_STAGE(PG8_SB(0, 0), b2, voffB); PG8_STAGE(PG8_SB(0, 1), b2 + hstepB, voffB); PG8_STAGE(PG8_SA(0, 0), a2, voffA);
            PG8_WAIT_V(8); PG8_WAIT_L(0); PG8_BAR; PG8_MMA(1, 0, At, B0); PG8_MMA(1, 1, At, B1); PG8_BAR; PG8_SCHED;
            PG8_LDB(B0, 1, 0); PG8_LDB(B1, 1, 1); PG8_SCHED; PG8_LDA(At, 1, 0); PG8_STAGE(PG8_SA(0, 1), a2 + hstepA, voffA);
            PG8_WAIT_V(8); PG8_WAIT_L(0); PG8_BAR; PG8_MMA(0, 0, At, B0); PG8_MMA(0, 1, At, B1); PG8_BAR; PG8_SCHED;
            PG8_LDA(At, 1, 1); PG8_STAGE(PG8_SB(1, 0), b3, voffB); PG8_STAGE(PG8_SB(1, 1), b3 + hstepB, voffB); PG8_STAGE(PG8_SA(1, 0), a3, voffA);
            PG8_WAIT_V(8); PG8_WAIT_L(0); PG8_BAR; PG8_MMA(1, 0, At, B0); PG8_MMA(1, 1, At, B1); PG8_BAR; PG8_SCHED;
        }
        if (wr == 0) PG8_BAR;
        E(acc, cur, wr, wc, fr, fq);
        if (!has_next) break;
#pragma unroll
        for (int a = 0; a < 2; ++a)
#pragma unroll
            for (int b = 0; b < 2; ++b)
#pragma unroll
                for (int m = 0; m < 4; ++m)
#pragma unroll
                    for (int n = 0; n < 2; ++n) acc[a][b][m][n] = (f32x4){0.f, 0.f, 0.f, 0.f};
        cur = nxt; cA = nA; cB = nB; ++ui;
        if (wr == 1) PG8_BAR;
    }
    PG8_WAIT_V(0);
    PG8_BAR;
#undef PG8_SA
#undef PG8_SB
#undef PG8_STAGE
#undef PG8_LDA
#undef PG8_LDB
#undef PG8_MMA
#undef PG8_WAIT_V
#undef PG8_WAIT_L
#undef PG8_BAR
#undef PG8_SCHED
}

#define EPI_LOOP_BEGIN const int row0 = u.pm * BM + wr * 64 + fr, col0 = u.pn * BM + wc * 64 + 8 * fq; \
    _Pragma("unroll") for (int ai = 0; ai < 2; ++ai) _Pragma("unroll") for (int m = 0; m < 4; ++m) { const size_t row = (size_t)(row0 + ai * HALF + m * 16); \
    _Pragma("unroll") for (int bj = 0; bj < 2; ++bj) { const int col = col0 + bj * 32; f32x4 v0 = acc[ai][bj][m][0], v1 = acc[ai][bj][m][1];
#define EPI_LOOP_END } }
__device__ __forceinline__ u32x4 pk8(f32x4 v0, f32x4 v1) { u32x4 w; w.x = cvtpk(v0[0], v0[1]); w.y = cvtpk(v0[2], v0[3]); w.z = cvtpk(v1[0], v1[1]); w.w = cvtpk(v1[2], v1[3]); return w; }
__device__ __forceinline__ float sigm(float v) { return __builtin_amdgcn_rcpf(1.f + __builtin_amdgcn_exp2f(-1.4426950408889634f * v)); }

template <bool NT> __device__ __forceinline__ void st_lines(LAS unsigned char* scr, u32x4 w0, u32x4 w1, bf16* tile, size_t ldc, int fr, int fq) {
    const int lane = fq * 16 + fr, rr = lane >> 3, c = lane & 7;
    *(LAS u32x4*)(scr + fr * 128 + ((fq ^ (fr & 7)) << 4)) = w0;
    *(LAS u32x4*)(scr + fr * 128 + (((4 + fq) ^ (fr & 7)) << 4)) = w1;
    const u32x4 a = *(const LAS u32x4*)(scr + rr * 128 + ((c ^ rr) << 4)), b = *(const LAS u32x4*)(scr + (8 + rr) * 128 + ((c ^ rr) << 4));
    bf16* d = tile + (size_t)rr * ldc + c * 8;
    if constexpr (NT) { __builtin_nontemporal_store(a, (u32x4*)d); __builtin_nontemporal_store(b, (u32x4*)(d + 8 * ldc)); }
    else { *(u32x4*)d = a; *(u32x4*)(d + 8 * ldc) = b; }
}
struct EpiIn {
    static constexpr bool HOOK = false;
    bf16* Z; bf16* G; const float* bg; LAS unsigned char* scr;
    __device__ __forceinline__ void operator()(const f32x4 (&acc)[2][2][4][2], const Unit& u, int wr, int wc, int fr, int fq) const {
        const bool isg = u.pn * BM >= NZ;
        const int colw = u.pn * BM + wc * 64 - (isg ? NZ : 0);
        bf16* base = (isg ? G : Z) + (size_t)(u.pm * BM + wr * 64) * (isg ? NGATE : NZ) + colw; const size_t ldc = isg ? NGATE : NZ;
        LAS unsigned char* sw = scr + (wr * 4 + wc) * 2048;
        f32x4 b00, b01, b10, b11;
        if (isg) { const float* bp = bg + colw + 8 * fq; b00 = *(const f32x4*)bp; b01 = *(const f32x4*)(bp + 4); b10 = *(const f32x4*)(bp + 32); b11 = *(const f32x4*)(bp + 36); }
#pragma unroll
        for (int ai = 0; ai < 2; ++ai)
#pragma unroll
            for (int m = 0; m < 4; ++m) {
                f32x4 v0 = acc[ai][0][m][0], v1 = acc[ai][0][m][1], v2 = acc[ai][1][m][0], v3 = acc[ai][1][m][1];
                if (isg) { v0 += b00; v1 += b01; v2 += b10; v3 += b11;
#pragma unroll
                    for (int e = 0; e < 4; ++e) { v0[e] = sigm(v0[e]); v1[e] = sigm(v1[e]); v2[e] = sigm(v2[e]); v3[e] = sigm(v3[e]); } }
                st_lines<true>(sw, pk8(v0, v1), pk8(v2, v3), base + (size_t)(ai * HALF + m * 16) * ldc, ldc, fr, fq); }
    }
};
struct EpiPlain {
    static constexpr bool HOOK = false;
    bf16* O; int ldc; LAS unsigned char* scr;
    __device__ __forceinline__ void operator()(const f32x4 (&acc)[2][2][4][2], const Unit& u, int wr, int wc, int fr, int fq) const {
        bf16* base = O + (size_t)(u.pm * BM + wr * 64) * ldc + u.pn * BM + wc * 64; LAS unsigned char* sw = scr + (wr * 4 + wc) * 2048;
#pragma unroll
        for (int ai = 0; ai < 2; ++ai)
#pragma unroll
            for (int m = 0; m < 4; ++m)
                st_lines<false>(sw, pk8(acc[ai][0][m][0], acc[ai][0][m][1]), pk8(acc[ai][1][m][0], acc[ai][1][m][1]), base + (size_t)(ai * HALF + m * 16) * ldc, (size_t)ldc, fr, fq);
    }
};
struct EpiMerge {
    static constexpr bool HOOK = true;
    const bf16* G; bf16* Ob; LAS unsigned char* scr;
    __device__ __forceinline__ void mid(f32x4 (&acc)[2][2][4][2], const Unit& u, int wr, int wc, int fr, int fq, int t) const {
        const __amdgpu_buffer_rsrc_t rs = __builtin_amdgcn_make_buffer_rsrc((void*)G, 0, (int)((size_t)M * NGATE * 2), 0x00020000);
        const int gx = (t == 8) ? 0 : DM;
        const int voff = ((u.pm * BM + wr * 64 + fr) * NGATE + u.pn * BM + wc * 64 + 8 * fq + gx) * 2;
#pragma unroll
        for (int ai = 0; ai < 2; ++ai) {
            u32x4 wa[4][2], wb[4][2];
#pragma unroll
            for (int m = 0; m < 4; ++m)
#pragma unroll
                for (int bj = 0; bj < 2; ++bj) { const int so = ((ai * HALF + m * 16) * NGATE + bj * 32) * 2;
                    wa[m][bj] = __builtin_amdgcn_raw_buffer_load_b128(rs, voff, so, 0); wb[m][bj] = __builtin_amdgcn_raw_buffer_load_b128(rs, voff, so + DM * 2, 0); }
#pragma unroll
            for (int m = 0; m < 4; ++m)
#pragma unroll
                for (int bj = 0; bj < 2; ++bj) {
                    float a[8], b[8]; unpack8(wa[m][bj], a); unpack8(wb[m][bj], b);
#pragma unroll
                    for (int e = 0; e < 8; ++e) a[e] = a[e] * __builtin_amdgcn_rcpf(fmaxf(b[e], 1e-30f));
                    f32x4& v0 = acc[ai][bj][m][0]; f32x4& v1 = acc[ai][bj][m][1];
                    v0[0] *= a[0]; v0[1] *= a[1]; v0[2] *= a[2]; v0[3] *= a[3]; v1[0] *= a[4]; v1[1] *= a[5]; v1[2] *= a[6]; v1[3] *= a[7]; }
            SBAR(); }
    }
    __device__ __forceinline__ void operator()(const f32x4 (&acc)[2][2][4][2], const Unit& u, int wr, int wc, int fr, int fq) const {
        bf16* base = Ob + (size_t)(u.pm * BM + wr * 64) * DM + u.pn * BM + wc * 64; LAS unsigned char* sw = scr + (wr * 4 + wc) * 2048;
        const bf16* gb = G + (size_t)(u.pm * BM + wr * 64 + fr) * NGATE + 2 * DM + u.pn * BM + wc * 64 + 8 * fq;
        u32x4 gq[2][4][2];
#pragma unroll
        for (int ai = 0; ai < 2; ++ai)
#pragma unroll
            for (int m = 0; m < 4; ++m) { const bf16* gp = gb + (size_t)(ai * HALF + m * 16) * NGATE; gq[ai][m][0] = *(const u32x4*)gp; gq[ai][m][1] = *(const u32x4*)(gp + 32); }
#pragma unroll
        for (int ai = 0; ai < 2; ++ai)
#pragma unroll
            for (int m = 0; m < 4; ++m) {
                float g0[8], g1[8]; unpack8(gq[ai][m][0], g0); unpack8(gq[ai][m][1], g1);
                f32x4 v0 = acc[ai][0][m][0], v1 = acc[ai][0][m][1], v2 = acc[ai][1][m][0], v3 = acc[ai][1][m][1];
                v0[0] *= g0[0]; v0[1] *= g0[1]; v0[2] *= g0[2]; v0[3] *= g0[3]; v1[0] *= g0[4]; v1[1] *= g0[5]; v1[2] *= g0[6]; v1[3] *= g0[7];
                v2[0] *= g1[0]; v2[1] *= g1[1]; v2[2] *= g1[2]; v2[3] *= g1[3]; v3[0] *= g1[4]; v3[1] *= g1[5]; v3[2] *= g1[6]; v3[3] *= g1[7];
                st_lines<false>(sw, pk8(v0, v1), pk8(v2, v3), base + (size_t)(ai * HALF + m * 16) * DM, (size_t)DM, fr, fq); }
    }
};
struct EpiResidSplit {
    static constexpr bool HOOK = false;
    float* X; float* P; int pmS, KS; LAS unsigned char* scr;
    __device__ __forceinline__ void operator()(const f32x4 (&acc)[2][2][4][2], const Unit& u, int wr, int wc, int fr, int fq) const {
        const bool piece = u.pm >= pmS;
        float* base = (piece ? P + (size_t)(u.koff / KS) * (MS * DM) - (size_t)u.pm * BM * DM : X) + (size_t)(u.pm * BM + wr * 64) * DM + u.pn * BM + wc * 64;
        LAS unsigned char* sw = scr + (wr * 4 + wc) * 2048;
        const int lane = fq * 16 + fr, rr = lane >> 3, c = lane & 7;
        float* drow = base + (size_t)rr * DM + c * 4;
#define RS_OFF(st) ((size_t)((((st) >> 3) & 1) * HALF + (((st) >> 1) & 3) * 16) * DM + ((st) & 1) * 32)
        f32x4 xa[2][4], xb[2][4];
        if (!piece) {
#pragma unroll
            for (int q = 0; q < 4; ++q) { const float* d = drow + RS_OFF(q); xa[0][q] = *(const f32x4*)d; xb[0][q] = *(const f32x4*)(d + 8 * DM); } }
#pragma unroll
        for (int bt = 0; bt < 4; ++bt) {
            if (!piece && bt < 3) {
#pragma unroll
                for (int q = 0; q < 4; ++q) { const float* d = drow + RS_OFF(4 * (bt + 1) + q); xa[(bt + 1) & 1][q] = *(const f32x4*)d; xb[(bt + 1) & 1][q] = *(const f32x4*)(d + 8 * DM); } }
#pragma unroll
            for (int q = 0; q < 4; ++q) { const int st = 4 * bt + q, ai = (st >> 3) & 1, m = (st >> 1) & 3, bj = st & 1;
                *(LAS f32x4*)(sw + fr * 128 + (((2 * fq) ^ (fr & 7)) << 4)) = acc[ai][bj][m][0];
                *(LAS f32x4*)(sw + fr * 128 + (((2 * fq + 1) ^ (fr & 7)) << 4)) = acc[ai][bj][m][1];
                f32x4 a = *(const LAS f32x4*)(sw + rr * 128 + ((c ^ rr) << 4)), b = *(const LAS f32x4*)(sw + (8 + rr) * 128 + ((c ^ rr) << 4));
                float* d = drow + RS_OFF(st);
                if (!piece) { a += xa[bt & 1][q]; b += xb[bt & 1][q]; }
                *(f32x4*)d = a; *(f32x4*)(d + 8 * DM) = b; }
        }
#undef RS_OFF
    }
};
struct EpiUp {
    static constexpr bool HOOK = false;
    bf16* U; LAS unsigned char* scr;
    __device__ __forceinline__ void operator()(const f32x4 (&acc)[2][2][4][2], const Unit& u, int wr, int wc, int fr, int fq) const {
        bf16* base = U + (size_t)(u.pm * BM + wr * 64) * DFF + u.pn * BM + wc * 64; LAS unsigned char* sw = scr + (wr * 4 + wc) * 2048;
#pragma unroll
        for (int ai = 0; ai < 2; ++ai)
#pragma unroll
            for (int m = 0; m < 4; ++m) {
                f32x4 v0 = acc[ai][0][m][0], v1 = acc[ai][0][m][1], v2 = acc[ai][1][m][0], v3 = acc[ai][1][m][1];
#pragma unroll
                for (int e = 0; e < 4; ++e) { const float a = fmaxf(v0[e], 0.f), b = fmaxf(v1[e], 0.f), c = fmaxf(v2[e], 0.f), d = fmaxf(v3[e], 0.f); v0[e] = a * a; v1[e] = b * b; v2[e] = c * c; v3[e] = d * d; }
                st_lines<true>(sw, pk8(v0, v1), pk8(v2, v3), base + (size_t)(ai * HALF + m * 16) * DFF, (size_t)DFF, fr, fq); }
    }
};
}

namespace att {
__device__ __forceinline__ int crow(int r, int hi) { return (r & 3) + 8 * (r >> 2) + 4 * hi; }
__device__ __forceinline__ int v_st(int k, int c) { const int kk = (k & ~0xC) | ((k & 4) << 1) | ((k & 8) >> 1); return ((kk >> 3) * 4 + (c >> 5)) * 512 + ((kk & 7) * 32 + (c & 31)) * 2; }
__device__ __forceinline__ int v_rd_base(int lane) { return ((lane & 3) << 3) | (((lane >> 2) & 3) << 6) | (((lane >> 4) & 1) << 5) | (((lane >> 5) & 1) << 8); }
constexpr int v_rd_off(int d0, int ks, int half) { return d0 * 512 + ks * 4096 + half * 2048; }
template <int OFF> __device__ __forceinline__ s16x4 tr_read(unsigned vb) {
    s16x4 r; asm volatile("ds_read_b64_tr_b16 %0, %1 offset:%2" : "=&v"(r) : "v"(vb), "i"(OFF) : "memory"); return r;
}
template <int DQK> struct Cn {
    static constexpr float SCALE = DQK == 64 ? 0.125f : (DQK == 128 ? 0.08838834764831845f : 0.07216878364870323f);
    static constexpr float C = SCALE * 1.4426950408889634f;
    static constexpr float THRR = 8.f / SCALE;
};
template <int DQK> __device__ __forceinline__ int kswz(int row) { return (DQK == 128 ? (row & 15) : ((row >> 1) & 7)) << 4; }
template <int DQK>
__device__ __forceinline__ void qkt_h(f32x16& p, const f32x16& cinit, const LAS char* Ks, int rowbase, const bf16x8* qr, int r32, int hi) {
    constexpr int KRB = DQK * 2;
    p = cinit;
    const int sw = kswz<DQK>(r32);
#pragma unroll
    for (int d0 = 0; d0 < DQK / 16; ++d0) { const int cb = (d0 * 2 + hi) * 16;
        const bf16x8 b = *(const LAS bf16x8*)(Ks + (rowbase + r32) * KRB + (cb ^ sw));
        p = __builtin_amdgcn_mfma_f32_32x32x16_bf16(b, qr[d0], p, 0, 0, 0); }
}
template <int DQK>
__device__ __forceinline__ void smx_h(f32x16& p, float negB, float& l_acc, bf16x8& paA, bf16x8& paB) {
#pragma unroll
    for (int r = 0; r < 16; ++r) p[r] = __builtin_amdgcn_exp2f(p[r]);
    float s0 = (p[0] + p[1]) + (p[2] + p[3]), s1 = (p[4] + p[5]) + (p[6] + p[7]), s2 = (p[8] + p[9]) + (p[10] + p[11]), s3 = (p[12] + p[13]) + (p[14] + p[15]);
    l_acc += (s0 + s1) + (s2 + s3);
#define PK4(P, BASE, OUT) do { unsigned a0 = cvtpk(P[BASE + 0], P[BASE + 1]), a1 = cvtpk(P[BASE + 2], P[BASE + 3]);   \
    unsigned b0 = cvtpk(P[BASE + 4], P[BASE + 5]), b1 = cvtpk(P[BASE + 6], P[BASE + 7]);                              \
    auto r0 = __builtin_amdgcn_permlane32_swap(a0, b0, false, false); auto r1 = __builtin_amdgcn_permlane32_swap(a1, b1, false, false); \
    u32x4 w = {r0[0], r1[0], r0[1], r1[1]}; OUT = __builtin_bit_cast(bf16x8, w); } while (0)
    PK4(p, 0, paA); PK4(p, 8, paB);
#undef PK4
}
template <int D0, int KS0> __device__ __forceinline__ void pv_half_one(f32x16& od, unsigned vb, bf16x8 paA, bf16x8 paB) {
    s16x4 l0 = tr_read<v_rd_off(D0, KS0, 0)>(vb), h0 = tr_read<v_rd_off(D0, KS0, 1)>(vb), l1 = tr_read<v_rd_off(D0, KS0 + 1, 0)>(vb), h1 = tr_read<v_rd_off(D0, KS0 + 1, 1)>(vb);
    asm volatile("s_waitcnt lgkmcnt(0)" : "+v"(l0), "+v"(h0), "+v"(l1), "+v"(h1) :: "memory");
#define PK(L, H) (bf16x8){L[0], L[1], L[2], L[3], H[0], H[1], H[2], H[3]}
    od = __builtin_amdgcn_mfma_f32_32x32x16_bf16(paA, PK(l0, h0), od, 0, 0, 0);
    od = __builtin_amdgcn_mfma_f32_32x32x16_bf16(paB, PK(l1, h1), od, 0, 0, 0);
#undef PK
}
template <int KS0> __device__ __forceinline__ void pv_half(f32x16* o, unsigned vb, bf16x8 paA, bf16x8 paB) {
#define TR4(D0) s16x4 l0_##D0 = tr_read<v_rd_off(D0, KS0, 0)>(vb), h0_##D0 = tr_read<v_rd_off(D0, KS0, 1)>(vb), l1_##D0 = tr_read<v_rd_off(D0, KS0 + 1, 0)>(vb), h1_##D0 = tr_read<v_rd_off(D0, KS0 + 1, 1)>(vb)
    TR4(0); TR4(1); TR4(2); TR4(3);
#undef TR4
    asm volatile("s_waitcnt lgkmcnt(0)" : "+v"(l0_0), "+v"(h0_0), "+v"(l1_0), "+v"(h1_0), "+v"(l0_1), "+v"(h0_1), "+v"(l1_1), "+v"(h1_1),
                                          "+v"(l0_2), "+v"(h0_2), "+v"(l1_2), "+v"(h1_2), "+v"(l0_3), "+v"(h0_3), "+v"(l1_3), "+v"(h1_3) :: "memory");
#define PK(L, H) (bf16x8){L[0], L[1], L[2], L[3], H[0], H[1], H[2], H[3]}
#define MM(D0) o[D0] = __builtin_amdgcn_mfma_f32_32x32x16_bf16(paA, PK(l0_##D0, h0_##D0), o[D0], 0, 0, 0); o[D0] = __builtin_amdgcn_mfma_f32_32x32x16_bf16(paB, PK(l1_##D0, h1_##D0), o[D0], 0, 0, 0)
    MM(0); MM(1); MM(2); MM(3);
#undef MM
#undef PK
}
struct VFrag { s16x4 l0[4], h0[4], l1[4], h1[4]; };
template <int KS0> __device__ __forceinline__ void pv_issue(VFrag& f, unsigned vb) {
    f.l0[0] = tr_read<v_rd_off(0, KS0, 0)>(vb); f.h0[0] = tr_read<v_rd_off(0, KS0, 1)>(vb); f.l1[0] = tr_read<v_rd_off(0, KS0 + 1, 0)>(vb); f.h1[0] = tr_read<v_rd_off(0, KS0 + 1, 1)>(vb);
    f.l0[1] = tr_read<v_rd_off(1, KS0, 0)>(vb); f.h0[1] = tr_read<v_rd_off(1, KS0, 1)>(vb); f.l1[1] = tr_read<v_rd_off(1, KS0 + 1, 0)>(vb); f.h1[1] = tr_read<v_rd_off(1, KS0 + 1, 1)>(vb);
    f.l0[2] = tr_read<v_rd_off(2, KS0, 0)>(vb); f.h0[2] = tr_read<v_rd_off(2, KS0, 1)>(vb); f.l1[2] = tr_read<v_rd_off(2, KS0 + 1, 0)>(vb); f.h1[2] = tr_read<v_rd_off(2, KS0 + 1, 1)>(vb);
    f.l0[3] = tr_read<v_rd_off(3, KS0, 0)>(vb); f.h0[3] = tr_read<v_rd_off(3, KS0, 1)>(vb); f.l1[3] = tr_read<v_rd_off(3, KS0 + 1, 0)>(vb); f.h1[3] = tr_read<v_rd_off(3, KS0 + 1, 1)>(vb);
}
__device__ __forceinline__ void pv_wait(VFrag& f) {
    asm volatile("s_waitcnt lgkmcnt(0)" : "+v"(f.l0[0]), "+v"(f.h0[0]), "+v"(f.l1[0]), "+v"(f.h1[0]), "+v"(f.l0[1]), "+v"(f.h0[1]), "+v"(f.l1[1]), "+v"(f.h1[1]),
                                          "+v"(f.l0[2]), "+v"(f.h0[2]), "+v"(f.l1[2]), "+v"(f.h1[2]), "+v"(f.l0[3]), "+v"(f.h0[3]), "+v"(f.l1[3]), "+v"(f.h1[3]) :: "memory");
}
__device__ __forceinline__ void pv_mma(f32x16* o, const VFrag& f, bf16x8 paA, bf16x8 paB) {
#define PK(L, H) (bf16x8){L[0], L[1], L[2], L[3], H[0], H[1], H[2], H[3]}
#pragma unroll
    for (int d = 0; d < 4; ++d) { o[d] = __builtin_amdgcn_mfma_f32_32x32x16_bf16(paA, PK(f.l0[d], f.h0[d]), o[d], 0, 0, 0); o[d] = __builtin_amdgcn_mfma_f32_32x32x16_bf16(paB, PK(f.l1[d], f.h1[d]), o[d], 0, 0, 0); }
#undef PK
}
struct UnitP {
    const bf16* Q; int ldq; int nq;
    const bf16* K; int ldk; const bf16* V; int ldv;
    void* O; int ldo;
    int NT;
    int kvalid;
    int lo_base, lo_step, hi_base, hi_step;
    int qpos0, kpos0; const float* tab;
    float negB;
    int fix_lo, fix_hi;
};
constexpr int LDS_ATT_V = 0, LDS_ATT_K = 49152, LDS_ATT_WS = RING_BYTES + 1024, LDS_ATT_TAB = LDS_ATT_WS + 2048, LDS_ATT_END = LDS_ATT_TAB + 1088;
static_assert(LDS_ATT_K + 3 * 24576 <= RING_BYTES && LDS_ATT_WS >= MISC_OFF + 128 && LDS_ATT_END <= EPI_OFF, "attention LDS");

template <int DQK, bool F32OUT, bool BIAS, bool PIPE2>
__device__ __forceinline__ void attn_unit(const UnitP& P, LAS char* lds) {
    constexpr int NQ = DQK / 16, KRB = DQK * 2, KCH = DQK / 8, KP = DQK / 64;
    constexpr int SHM_V = 16384, SHM_K = 64 * DQK * 2;
    constexpr float NEGINF = -__builtin_huge_valf();
    const int tid = fresh_tid(), wid = __builtin_amdgcn_readfirstlane(tid >> 6), lane = tid & 63, r32 = lane & 31, hi = lane >> 5;
    LAS char* V_lds = lds + LDS_ATT_V; LAS char* K_lds = lds + LDS_ATT_K;
    LAS float* ws = (LAS float*)(lds + LDS_ATT_WS) + wid * 64; LAS float* li_l = ws; LAS float* al_l = ws + 32;
    LAS float* tblS = (LAS float*)(lds + LDS_ATT_TAB);
    const int NT = P.NT, kvalid = P.kvalid;
    int lo_w = P.lo_base + P.lo_step * (wid >> 1); lo_w = lo_w < 0 ? 0 : lo_w;
    const int hi_w = P.hi_base + P.hi_step * (wid >> 1);
    float l_reg = 0.f; const float negB = P.negB; f32x16 o[4] = {}; bf16x8 qr[NQ];
    { int qrow = wid * 32 + r32; qrow = qrow < P.nq ? qrow : P.nq - 1;
      const bf16* Qw = P.Q + (size_t)qrow * P.ldq + hi * 8;
#pragma unroll
      for (int d0 = 0; d0 < NQ; ++d0) qr[d0] = *(const bf16x8*)(Qw + d0 * 16); }
    unsigned voffV[2], voffK[KP];
#pragma unroll
    for (int i = 0; i < 2; ++i) { const int b_ = (tid + 512 * i) * 16, st = b_ >> 9, kk = (st >> 2) * 8 + ((b_ & 511) >> 6), c = (st & 3) * 32 + ((b_ & 63) >> 1), k = (kk & ~0xC) | ((kk & 4) << 1) | ((kk & 8) >> 1);
        voffV[i] = (unsigned)(k * P.ldv + c) * 2u; }
#pragma unroll
    for (int p = 0; p < KP; ++p) { const int G = tid + 512 * p, row = G / KCH, slot = G % KCH, g = slot ^ (kswz<DQK>(row) >> 4); voffK[p] = (unsigned)(row * P.ldk + g * 8) * 2u; }
    const unsigned vb0 = (unsigned)(uintptr_t)V_lds + (unsigned)v_rd_base(lane);
    const bf16* Kh = P.K; const bf16* Vh = P.V; const int ldk = P.ldk, ldv = P.ldv;
#define DMA(b, k0) do { const char* vsrc_ = (const char*)(Vh + (size_t)(k0) * ldv); const char* ksrc_ = (const char*)(Kh + (size_t)(k0) * ldk); \
    _Pragma("unroll") for (int i = 0; i < 2; ++i) __builtin_amdgcn_global_load_lds((const unsigned*)(vsrc_ + voffV[i]), (LAS unsigned*)(V_lds + (b) * SHM_V + wid * 1024 + i * 8192), 16, 0, 0); \
    _Pragma("unroll") for (int p = 0; p < KP; ++p) __builtin_amdgcn_global_load_lds((const unsigned*)(ksrc_ + voffK[p]), (LAS unsigned*)(K_lds + (b) * SHM_K + wid * 1024 + p * 8192), 16, 0, 0); } while (0)
#define FIXUP(p0, p1, jt) do { \
    if ((jt) < P.fix_lo || (jt) >= P.fix_hi) { int kv_ = kvalid, lo_ = lo_w, hi_ = hi_w; asm volatile("; masked-tile path" : "+s"(kv_), "+s"(lo_), "+s"(hi_) :: "memory");     \
      if ((jt) < lo_ || (jt) > hi_) { _Pragma("unroll") for (int r = 0; r < 16; ++r) { p0[r] = NEGINF; p1[r] = NEGINF; } } \
      else if (((jt) + 1) * 64 > kv_) { _Pragma("unroll") for (int r = 0; r < 16; ++r) { const int key = (jt) * 64 + crow(r, hi); if (key >= kv_) p0[r] = NEGINF; if (key + 32 >= kv_) p1[r] = NEGINF; } } } \
    if constexpr (BIAS) { if ((jt) >= lo_w && (jt) <= hi_w) { const int kb_ = P.kpos0 + (jt) * 64, qw_ = P.qpos0 + wid * 32; \
        if (qw_ - (kb_ + 63) >= 128) { const float c_ = tblS[256]; _Pragma("unroll") for (int r = 0; r < 16; ++r) { p0[r] += c_; p1[r] += c_; } } \
        else { const int dq_ = qw_ + r32 - kb_; _Pragma("unroll") for (int r = 0; r < 16; ++r) { int d0_ = dq_ - crow(r, hi), d1_ = d0_ - 32; \
            d0_ = d0_ < -128 ? -128 : (d0_ > 128 ? 128 : d0_); d1_ = d1_ < -128 ? -128 : (d1_ > 128 ? 128 : d1_); p0[r] += tblS[d0_ + 128]; p1[r] += tblS[d1_ + 128]; } } } } \
    } while (0)
    f32x16 pA0, pA1; bf16x8 pa0, pa1, pa2, pa3;
    DMA(0, 0); if (1 < NT) DMA(1, 64);
    if constexpr (BIAS) { if (tid < 257) tblS[tid] = P.tab[tid] * 1.4426950408889634f; }
    if (1 < NT) { if constexpr (KP == 1) asm volatile("s_waitcnt vmcnt(3)" ::: "memory"); else if constexpr (KP == 2) asm volatile("s_waitcnt vmcnt(4)" ::: "memory"); else asm volatile("s_waitcnt vmcnt(5)" ::: "memory"); }
    else asm volatile("s_waitcnt vmcnt(0)" ::: "memory");
    asm volatile("s_waitcnt lgkmcnt(0)\n\ts_barrier" ::: "memory");
    if constexpr (!PIPE2) {
#define FIXUP_H(p, jt, kofs) do { \
    if ((jt) < P.fix_lo || (jt) >= P.fix_hi) { int kv_ = kvalid, lo_ = lo_w, hi_ = hi_w; asm volatile("; masked-tile path" : "+s"(kv_), "+s"(lo_), "+s"(hi_) :: "memory"); \
      if ((jt) < lo_ || (jt) > hi_) { _Pragma("unroll") for (int r = 0; r < 16; ++r) p[r] = NEGINF; } \
      else if (((jt) + 1) * 64 > kv_) { _Pragma("unroll") for (int r = 0; r < 16; ++r) { if ((jt) * 64 + (kofs) + crow(r, hi) >= kv_) p[r] = NEGINF; } } } \
    if constexpr (BIAS) { if ((jt) >= lo_w && (jt) <= hi_w) { const int kb_ = P.kpos0 + (jt) * 64 + (kofs), qw_ = P.qpos0 + wid * 32; \
        if (qw_ - (kb_ + 31) >= 128) { const float c_ = tblS[256]; _Pragma("unroll") for (int r = 0; r < 16; ++r) p[r] += c_; } \
        else { const int dq_ = qw_ + r32 - kb_; _Pragma("unroll") for (int r = 0; r < 16; ++r) { int d0_ = dq_ - crow(r, hi); d0_ = d0_ < -128 ? -128 : (d0_ > 128 ? 128 : d0_); p[r] += tblS[d0_ + 128]; } } } } \
    } while (0)
        static_assert(!PIPE2, "q is pre-scaled: only the half-tile loop is current");
        f32x16 cinit;
#pragma unroll
        for (int r = 0; r < 16; ++r) cinit[r] = negB;
        const bool wave_on = wid * 32 < P.nq;
        int bsel = 0;
        for (int j = 0; j < NT; ++j) {
            const int bn1 = bsel == 2 ? 0 : bsel + 1, bn2 = bn1 == 2 ? 0 : bn1 + 1;
            if (j + 2 < NT) DMA(bn2, (j + 2) * 64);
            if (wave_on && j >= lo_w && j <= hi_w) {
            SBAR(); qkt_h<DQK>(pA0, cinit, K_lds + bsel * SHM_K, 0, qr, r32, hi);
            FIXUP_H(pA0, j, 0);
            SBAR(); qkt_h<DQK>(pA1, cinit, K_lds + bsel * SHM_K, 32, qr, r32, hi); smx_h<DQK>(pA0, negB, l_reg, pa0, pa1);
            FIXUP_H(pA1, j, 32);
            if constexpr (true) {
                VFrag f0, f2; SBAR(); pv_issue<0>(f0, vb0 + bsel * SHM_V); pv_wait(f0); pv_issue<2>(f2, vb0 + bsel * SHM_V);
                pv_mma(o, f0, pa0, pa1); smx_h<DQK>(pA1, negB, l_reg, pa2, pa3);
                SBAR(); pv_wait(f2); pv_mma(o, f2, pa2, pa3); SBAR();
            } else {
            SBAR(); pv_half<0>(o, vb0 + bsel * SHM_V, pa0, pa1); smx_h<DQK>(pA1, negB, l_reg, pa2, pa3);
            SBAR(); pv_half<2>(o, vb0 + bsel * SHM_V, pa2, pa3); SBAR();
            }
            }
            if (j + 2 < NT) { if constexpr (KP == 1) asm volatile("s_waitcnt vmcnt(3) lgkmcnt(0)\n\ts_barrier" ::: "memory"); else if constexpr (KP == 2) asm volatile("s_waitcnt vmcnt(4) lgkmcnt(0)\n\ts_barrier" ::: "memory"); else asm volatile("s_waitcnt vmcnt(5) lgkmcnt(0)\n\ts_barrier" ::: "memory"); }
            else asm volatile("s_waitcnt vmcnt(0) lgkmcnt(0)\n\ts_barrier" ::: "memory");
            bsel = bn1;
        }
#undef FIXUP_H
    }
    { auto rr = __builtin_amdgcn_permlane32_swap(__float_as_uint(l_reg), __float_as_uint(l_reg), false, false); l_reg = __uint_as_float(rr[0]) + __uint_as_float(rr[1]); }
    if (hi == 0) li_l[r32] = l_reg; asm volatile("s_waitcnt lgkmcnt(0)" ::: "memory");
    float rli[16];
#pragma unroll
    for (int r = 0; r < 16; ++r) rli[r] = __builtin_amdgcn_rcpf(li_l[crow(r, hi)]);
    const int nq = P.nq, ldo = P.ldo;
#pragma unroll
    for (int r = 0; r < 16; ++r) { const int orow = wid * 32 + crow(r, hi);
        if (orow < nq) {
            if constexpr (F32OUT) { float* Ow = (float*)P.O + (size_t)orow * ldo + r32;
#pragma unroll
                for (int d0 = 0; d0 < 4; ++d0) Ow[d0 * 32] = o[d0][r] * rli[r]; }
            else { bf16* Ow = (bf16*)P.O + (size_t)orow * ldo + r32;
#pragma unroll
                for (int d0 = 0; d0 < 4; ++d0) Ow[d0 * 32] = (bf16)(cvtpk(o[d0][r] * rli[r], 0.f) & 0xffffu); }
        } }
    __syncthreads();
#undef DMA
#undef FIXUP
}
}

template <class T> __device__ __forceinline__ T* launder(T* p) { asm volatile("" : "+s"(p)); return p; }
struct Frame {
    LAS unsigned char* lds;
    int tid, lane, wave, vcu, G, bx;
    int gw, NGW;
    float* out; unsigned char* ws;
};
struct Args { const float* in[31]; float* out; unsigned char* ws; int ph_lo, ph_hi; int use_bar, pad; };
typedef const __attribute__((address_space(4))) Args* ArgsP;
__device__ __forceinline__ ArgsP fresh_args() { ArgsP p = (ArgsP)__builtin_amdgcn_kernarg_segment_ptr(); asm volatile("" : "+s"(p)); return p; }
enum { I_XP = 0, I_XS, I_CAK, I_CAV, I_CBC, I_CBP, I_CCK, I_CCV, I_ANORM, I_WIN, I_BGATE, I_AQN, I_AKN, I_ALAM, I_ASUB, I_BQAN, I_BKVN, I_WQB, I_WKVB, I_BQN, I_BKN, I_CQN, I_CKN, I_CBIAS,
       I_WBRA, I_WBRB, I_WBRC, I_WO, I_MNORM, I_WUP, I_WDN };

__device__ __forceinline__ void transpose_item(const float* W, int K, int N, bf16* WT, int ldw, int gap_at, int gap, LAS float* scr, int item, int lane) {
    const int nblk = N / 32, kb = item / nblk, nb = item % nblk, k0 = 64 * kb, n0 = 32 * nb;
    float t[32];
#pragma unroll
    for (int i = 0; i < 32; ++i) t[i] = __builtin_nontemporal_load(W + (size_t)(k0 + 2 * i + (lane >> 5)) * N + n0 + (lane & 31));
#pragma unroll
    for (int i = 0; i < 32; ++i) scr[(2 * i + (lane >> 5)) * 33 + (lane & 31)] = t[i];
    LDS_WAIT(); asm volatile("" ::: "memory");
    const int c = lane & 7; const int roff = (n0 >= gap_at) ? gap : 0;
#pragma unroll
    for (int j = 0; j < 4; ++j) { const int n = (lane >> 3) + 8 * j; const LAS float* s = scr + (8 * c) * 33 + n;
        u32x4 o; o.x = cvtpk(s[0 * 33], s[1 * 33]); o.y = cvtpk(s[2 * 33], s[3 * 33]); o.z = cvtpk(s[4 * 33], s[5 * 33]); o.w = cvtpk(s[6 * 33], s[7 * 33]);
        *(u32x4*)(WT + (size_t)(roff + n0 + n) * ldw + k0 + 8 * c) = o; }
    LDS_WAIT(); asm volatile("" ::: "memory");
}

__device__ __forceinline__ void rmsnorm_rows(const Frame& F, ArgsP A, const float* g, bf16* H, bool first, const float* slab, int ns) {
    float* X = F.out + OUT_Y;
    if (!first) {
        LAS float* part = (LAS float*)(F.lds + EPI_OFF);
        for (int rs = F.vcu; rs < MS; rs += F.G) {
            const size_t off = (size_t)rs * DM + 256 * F.wave + 4 * F.lane;
            f32x4 v = *(const f32x4*)(X + (size_t)MP * DM + off);
            const float* sp = slab + off;
            for (int k = 0; k < ns; k += 8) { f32x4 t[8];
#pragma unroll
                for (int q = 0; q < 8; ++q) t[q] = *(const f32x4*)(sp + (size_t)(k + q) * MS * DM);
#pragma unroll
                for (int q = 0; q < 8; ++q) v += t[q]; }
            const float ps = wave_sum((v.x * v.x + v.y * v.y) + (v.z * v.z + v.w * v.w));
            __syncthreads();
            if (F.lane == 0) part[F.wave] = ps;
            __syncthreads();
            float tot = 0.f;
#pragma unroll
            for (int w = 0; w < 8; ++w) tot += part[w];
            const float rstd = rsqrtf(tot * (1.f / DM) + EPS);
            const f32x4 gg = *(const f32x4*)(g + 256 * F.wave + 4 * F.lane);
            u32x2 w; w.x = cvtpk(v.x * rstd * gg.x, v.y * rstd * gg.y); w.y = cvtpk(v.z * rstd * gg.z, v.w * rstd * gg.w);
            *(u32x2*)(H + (size_t)MP * DM + off) = w;
            *(f32x4*)(X + (size_t)MP * DM + off) = v;
        }
    }
    constexpr int RU = 4;
    const int Rn = first ? M : MP;
    f32x4 gg[8];
#pragma unroll
    for (int j = 0; j < 8; ++j) gg[j] = *(const f32x4*)(g + 4 * F.lane + 256 * j);
    for (int row0 = F.gw; row0 < Rn; row0 += RU * F.NGW) {
        f32x4 v[RU][8];
#pragma unroll
        for (int u = 0; u < RU; ++u) { const int row = row0 + u * F.NGW;
            if (row < Rn) { const float* xr = first ? (row < MP ? A->in[I_XP] + (size_t)row * DM : A->in[I_XS] + (size_t)(row - MP) * DM) : X + (size_t)row * DM;
#pragma unroll
                for (int j = 0; j < 8; ++j) v[u][j] = *(const f32x4*)(xr + 4 * F.lane + 256 * j); } }
#pragma unroll
        for (int u = 0; u < RU; ++u) { const int row = row0 + u * F.NGW;
            if (row < Rn) {
                float ss = 0.f;
#pragma unroll
                for (int j = 0; j < 8; ++j) ss += (v[u][j].x * v[u][j].x + v[u][j].y * v[u][j].y) + (v[u][j].z * v[u][j].z + v[u][j].w * v[u][j].w);
                const float rstd = rsqrtf(wave_sum(ss) * (1.f / DM) + EPS);
#pragma unroll
                for (int j = 0; j < 8; ++j) {
                    u32x2 w; w.x = cvtpk(v[u][j].x * rstd * gg[j].x, v[u][j].y * rstd * gg[j].y); w.y = cvtpk(v[u][j].z * rstd * gg[j].z, v[u][j].w * rstd * gg[j].w);
                    *(u32x2*)(H + (size_t)row * DM + 4 * F.lane + 256 * j) = w;
                    if (first) *(f32x4*)(X + (size_t)row * DM + 4 * F.lane + 256 * j) = v[u][j]; } } }
    }
}
__device__ __forceinline__ void final_combine(const Frame& F, const float* slab, int ns) {
    float* X = F.out + OUT_Y;
    for (int rs = F.vcu; rs < MS; rs += F.G) {
        const size_t off = (size_t)rs * DM + 256 * F.wave + 4 * F.lane;
        f32x4 v = *(const f32x4*)(X + (size_t)MP * DM + off);
        const float* sp = slab + off;
        for (int k = 0; k < ns; k += 8) { f32x4 t[8];
#pragma unroll
            for (int q = 0; q < 8; ++q) t[q] = *(const f32x4*)(sp + (size_t)(k + q) * MS * DM);
#pragma unroll
            for (int q = 0; q < 8; ++q) v += t[q]; }
        *(f32x4*)(X + (size_t)MP * DM + off) = v;
    }
}
__device__ __forceinline__ void pre_weights(const Frame& F, ArgsP A, int l, unsigned char* wsw, int gw, int NGW, int it_lo = 0, int it_hi = 1 << 30) {
    LAS float* scr = (LAS float*)(F.lds + F.wave * 16384);
    constexpr int I_IN = (DM / 64) * (INCOLS / 32), I_QB = (512 / 64) * (1536 / 32), I_KVB = (256 / 64) * (2048 / 32), I_BA = (512 / 64) * (DM / 32), I_BB = (1024 / 64) * (DM / 32),
                  I_O = (DM / 64) * (DM / 32), I_UP = (DM / 64) * (DFF / 32), I_DN = (DFF / 64) * (DM / 32);
    constexpr int NITEMS = I_IN + I_QB + I_KVB + 2 * I_BA + I_BB + I_O + I_UP + I_DN;
    const int it_end = it_hi < NITEMS ? it_hi : NITEMS;
    for (int it = it_lo + gw; it < it_end; it += NGW) {
        int r = it;
        if (r < I_IN) { transpose_item(A->in[I_WIN] + (size_t)l * DM * INCOLS, DM, INCOLS, (bf16*)(wsw + WS_WIN), DM, 2368, 192, scr, r, F.lane); continue; } r -= I_IN;
        if (r < I_QB) { transpose_item(A->in[I_WQB] + (size_t)l * 512 * 1536, 512, 1536, (bf16*)(wsw + WS_WQB), 512, 1 << 30, 0, scr, r, F.lane); continue; } r -= I_QB;
        if (r < I_KVB) { transpose_item(A->in[I_WKVB] + (size_t)l * 256 * 2048, 256, 2048, (bf16*)(wsw + WS_WKVB), 256, 1 << 30, 0, scr, r, F.lane); continue; } r -= I_KVB;
        if (r < I_BA) { transpose_item(A->in[I_WBRA] + (size_t)l * 512 * DM, 512, DM, (bf16*)(wsw + WS_WBR), DM, 1 << 30, 0, scr, r, F.lane); continue; } r -= I_BA;
        if (r < I_BB) { transpose_item(A->in[I_WBRB] + (size_t)l * 1024 * DM, 1024, DM, (bf16*)(wsw + WS_WBR) + 512, DM, 1 << 30, 0, scr, r, F.lane); continue; } r -= I_BB;
        if (r < I_BA) { transpose_item(A->in[I_WBRC] + (size_t)l * 512 * DM, 512, DM, (bf16*)(wsw + WS_WBR) + 1536, DM, 1 << 30, 0, scr, r, F.lane); continue; } r -= I_BA;
        if (r < I_O) { transpose_item(A->in[I_WO] + (size_t)l * DM * DM, DM, DM, (bf16*)(wsw + WS_WO), DM, 1 << 30, 0, scr, r, F.lane); continue; } r -= I_O;
        if (r < I_UP) { transpose_item(A->in[I_WUP] + (size_t)l * DM * DFF, DM, DFF, (bf16*)(wsw + WS_WUP), DM, 1 << 30, 0, scr, r, F.lane); continue; } r -= I_UP;
        transpose_item(A->in[I_WDN] + (size_t)l * DFF * DM, DFF, DM, (bf16*)(wsw + WS_WDN), DFF, 1 << 30, 0, scr, r, F.lane);
    }
    const int gt = gw * 64 + F.lane, NGT = NGW * 64;
    if (it_lo == 0) {
        bf16* wz = (bf16*)(wsw + WS_WIN) + (size_t)2368 * DM;
        for (int i = gt; i < 192 * DM / 8; i += NGT) *(u32x4*)(wz + (size_t)i * 8) = (u32x4){0u, 0u, 0u, 0u};
    }
}
__device__ __forceinline__ void pre_caches(const Frame& F, ArgsP A, int l, int gw, int NGW) {
    unsigned char* ws = F.ws; const int gt = gw * 64 + F.lane, NGT = NGW * 64;
    {
        bf16* KA = (bf16*)(ws + WS_KA); bf16* VA = (bf16*)(ws + WS_VA); bf16* CKV = (bf16*)(ws + WS_CKV); float* KPE = (float*)(ws + WS_KPE); bf16* KC = (bf16*)(ws + WS_KC); bf16* VC = (bf16*)(ws + WS_VC);
        const float* cak = A->in[I_CAK] + (size_t)l * DECB * PAST * 512; const float* cav = A->in[I_CAV] + (size_t)l * DECB * PAST * 512;
        const float* cbc = A->in[I_CBC] + (size_t)l * DECB * PAST * 256; const float* cbp = A->in[I_CBP] + (size_t)l * DECB * PAST * 64;
        const float* cck = A->in[I_CCK] + (size_t)l * DECB * CPAST * 512; const float* ccv = A->in[I_CCV] + (size_t)l * DECB * CPAST * 512;
        for (int i0 = gt; i0 < DECB * PAST * 512 / 8; i0 += 4 * NGT) { f32x4 ka[4][2], va[4][2];
#pragma unroll
            for (int u = 0; u < 4; ++u) { const int i = i0 + u * NGT; if (i < DECB * PAST * 512 / 8) { const float* pk = cak + (size_t)i * 8; const float* pv = cav + (size_t)i * 8;
                ka[u][0] = *(const f32x4*)pk; ka[u][1] = *(const f32x4*)(pk + 4); va[u][0] = *(const f32x4*)pv; va[u][1] = *(const f32x4*)(pv + 4); } }
#pragma unroll
            for (int u = 0; u < 4; ++u) { const int i = i0 + u * NGT; if (i < DECB * PAST * 512 / 8) { const int c = (i & 63) * 8, rr = i >> 6, b = rr >> 11, p = rr & 2047; const size_t d = ((size_t)MP + b * SROWS + p) * 512 + c;
                *(u32x4*)(KA + d) = pg8::pk8(ka[u][0], ka[u][1]); *(u32x4*)(VA + d) = pg8::pk8(va[u][0], va[u][1]); } } }
        for (int i0 = gt; i0 < DECB * PAST * 256 / 8; i0 += 4 * NGT) { f32x4 ka[4][2];
#pragma unroll
            for (int u = 0; u < 4; ++u) { const int i = i0 + u * NGT; if (i < DECB * PAST * 256 / 8) { const float* pk = cbc + (size_t)i * 8; ka[u][0] = *(const f32x4*)pk; ka[u][1] = *(const f32x4*)(pk + 4); } }
#pragma unroll
            for (int u = 0; u < 4; ++u) { const int i = i0 + u * NGT; if (i < DECB * PAST * 256 / 8) { const int c = (i & 31) * 8, rr = i >> 5, b = rr >> 11, p = rr & 2047; const size_t d = ((size_t)MP + b * SROWS + p) * 256 + c;
                *(u32x4*)(CKV + d) = pg8::pk8(ka[u][0], ka[u][1]); } } }
        for (int i = gt; i < DECB * PAST * 64 / 8; i += NGT) { const int c = (i & 7) * 8, rr = i >> 3, b = rr >> 11, p = rr & 2047; const size_t d = ((size_t)MP + b * SROWS + p) * 64 + c;
            float v[8]; ld8f(cbp + (size_t)i * 8, v); st8f(KPE + d, v); }
        for (int i0 = gt; i0 < DECB * CPAST * 512 / 8; i0 += 4 * NGT) { f32x4 ka[4][2], va[4][2];
#pragma unroll
            for (int u = 0; u < 4; ++u) { const int i = i0 + u * NGT; if (i < DECB * CPAST * 512 / 8) { const float* pk = cck + (size_t)i * 8; const float* pv = ccv + (size_t)i * 8;
                ka[u][0] = *(const f32x4*)pk; ka[u][1] = *(const f32x4*)(pk + 4); va[u][0] = *(const f32x4*)pv; va[u][1] = *(const f32x4*)(pv + 4); } }
#pragma unroll
            for (int u = 0; u < 4; ++u) { const int i = i0 + u * NGT; if (i < DECB * CPAST * 512 / 8) { const int c = (i & 63) * 8, rr = i >> 6, b = rr >> 9, p = rr & 511; const size_t d = ((size_t)MP + b * CROWS + p) * 512 + c;
                *(u32x4*)(KC + d) = pg8::pk8(ka[u][0], ka[u][1]); *(u32x4*)(VC + d) = pg8::pk8(va[u][0], va[u][1]); } } }
        const u32x4 z4 = (u32x4){0u, 0u, 0u, 0u};
        for (int i = gt; i < DECB * 112 * 64; i += NGT) { const int c = (i & 63) * 8, rr = i >> 6, b = rr / 112, p = rr % 112;
            const size_t d = ((size_t)MP + b * SROWS + PAST + DECS + p) * 512 + c; *(u32x4*)(KA + d) = z4; *(u32x4*)(VA + d) = z4;
            const size_t dc = ((size_t)MP + b * CROWS + CPAST + DECS + p) * 512 + c; *(u32x4*)(KC + dc) = z4; *(u32x4*)(VC + dc) = z4; }
        for (int i = gt; i < DECB * 112 * 32; i += NGT) { const int c = (i & 31) * 8, rr = i >> 5, b = rr / 112, p = rr % 112;
            const size_t d = ((size_t)MP + b * SROWS + PAST + DECS + p) * 256 + c; *(u32x4*)(CKV + d) = z4; }
        for (int i = gt; i < DECB * 112 * 16; i += NGT) { const int c = (i & 15) * 4, rr = i >> 4, b = rr / 112, p = rr % 112;
            const size_t d = ((size_t)MP + b * SROWS + PAST + DECS + p) * 64 + c; *(f32x4*)(KPE + d) = (f32x4){0.f, 0.f, 0.f, 0.f}; }
    }
}
constexpr size_t WS_SLAB_O = WS_R2, WS_SLAB_DN = WS_R2 + 64 * MiB;
constexpr int NS_O = 16, NS_DN = 32;
static_assert(NS_O % 8 == 0 && NS_DN % 8 == 0 && (size_t)NS_O * MS * DM * 4 <= 64 * MiB && (size_t)NS_DN * MS * DM * 4 <= 64 * MiB && WS_SLAB_DN + 64 * MiB <= WS_OALL, "slabs");
constexpr int WCUT1 = 13000, WCUT2 = 26500;
constexpr size_t WS_WSET1 = 1823 * MiB;
static_assert(WS_WDN + WS_WSET1 + (size_t)DM * DFF * 2 <= 2032 * MiB && WS_WIN + WS_WSET1 >= WS_END, "second weight set");
__device__ __forceinline__ void phase_pre(const Frame& F, ArgsP A, int l) {
    if (l == 0) { pre_weights(F, A, 0, F.ws, F.gw, F.NGW); pre_caches(F, A, 0, F.gw, F.NGW); }
    rmsnorm_rows(F, A, A->in[I_ANORM] + (size_t)l * DM, (bf16*)(F.ws + WS_R3), l == 0, (const float*)(F.ws + WS_SLAB_DN), NS_DN);
}

__device__ __forceinline__ float rope_inv(int lane) { return __builtin_amdgcn_exp2f(-(float)(lane & 31) * (18.931568569324174f / 32.f)); }
__device__ __forceinline__ void rope_cs(int pos, float inv, float& cs, float& sn) {
    const float a = (float)pos * inv; const float k = rintf(a * 0.15915494309189535f);
    float r = fmaf(-k, 6.28125f, a); r = fmaf(-k, 1.9353071795864769e-3f, r);
    const float rev = r * 0.15915494309189535f;
    cs = __builtin_amdgcn_cosf(rev); sn = __builtin_amdgcn_sinf(rev);
}

__device__ __forceinline__ void phase_post_in(const Frame& F, ArgsP A, int l) {
    unsigned char* ws = F.ws; const int lane = F.lane;
    const bf16* Z = (const bf16*)(ws + WS_R1);
    bf16* QA = (bf16*)(ws + WS_QA); bf16* KA = (bf16*)(ws + WS_KA); bf16* VA = (bf16*)(ws + WS_VA); bf16* CQ = (bf16*)(ws + WS_CQ); bf16* CKV = (bf16*)(ws + WS_CKV); float* KPE = (float*)(ws + WS_KPE);
    bf16* QC = (bf16*)(ws + WS_QC); bf16* KC = (bf16*)(ws + WS_KC); bf16* VC = (bf16*)(ws + WS_VC);
    const float inv = rope_inv(lane);
    float gq[8], gk[8], gqa[8], gkv[8], gcq[8], gck[8];
    ld8f(A->in[I_AQN] + l * 64 + 8 * (lane & 7), gq); ld8f(A->in[I_AKN] + l * 64 + 8 * (lane & 7), gk);
    ld8f(A->in[I_BQAN] + l * 512 + 8 * lane, gqa); ld8f(A->in[I_BKVN] + l * 256 + 8 * (lane & 31), gkv);
    ld8f(A->in[I_CQN] + l * 128 + 8 * (lane & 15), gcq); ld8f(A->in[I_CKN] + l * 128 + 8 * (lane & 15), gck);
    u32x4 zc[8], zn[8];
    if (F.gw < M) {
#pragma unroll
        for (int q = 0; q < 8; ++q) zc[q] = __builtin_nontemporal_load((const u32x4*)(Z + (size_t)F.gw * NZ + 8 * lane + 512 * q)); }
    for (int row = F.gw; row < M; row += F.NGW) {
        { const int nrow = row + F.NGW;
          if (nrow < M) {
#pragma unroll
              for (int q = 0; q < 8; ++q) zn[q] = __builtin_nontemporal_load((const u32x4*)(Z + (size_t)nrow * NZ + 8 * lane + 512 * q)); } }
        const bool samp = row >= MP; int b, t, pos;
        if (!samp) { b = row >> 14; t = row & (SEQ - 1); pos = t; } else { const int r = row - MP; b = r >> 4; t = r & 15; pos = PAST + t; }
        const size_t kvrow = samp ? (size_t)MP + b * SROWS + PAST + t : (size_t)row;
        const size_t ccrow = samp ? (size_t)MP + b * CROWS + CPAST + t : (size_t)row;
        float* o_ak = F.out + (samp ? OUT_AK_S + ((size_t)l * MS + (row - MP)) * 512 : OUT_AK_P + ((size_t)l * MP + row) * 512) + 8 * lane;
        float* o_av = F.out + (samp ? OUT_AV_S + ((size_t)l * MS + (row - MP)) * 512 : OUT_AV_P + ((size_t)l * MP + row) * 512) + 8 * lane;
        float* o_bc = F.out + (samp ? OUT_BC_S + ((size_t)l * MS + (row - MP)) * 256 : OUT_BC_P + ((size_t)l * MP + row) * 256) + 8 * (lane & 31);
        float* o_bp = F.out + (samp ? OUT_BP_S + ((size_t)l * MS + (row - MP)) * 64 : OUT_BP_P + ((size_t)l * MP + row) * 64) + 8 * (lane & 7);
        const bool cout = samp || t >= SEQ - 512;
        float* o_ck = F.out + (samp ? OUT_CK_S + ((size_t)l * MS + (row - MP)) * 512 : OUT_CK_P + (((size_t)l * NBATCH + b) * 512 + (t - (SEQ - 512))) * 512) + 8 * lane;
        float* o_cv = F.out + (samp ? OUT_CV_S + ((size_t)l * MS + (row - MP)) * 512 : OUT_CV_P + (((size_t)l * NBATCH + b) * 512 + (t - (SEQ - 512))) * 512) + 8 * lane;
        float cs, sn; rope_cs(pos, inv, cs, sn);
        float v[8], y[8];
#pragma unroll
        for (int seg = 0; seg < 2; ++seg) {
            unpack8(zc[seg], v);
            float ss = sumsq8(v); ss += __shfl_xor(ss, 1); ss += __shfl_xor(ss, 2); ss += __shfl_xor(ss, 4);
            const float rstd = rsqrtf(ss * (1.f / 64) + EPS);
#pragma unroll
            for (int e = 0; e < 8; ++e) y[e] = v[e] * rstd * (seg == 0 ? gq[e] : gk[e]);
#pragma unroll
            for (int e = 0; e < 8; ++e) { const float part = __shfl_xor(y[e], 1), c = __shfl(cs, 4 * e), s = __shfl(sn, 4 * e);
                if ((lane & 7) == 0) y[e] = y[e] * c - part * s; else if ((lane & 7) == 1) y[e] = y[e] * c + part * s; }
            if (seg == 0) { float yq[8];
#pragma unroll
                for (int e = 0; e < 8; ++e) yq[e] = y[e] * att::Cn<64>::C;
                *(u32x4*)(QA + (size_t)row * 512 + 8 * lane) = pack8(yq); }
            else { *(u32x4*)(KA + kvrow * 512 + 8 * lane) = pack8(y); st8f_nt(o_ak, y); }
        }
        { const u32x4 w = zc[2]; *(u32x4*)(VA + kvrow * 512 + 8 * lane) = w; unpack8(w, v); st8f_nt(o_av, v); }
        { unpack8(zc[3], v); const float rstd = rsqrtf(wave_sum(sumsq8(v)) * (1.f / 512) + EPS);
#pragma unroll
          for (int e = 0; e < 8; ++e) y[e] = v[e] * rstd * gqa[e];
          *(u32x4*)(CQ + (size_t)row * 512 + 8 * lane) = pack8(y); }
        { unpack8(zc[4], v);
          float ss = sumsq8(v); ss += __shfl_xor(ss, 1); ss += __shfl_xor(ss, 2); ss += __shfl_xor(ss, 4); ss += __shfl_xor(ss, 8); ss += __shfl_xor(ss, 16);
          const float rstd = rsqrtf(ss * (1.f / 256) + EPS);
          const int i = lane & 7;
#pragma unroll
          for (int e = 0; e < 8; ++e) { const float part = __shfl_xor(v[e], 4); const int fi = 8 * (i & 3) + e; const float c = __shfl(cs, fi), s = __shfl(sn, fi);
              y[e] = (lane < 32) ? v[e] * rstd * gkv[e] : ((i < 4) ? v[e] * c - part * s : v[e] * c + part * s); }
          if (lane < 32) { *(u32x4*)(CKV + kvrow * 256 + 8 * lane) = pack8(y); st8f_nt(o_bc, y); }
          else if (lane < 40) { st8f(KPE + kvrow * 64 + 8 * i, y); st8f_nt(o_bp, y); } }
#pragma unroll
        for (int seg = 0; seg < 2; ++seg) {
            unpack8(zc[5 + seg], v);
            float ss = sumsq8(v); ss += __shfl_xor(ss, 1); ss += __shfl_xor(ss, 2); ss += __shfl_xor(ss, 4); ss += __shfl_xor(ss, 8);
            const float rstd = rsqrtf(ss * (1.f / 128) + EPS);
#pragma unroll
            for (int e = 0; e < 8; ++e) y[e] = v[e] * rstd * (seg == 0 ? gcq[e] * att::Cn<128>::C : gck[e]);
            if (seg == 0) *(u32x4*)(QC + (size_t)row * 512 + 8 * lane) = pack8(y);
            else { *(u32x4*)(KC + ccrow * 512 + 8 * lane) = pack8(y); if (cout) st8f_nt(o_ck, y); }
        }
        { const u32x4 w = zc[7]; *(u32x4*)(VC + ccrow * 512 + 8 * lane) = w; if (cout) { unpack8(w, v); st8f_nt(o_cv, v); } }
#pragma unroll
        for (int q = 0; q < 8; ++q) zc[q] = zn[q];
    }
}

__device__ __forceinline__ void phase_post_b(const Frame& F, ArgsP A, int l) {
    unsigned char* ws = F.ws; const int lane = F.lane, h = lane >> 3, i = lane & 7;
    const bf16* QBR = (const bf16*)(ws + WS_R2); const bf16* KVR = (const bf16*)(ws + WS_R1); const float* KPE = (const float*)(ws + WS_KPE);
    bf16* QB = (bf16*)(ws + WS_QB); bf16* KB = (bf16*)(ws + WS_R3);
    const float inv = rope_inv(lane);
    float g0[8], g1[8], g2[8];
    ld8f(A->in[I_BQN] + l * 192 + 8 * i, g0); ld8f(A->in[I_BQN] + l * 192 + 64 + 8 * i, g1); ld8f(A->in[I_BQN] + l * 192 + 128 + 8 * i, g2);
    constexpr int RU = 4;
    for (int row0 = F.gw; row0 < M; row0 += RU * F.NGW) {
        u32x4 w0[RU], w1[RU], w2[RU];
#pragma unroll
        for (int u = 0; u < RU; ++u) { const int row = row0 + u * F.NGW;
            if (row < M) { const bf16* src = QBR + (size_t)row * 1536 + 192 * h + 8 * i; w0[u] = *(const u32x4*)src; w1[u] = *(const u32x4*)(src + 64); w2[u] = *(const u32x4*)(src + 128); } }
#pragma unroll
        for (int u = 0; u < RU; ++u) { const int row = row0 + u * F.NGW;
            if (row < M) {
                const int pos = row < MP ? (row & (SEQ - 1)) : PAST + ((row - MP) & 15);
                float cs, sn; rope_cs(pos, inv, cs, sn);
                float v0[8], v1[8], v2[8]; unpack8(w0[u], v0); unpack8(w1[u], v1); unpack8(w2[u], v2);
#pragma unroll
                for (int e = 0; e < 8; ++e) { const float part = __shfl_xor(v2[e], 4); const int fi = 8 * (i & 3) + e; const float c = __shfl(cs, fi), s = __shfl(sn, fi);
                    v2[e] = (i < 4) ? v2[e] * c - part * s : v2[e] * c + part * s; }
                float ss = sumsq8(v0) + sumsq8(v1) + sumsq8(v2); ss += __shfl_xor(ss, 1); ss += __shfl_xor(ss, 2); ss += __shfl_xor(ss, 4);
                const float rstd = rsqrtf(ss * (1.f / 192) + EPS);
#pragma unroll
                for (int e = 0; e < 8; ++e) { v0[e] *= rstd * g0[e] * att::Cn<192>::C; v1[e] *= rstd * g1[e] * att::Cn<192>::C; v2[e] *= rstd * g2[e] * att::Cn<192>::C; }
                bf16* dst = QB + (size_t)row * 1536 + 192 * h + 8 * i;
                *(u32x4*)dst = pack8(v0); *(u32x4*)(dst + 64) = pack8(v1); *(u32x4*)(dst + 128) = pack8(v2); } }
    }
    ld8f(A->in[I_BKN] + l * 192 + 8 * i, g0); ld8f(A->in[I_BKN] + l * 192 + 64 + 8 * i, g1); ld8f(A->in[I_BKN] + l * 192 + 128 + 8 * i, g2);
    for (int row0 = F.gw; row0 < M2; row0 += RU * F.NGW) {
        u32x4 w0[RU], w1[RU]; f32x4 p0[RU], p1[RU];
#pragma unroll
        for (int u = 0; u < RU; ++u) { const int row = row0 + u * F.NGW;
            if (row < M2) { const bf16* src = KVR + (size_t)row * 2048 + 256 * h + 8 * i; w0[u] = *(const u32x4*)src; w1[u] = *(const u32x4*)(src + 64);
                const float* kp = KPE + (size_t)row * 64 + 8 * i; p0[u] = *(const f32x4*)kp; p1[u] = *(const f32x4*)(kp + 4); } }
#pragma unroll
        for (int u = 0; u < RU; ++u) { const int row = row0 + u * F.NGW;
            if (row < M2) {
                float v0[8], v1[8], v2[8]; unpack8(w0[u], v0); unpack8(w1[u], v1);
                v2[0] = p0[u].x; v2[1] = p0[u].y; v2[2] = p0[u].z; v2[3] = p0[u].w; v2[4] = p1[u].x; v2[5] = p1[u].y; v2[6] = p1[u].z; v2[7] = p1[u].w;
                float ss = sumsq8(v0) + sumsq8(v1) + sumsq8(v2); ss += __shfl_xor(ss, 1); ss += __shfl_xor(ss, 2); ss += __shfl_xor(ss, 4);
                const float rstd = rsqrtf(ss * (1.f / 192) + EPS);
#pragma unroll
                for (int e = 0; e < 8; ++e) { v0[e] *= rstd * g0[e]; v1[e] *= rstd * g1[e]; v2[e] *= rstd * g2[e]; }
                bf16* dst = KB + (size_t)row * 1536 + 192 * h + 8 * i;
                *(u32x4*)dst = pack8(v0); *(u32x4*)(dst + 64) = pack8(v1); *(u32x4*)(dst + 128) = pack8(v2); } }
    }
}

__device__ __forceinline__ void phase_post_a(const Frame& F, ArgsP A, int l) {
    unsigned char* ws = F.ws; const int lane = F.lane, h = lane >> 4, i = lane & 15;
    const float* OAR = (const float*)(ws + WS_R2); bf16* OA = (bf16*)(ws + WS_OALL);
    const float* lf = A->in[I_ALAM] + l * 256;
    const float s1 = wave_sum(lf[lane] * lf[64 + lane]), s2 = wave_sum(lf[128 + lane] * lf[192 + lane]);
    const float lam_init = 0.8f - 0.6f * expf(-0.3f * (float)l);
    const float lam = expf(s1) - expf(s2) + lam_init, og = 1.f - lam_init;
    float g[8]; ld8f(A->in[I_ASUB] + l * 128 + 8 * i, g);
    constexpr int RU = 4;
    for (int row0 = F.gw; row0 < M; row0 += RU * F.NGW) {
        f32x4 a0[RU], a1[RU], b0[RU], b1[RU];
#pragma unroll
        for (int u = 0; u < RU; ++u) { const int row = row0 + u * F.NGW;
            if (row < M) { const float* src = OAR + (size_t)row * 1024 + 256 * h + 8 * i; a0[u] = *(const f32x4*)src; a1[u] = *(const f32x4*)(src + 4); b0[u] = *(const f32x4*)(src + 128); b1[u] = *(const f32x4*)(src + 132); } }
#pragma unroll
        for (int u = 0; u < RU; ++u) { const int row = row0 + u * F.NGW;
            if (row < M) {
                float d[8];
                d[0] = a0[u].x - lam * b0[u].x; d[1] = a0[u].y - lam * b0[u].y; d[2] = a0[u].z - lam * b0[u].z; d[3] = a0[u].w - lam * b0[u].w;
                d[4] = a1[u].x - lam * b1[u].x; d[5] = a1[u].y - lam * b1[u].y; d[6] = a1[u].z - lam * b1[u].z; d[7] = a1[u].w - lam * b1[u].w;
                float ss = sumsq8(d); ss += __shfl_xor(ss, 1); ss += __shfl_xor(ss, 2); ss += __shfl_xor(ss, 4); ss += __shfl_xor(ss, 8);
                const float rstd = rsqrtf(ss * (1.f / 128) + EPS) * og;
#pragma unroll
                for (int e = 0; e < 8; ++e) d[e] *= rstd * g[e];
                *(u32x4*)(OA + (size_t)row * 2048 + 128 * h + 8 * i) = pack8(d); } }
    }
}

__device__ __forceinline__ float wave_absmax(const float* g, int n, int lane) {
    float m = 0.f;
    for (int i = lane; i < n; i += 64) m = fmaxf(m, fabsf(g[i]));
#pragma unroll
    for (int o = 1; o < 64; o <<= 1) m = fmaxf(m, __shfl_xor(m, o));
    return __uint_as_float(__builtin_amdgcn_readfirstlane(__float_as_uint(m)));
}
__device__ __forceinline__ void phase_attn(const Frame& F, ArgsP A, int l) {
    unsigned char* ws = F.ws; LAS char* lds = (LAS char*)F.lds;
    const bf16* QA = (const bf16*)(ws + WS_QA); const bf16* KA = (const bf16*)(ws + WS_KA); const bf16* VA = (const bf16*)(ws + WS_VA);
    const bf16* QB = (const bf16*)(ws + WS_QB); const bf16* KB = (const bf16*)(ws + WS_R3); const bf16* KVR = (const bf16*)(ws + WS_R1);
    const bf16* QC = (const bf16*)(ws + WS_QC); const bf16* KC = (const bf16*)(ws + WS_KC); const bf16* VC = (const bf16*)(ws + WS_VC);
    float* OAR = (float*)(ws + WS_R2); bf16* OB = (bf16*)(ws + WS_OALL) + 512; bf16* OC = (bf16*)(ws + WS_OALL) + 1536;
    const float negB_A = -1.4426950408889634f * 1.02f * 8.f * wave_absmax(A->in[I_AQN] + l * 64, 64, F.lane) * wave_absmax(A->in[I_AKN] + l * 64, 64, F.lane);
    const float negB_B = -1.4426950408889634f * 1.02f * 13.856406460551018f * wave_absmax(A->in[I_BQN] + l * 192, 192, F.lane) * wave_absmax(A->in[I_BKN] + l * 192, 192, F.lane);
    const float negB_C = -1.4426950408889634f * (1.02f * 11.313708498984761f * wave_absmax(A->in[I_CQN] + l * 128, 128, F.lane) * wave_absmax(A->in[I_CKN] + l * 128, 128, F.lane)
                                                + wave_absmax(A->in[I_CBIAS] + (size_t)l * 4 * 257, 4 * 257, F.lane));
#ifndef ATTM
#define ATTM 7
#endif
    if (ATTM & 1) for (int n = F.vcu; n < 1024 + 128; n += F.G) {
        att::UnitP P; P.ldq = 512; P.ldk = 512; P.ldv = 512; P.ldo = 1024; P.qpos0 = 0; P.kpos0 = 0; P.tab = nullptr; P.lo_base = 0; P.lo_step = 0;
        if (n < 1024) { const int v = n & 255, slot = n >> 8, x = v >> 5, j = v & 31, combo = 2 * x + (slot >> 1), b = combo >> 3, vh = combo & 7, i = (slot & 1) ? j : 63 - j;
            const size_t qrow = (size_t)b * SEQ + 256 * i, krow = (size_t)b * SEQ;
            P.Q = QA + qrow * 512 + 64 * vh; P.nq = 256; P.K = KA + krow * 512 + 64 * vh; P.V = VA + krow * 512 + 128 * (vh >> 1); P.O = OAR + qrow * 1024 + 128 * vh;
            P.NT = 4 * i + 4; P.kvalid = P.NT * 64; P.hi_base = 4 * i; P.hi_step = 1; P.fix_lo = 0; P.fix_hi = P.NT - 3;
        } else { const int s = n - 1024, b = s >> 3, vh = s & 7; const size_t qrow = (size_t)MP + 16 * b, krow = (size_t)MP + (size_t)b * SROWS;
            P.Q = QA + qrow * 512 + 64 * vh; P.nq = 16; P.K = KA + krow * 512 + 64 * vh; P.V = VA + krow * 512 + 128 * (vh >> 1); P.O = OAR + qrow * 1024 + 128 * vh;
            P.NT = SROWS / 64; P.kvalid = PAST + DECS; P.hi_base = SROWS / 64; P.hi_step = 0; P.fix_lo = 0; P.fix_hi = (PAST + DECS) / 64; }
        P.negB = negB_A; att::attn_unit<64, true, false, false>(P, lds);
    }
    if (ATTM & 2) for (int n = F.vcu; n < 1024 + 256; n += F.G) {
        att::UnitP P; P.ldq = 1536; P.ldk = 1536; P.ldv = 2048; P.ldo = 2048; P.qpos0 = 0; P.kpos0 = 0; P.tab = nullptr; P.lo_base = 0; P.lo_step = 0;
        if (n < 1024) { const int v = n & 255, slot = n >> 8, x = v >> 5, j = v & 31, combo = 2 * x + (slot >> 1), b = combo >> 3, hh = combo & 7, i = (slot & 1) ? j : 63 - j;
            const size_t qrow = (size_t)b * SEQ + 256 * i, krow = (size_t)b * SEQ;
            P.Q = QB + qrow * 1536 + 192 * hh; P.nq = 256; P.K = KB + krow * 1536 + 192 * hh; P.V = KVR + krow * 2048 + 256 * hh + 128; P.O = OB + qrow * 2048 + 128 * hh;
            P.NT = 4 * i + 4; P.kvalid = P.NT * 64; P.hi_base = 4 * i; P.hi_step = 1; P.fix_lo = 0; P.fix_hi = P.NT - 3;
        } else { const int s = n - 1024 - 128; if (s < 0) continue; const int b = s >> 3, hh = s & 7; const size_t qrow = (size_t)MP + 16 * b, krow = (size_t)MP + (size_t)b * SROWS;
            P.Q = QB + qrow * 1536 + 192 * hh; P.nq = 16; P.K = KB + krow * 1536 + 192 * hh; P.V = KVR + krow * 2048 + 256 * hh + 128; P.O = OB + qrow * 2048 + 128 * hh;
            P.NT = SROWS / 64; P.kvalid = PAST + DECS; P.hi_base = SROWS / 64; P.hi_step = 0; P.fix_lo = 0; P.fix_hi = (PAST + DECS) / 64; }
        P.negB = negB_B; att::attn_unit<192, false, false, false>(P, lds);
    }
    if (ATTM & 4) for (int n = F.vcu; n < 512 + 64; n += F.G) {
        att::UnitP P; P.ldq = 512; P.ldk = 512; P.ldv = 512; P.ldo = 2048;
        if (n < 512) { const int v = n & 255, slot = n >> 8, x = v >> 5, j = v & 31, b = x >> 2, hh = x & 3, i = j + 32 * slot, c0 = 4 * i, T0 = c0 >= 8 ? c0 - 8 : 0;
            const size_t qrow = (size_t)b * SEQ + 256 * i, krow = (size_t)b * SEQ + 64 * T0;
            P.Q = QC + qrow * 512 + 128 * hh; P.nq = 256; P.K = KC + krow * 512 + 128 * hh; P.V = VC + krow * 512 + 128 * hh; P.O = OC + qrow * 2048 + 128 * hh;
            P.NT = c0 + 4 - T0; P.kvalid = P.NT * 64; P.hi_base = c0 - T0; P.hi_step = 1; P.lo_base = c0 - 8 - T0; P.lo_step = 1; P.qpos0 = 256 * i; P.kpos0 = 64 * T0; P.fix_lo = 3; P.fix_hi = P.NT - 3;
            P.tab = A->in[I_CBIAS] + ((size_t)l * 4 + hh) * 257;
        } else { const int s = n - 512, b = s >> 2, hh = s & 3; const size_t qrow = (size_t)MP + 16 * b, krow = (size_t)MP + (size_t)b * CROWS;
            P.Q = QC + qrow * 512 + 128 * hh; P.nq = 16; P.K = KC + krow * 512 + 128 * hh; P.V = VC + krow * 512 + 128 * hh; P.O = OC + qrow * 2048 + 128 * hh;
            P.NT = CROWS / 64; P.kvalid = CPAST + DECS; P.hi_base = CROWS / 64; P.hi_step = 0; P.lo_base = 0; P.lo_step = 0; P.qpos0 = PAST; P.kpos0 = PAST - CPAST; P.fix_lo = 0; P.fix_hi = (CPAST + DECS) / 64;
            P.tab = A->in[I_CBIAS] + ((size_t)l * 4 + hh) * 257; }
        P.negB = negB_C; att::attn_unit<128, false, true, false>(P, lds);
    }
}

constexpr int NPH = 12, NPHASES = NPH * DEPTH + 1;

template <int l>
__device__ __forceinline__ void layer_body(Frame& F, LAS unsigned char* lds0, volatile LAS unsigned* MISC, const int lo, const int hi) {
#ifndef PHM
#define PHM 0xfff
#endif
#define IN(k) (((PHM >> ((k) % NPH)) & 1) && lo <= (k) && (k) < hi)
#define SEAM(k) do { if (IN(k) && IN((k) + 1)) { XcdBarrier b2; b2.bar = (unsigned*)(fresh_args()->ws + WS_CTL) + CW_BAR; b2.x = xb_xcc_id(); b2.st = MISC + 8; xcd_barrier(b2); } } while (0)
    bf16 *H, *Zb, *GT, *U; float* X;
#define FRESH() do { Ap = fresh_args(); F.tid = fresh_tid(); F.lane = F.tid & 63; F.wave = __builtin_amdgcn_readfirstlane(F.tid >> 6); \
    { int bx_ = blockIdx.x, G_ = gridDim.x; asm volatile("" : "+s"(bx_), "+s"(G_)); F.bx = bx_; F.G = G_; F.vcu = (G_ % 8 == 0) ? (bx_ % 8) * (G_ / 8) + bx_ / 8 : bx_; F.gw = F.vcu * 8 + F.wave; F.NGW = G_ * 8; } \
    { unsigned lb_ = 0; asm volatile("" : "+s"(lb_)); F.lds = lds0 + lb_; } \
    F.ws = Ap->ws; F.out = Ap->out; ws = F.ws; H = (bf16*)(ws + WS_R3); Zb = (bf16*)(ws + WS_R1); GT = (bf16*)(ws + WS_GATES); U = (bf16*)(ws + WS_R1); X = F.out + OUT_Y; } while (0)
    ArgsP Ap; unsigned char* ws;
    constexpr size_t WSET = (l & 1) ? WS_WSET1 : 0, WSET_NEXT = (l & 1) ? 0 : WS_WSET1;
        const int pb = NPH * l;
        if (IN(pb + 0)) { FRESH(); phase_pre(F, Ap, l); } SEAM(pb + 0);
        if (IN(pb + 1)) {
            FRESH(); ArgsP A = Ap;
            pg8::Gemm g{H, (const bf16*)(ws + WSET + WS_WIN), M, NIN, DM, DM, DM}; pg8::StaticOrder S; S.init(M, NIN, DM, F.G, F.bx, 4);
            pg8::EpiIn E{Zb, GT, A->in[I_BGATE] + (size_t)l * NGATE, F.lds + EPI_OFF};
            pg8::gemm_phase(F.lds, g, S, E);
            if (l + 1 < DEPTH) { const int nlast = ((M / 256) * (NIN / 256)) % F.G;
                if (nlast != 0 && F.bx >= nlast) pre_weights(F, Ap, l + 1, ws + WSET_NEXT, (F.bx - nlast) * 8 + F.wave, (F.G - nlast) * 8, 0, WCUT1); }
        } SEAM(pb + 1);
        if (IN(pb + 2)) { FRESH(); phase_post_in(F, Ap, l); } SEAM(pb + 2);
        if (IN(pb + 3)) {
            FRESH();
#pragma unroll 1
            for (int gi = 0; gi < 2; ++gi) {
                const bf16* Ain = (const bf16*)(ws + (gi == 0 ? WS_CQ : WS_CKV)); const bf16* Bt = (const bf16*)(ws + WSET + (gi == 0 ? WS_WQB : WS_WKVB));
                const int Mg = gi == 0 ? M : M2, Ng = gi == 0 ? 1536 : 2048, Kg = gi == 0 ? 512 : 256;
                pg8::Gemm g{Ain, Bt, Mg, Ng, Kg, Kg, Kg}; pg8::StaticOrder S; S.init(Mg, Ng, Kg, F.G, F.bx);
                pg8::EpiPlain E{(bf16*)(ws + (gi == 0 ? WS_R2 : WS_R1)), Ng, F.lds + EPI_OFF}; pg8::gemm_phase(F.lds, g, S, E);
            }
        } SEAM(pb + 3);
        if (IN(pb + 4)) { FRESH(); phase_post_b(F, Ap, l); } SEAM(pb + 4);
        if (IN(pb + 5)) { FRESH(); phase_attn(F, Ap, l); } SEAM(pb + 5);
        if (IN(pb + 6)) { FRESH(); phase_post_a(F, Ap, l); } SEAM(pb + 6);
        if (IN(pb + 7)) {
            FRESH();
            pg8::Gemm g{(const bf16*)(ws + WS_OALL), (const bf16*)(ws + WSET + WS_WBR), M, DM, DM, DM, DM}; pg8::StaticOrder S; S.init(M, DM, DM, F.G, F.bx, 4);
            pg8::EpiMerge E{GT, H, F.lds + EPI_OFF}; pg8::gemm_phase(F.lds, g, S, E);
            if (l + 1 < DEPTH) { const int nlast = ((M / 256) * (DM / 256)) % F.G;
                if (nlast != 0 && F.bx >= nlast) pre_caches(F, Ap, l + 1, (F.bx - nlast) * 8 + F.wave, (F.G - nlast) * 8); else if (nlast == 0) pre_caches(F, Ap, l + 1, F.gw, F.NGW); }
        } SEAM(pb + 7);
        if (IN(pb + 8)) {
            FRESH();
            { pg8::Gemm g{H, (const bf16*)(ws + WSET + WS_WO), M, DM, DM, DM, DM}; pg8::CombinedOrder S; S.init(MP, DM, DM, NS_O, F.G, F.bx);
              pg8::EpiResidSplit E{X, (float*)(ws + WS_SLAB_O), MP / 256, DM / NS_O, F.lds + EPI_OFF}; pg8::gemm_phase(F.lds, g, S, E); }
        } SEAM(pb + 8);
        if (IN(pb + 9)) { FRESH(); rmsnorm_rows(F, Ap, Ap->in[I_MNORM] + (size_t)l * DM, H, false, (const float*)(ws + WS_SLAB_O), NS_O); } SEAM(pb + 9);
        if (IN(pb + 10)) {
            FRESH();
            pg8::Gemm g{H, (const bf16*)(ws + WSET + WS_WUP), M, DFF, DM, DM, DM}; pg8::StaticOrder S; S.init(M, DFF, DM, F.G, F.bx, 4);
            pg8::EpiUp E{U, F.lds + EPI_OFF}; pg8::gemm_phase(F.lds, g, S, E);
            if (l + 1 < DEPTH) { const int nlast = ((M / 256) * (DFF / 256)) % F.G;
                if (nlast != 0 && F.bx >= nlast) pre_weights(F, Ap, l + 1, ws + WSET_NEXT, (F.bx - nlast) * 8 + F.wave, (F.G - nlast) * 8, WCUT1, WCUT2); }
        } SEAM(pb + 10);
        if (IN(pb + 11)) {
            FRESH();
            { pg8::Gemm g{U, (const bf16*)(ws + WSET + WS_WDN), M, DM, DFF, DFF, DFF}; pg8::CombinedOrder S; S.init(MP, DM, DFF, NS_DN, F.G, F.bx);
              pg8::EpiResidSplit E{X, (float*)(ws + WS_SLAB_DN), MP / 256, DFF / NS_DN, F.lds + EPI_OFF}; pg8::gemm_phase(F.lds, g, S, E); }
            if (l + 1 < DEPTH) { const int n1 = ((M / 256) * (NIN / 256)) % F.G, n2 = ((M / 256) * (DFF / 256)) % F.G;
                pre_weights(F, Ap, l + 1, ws + WSET_NEXT, F.gw, F.NGW, n1 != 0 ? (n2 != 0 ? WCUT2 : WCUT1) : 0, 1 << 30); }
        } SEAM(pb + 11);
    #undef IN
#undef SEAM
#undef FRESH
}

__global__ void __launch_bounds__(512, 2) fwd(Args args) {
    extern __shared__ __attribute__((aligned(16))) unsigned char lds_raw[];
    Frame F;
    F.lds = (LAS unsigned char*)lds_raw;
    F.tid = threadIdx.x; F.lane = F.tid & 63; F.wave = __builtin_amdgcn_readfirstlane(F.tid >> 6);
    F.G = gridDim.x; { const int bx = blockIdx.x; F.vcu = (F.G % 8 == 0) ? (bx % 8) * (F.G / 8) + bx / 8 : bx; }
    F.gw = F.vcu * 8 + F.wave; F.NGW = F.G * 8;
    F.out = args.out; F.ws = args.ws;
    unsigned char* ws = args.ws;
    volatile LAS unsigned* MISC = (volatile LAS unsigned*)(F.lds + MISC_OFF);
    for (int u = F.tid; u < (LDS_BYTES - LDSCTL_OFF) / 4; u += 512) ((LAS unsigned*)(F.lds + LDSCTL_OFF))[u] = 0u;
    __syncthreads();
    XcdBarrier bar; bar.bar = (unsigned*)(ws + WS_CTL) + CW_BAR; bar.x = 0; bar.st = nullptr;
    if (args.use_bar) bar = xcd_barrier_post((unsigned*)(ws + WS_CTL) + CW_BAR, MISC + 8);
    const int lo = args.ph_lo, hi = args.ph_hi;
    layer_body<0>(F, (LAS unsigned char*)lds_raw, MISC, lo, hi);
    layer_body<1>(F, (LAS unsigned char*)lds_raw, MISC, lo, hi);
    layer_body<2>(F, (LAS unsigned char*)lds_raw, MISC, lo, hi);
    layer_body<3>(F, (LAS unsigned char*)lds_raw, MISC, lo, hi);
    if (lo <= NPH * DEPTH && NPH * DEPTH < hi) {
        ArgsP Ap = fresh_args(); F.tid = fresh_tid(); F.lane = F.tid & 63; F.ws = Ap->ws; F.out = Ap->out;
        final_combine(F, (const float*)(F.ws + WS_SLAB_DN), NS_DN);
    }
}

extern "C" void kernel_launch(void* const* d_in, const int* in_sizes, int n_in, void* d_out, int out_size, void* d_ws, size_t ws_size, hipStream_t stream) {
    static int grid = 0;
    if (grid == 0) {
        if (n_in != 31 || (size_t)out_size != OUT_END || ws_size < WS_END) { fprintf(stderr, "kernel_launch: shape mismatch (n_in %d, out %d, ws %zu)\n", n_in, out_size, ws_size); grid = -1; return; }
        int dev = 0, cus = 0;
        if (hipGetDevice(&dev) != hipSuccess || hipDeviceGetAttribute(&cus, hipDeviceAttributeMultiprocessorCount, dev) != hipSuccess) { grid = -1; return; }
        if (hipFuncSetAttribute((const void*)fwd, hipFuncAttributeMaxDynamicSharedMemorySize, LDS_BYTES) != hipSuccess) { fprintf(stderr, "kernel_launch: hipFuncSetAttribute failed\n"); grid = -1; return; }
        int per_cu = 0;
        if (hipOccupancyMaxActiveBlocksPerMultiprocessor(&per_cu, (const void*)fwd, 512, LDS_BYTES) != hipSuccess || per_cu < 1) fprintf(stderr, "kernel_launch: occupancy query reports %d\n", per_cu);
        (void)hipGetLastError();
        grid = cus;
    }
    if (grid < 0) return;
    (void)hipMemsetAsync((char*)d_ws + WS_CTL, 0, CTL_ZERO_BYTES, stream);
    Args a{};
    for (int i = 0; i < 31; ++i) a.in[i] = (const float*)d_in[i];
    a.out = (float*)d_out; a.ws = (unsigned char*)d_ws; a.pad = 0;
#if MK_SPLIT
    for (int p = 0; p < NPHASES; ++p) { a.ph_lo = p; a.ph_hi = p + 1; a.use_bar = 0; hipLaunchKernelGGL(fwd, dim3(grid), dim3(512), LDS_BYTES, stream, a); }
#else
    a.ph_lo = 0; a.ph_hi = NPHASES; a.use_bar = 1; hipLaunchKernelGGL(fwd, dim3(grid), dim3(512), LDS_BYTES, stream, a);
#endif
}
```

```cpp
#include <hip/hip_runtime.h>
#include <cstdio>
#include <cstdint>
#include <cmath>

#ifndef MK_SPLIT
#define MK_SPLIT 0
#endif

#define GAS __attribute__((address_space(1)))
#define LAS __attribute__((address_space(3)))
typedef unsigned short bf16;
typedef short bf16x8 __attribute__((ext_vector_type(8)));
typedef short s16x4 __attribute__((ext_vector_type(4)));
typedef float f32x4 __attribute__((ext_vector_type(4)));
typedef float f32x16 __attribute__((ext_vector_type(16)));
typedef unsigned u32x4 __attribute__((ext_vector_type(4)));
typedef unsigned u32x2 __attribute__((ext_vector_type(2)));

constexpr int DM = 2048, SEQ = 16384, NBATCH = 2, DEPTH = 4, DECB = 16, DECS = 16, PAST = 2048;
constexpr int MP = NBATCH * SEQ, MS = DECB * DECS, M = MP + MS;
constexpr int SROWS = 2176, CROWS = 640, CPAST = 512;
constexpr int M2 = MP + DECB * SROWS;
constexpr int MC = MP + DECB * CROWS;
constexpr int NIN = 10240, NZ = 4096, NGATE = 6144, DFF = 8192, INCOLS = 10048;
constexpr float EPS = 1e-6f;
static_assert(M % 256 == 0 && M2 % 256 == 0, "row counts are whole 256-row panels");

constexpr size_t OUT_Y = 0;
constexpr size_t OUT_AK_P = OUT_Y + (size_t)M * DM;
constexpr size_t OUT_AV_P = OUT_AK_P + (size_t)DEPTH * MP * 512;
constexpr size_t OUT_BC_P = OUT_AV_P + (size_t)DEPTH * MP * 512;
constexpr size_t OUT_BP_P = OUT_BC_P + (size_t)DEPTH * MP * 256;
constexpr size_t OUT_CK_P = OUT_BP_P + (size_t)DEPTH * MP * 64;
constexpr size_t OUT_CV_P = OUT_CK_P + (size_t)DEPTH * NBATCH * 512 * 512;
constexpr size_t OUT_AK_S = OUT_CV_P + (size_t)DEPTH * NBATCH * 512 * 512;
constexpr size_t OUT_AV_S = OUT_AK_S + (size_t)DEPTH * MS * 512;
constexpr size_t OUT_BC_S = OUT_AV_S + (size_t)DEPTH * MS * 512;
constexpr size_t OUT_BP_S = OUT_BC_S + (size_t)DEPTH * MS * 256;
constexpr size_t OUT_CK_S = OUT_BP_S + (size_t)DEPTH * MS * 64;
constexpr size_t OUT_CV_S = OUT_CK_S + (size_t)DEPTH * MS * 512;
constexpr size_t OUT_END = OUT_CV_S + (size_t)DEPTH * MS * 512;
static_assert(OUT_END == 250413056ull, "output size");

constexpr size_t MiB = 1u << 20;
constexpr size_t WS_CTL = 0, CTL_ZERO_BYTES = 1 * MiB;
constexpr size_t WS_WIN = 1 * MiB;
constexpr size_t WS_WQB = 41 * MiB;
constexpr size_t WS_WKVB = 43 * MiB;
constexpr size_t WS_WBR = 44 * MiB;
constexpr size_t WS_WO = 52 * MiB;
constexpr size_t WS_WUP = 60 * MiB;
constexpr size_t WS_WDN = 92 * MiB;
constexpr size_t WS_R3 = 124 * MiB;
constexpr size_t WS_R1 = 322 * MiB;
constexpr size_t WS_GATES = 586 * MiB;
constexpr size_t WS_QA = 973 * MiB;
constexpr size_t WS_KA = 1006 * MiB;
constexpr size_t WS_VA = 1072 * MiB;
constexpr size_t WS_CQ = 1138 * MiB;
constexpr size_t WS_CKV = 1171 * MiB;
constexpr size_t WS_KPE = 1204 * MiB;
constexpr size_t WS_QC = 1221 * MiB;
constexpr size_t WS_KC = 1254 * MiB;
constexpr size_t WS_VC = 1296 * MiB;
constexpr size_t WS_R2 = 1338 * MiB;
constexpr size_t WS_OALL = 1596 * MiB;
constexpr size_t WS_QB = 1727 * MiB;
constexpr size_t WS_END = 1824 * MiB;
static_assert(WS_WIN + (size_t)NIN * DM * 2 <= WS_WQB && WS_WDN + (size_t)DM * DFF * 2 <= WS_R3, "weights");
static_assert(WS_R3 + (size_t)M2 * 1536 * 2 <= WS_R1 && WS_R1 + (size_t)M2 * 2048 * 2 <= WS_GATES && WS_GATES + (size_t)M * NGATE * 2 <= WS_QA, "R3/R1/gates");
static_assert(WS_R1 + (size_t)M * DFF * 2 <= WS_QA, "u overlay");
static_assert(WS_QA + (size_t)M * 512 * 2 <= WS_KA && WS_KA + (size_t)M2 * 512 * 2 <= WS_VA && WS_VA + (size_t)M2 * 512 * 2 <= WS_CQ, "A");
static_assert(WS_CQ + (size_t)M * 512 * 2 <= WS_CKV && WS_CKV + (size_t)M2 * 256 * 2 <= WS_KPE && WS_KPE + (size_t)M2 * 64 * 4 <= WS_QC, "B");
static_assert(WS_QC + (size_t)M * 512 * 2 <= WS_KC && WS_KC + (size_t)MC * 512 * 2 <= WS_VC && WS_VC + (size_t)MC * 512 * 2 <= WS_R2, "C");
static_assert(WS_R2 + (size_t)M * 2048 * 4 <= WS_OALL && WS_OALL + (size_t)M * 2048 * 2 <= WS_QB && WS_QB + (size_t)M * 1536 * 2 <= WS_END, "tail");

constexpr int CW_BAR = 4096;

constexpr int RING_BYTES = 131072;
constexpr int LDSCTL_OFF = RING_BYTES, MISC_OFF = LDSCTL_OFF + 320;
constexpr int LDS_BYTES = 155648;
constexpr int EPI_OFF = RING_BYTES + 8192;
static_assert(EPI_OFF + 8 * 2048 <= LDS_BYTES, "epilogue staging");

#define LDS_WAIT() asm volatile("s_waitcnt lgkmcnt(0)" ::: "memory")
#define VM_WAIT() asm volatile("s_waitcnt vmcnt(0)" ::: "memory")
#define SBAR() __builtin_amdgcn_sched_barrier(0)
__device__ __forceinline__ int fresh_tid() { int t = threadIdx.x; asm volatile("" : "+v"(t)); return t; }
__device__ __forceinline__ unsigned cvtpk(float lo, float hi) { unsigned r; asm volatile("v_cvt_pk_bf16_f32 %0, %1, %2" : "=v"(r) : "v"(lo), "v"(hi)); return r; }
__device__ __forceinline__ float bf_lo(unsigned u) { return __uint_as_float(u << 16); }
__device__ __forceinline__ float bf_hi(unsigned u) { return __uint_as_float(u & 0xffff0000u); }
__device__ __forceinline__ void unpack8(u32x4 w, float (&v)[8]) { v[0] = bf_lo(w.x); v[1] = bf_hi(w.x); v[2] = bf_lo(w.y); v[3] = bf_hi(w.y); v[4] = bf_lo(w.z); v[5] = bf_hi(w.z); v[6] = bf_lo(w.w); v[7] = bf_hi(w.w); }
__device__ __forceinline__ u32x4 pack8(const float (&v)[8]) { u32x4 w; w.x = cvtpk(v[0], v[1]); w.y = cvtpk(v[2], v[3]); w.z = cvtpk(v[4], v[5]); w.w = cvtpk(v[6], v[7]); return w; }
__device__ __forceinline__ void ld8bf(const bf16* p, float (&v)[8]) { unpack8(*(const u32x4*)p, v); }
__device__ __forceinline__ void ld8f(const float* p, float (&v)[8]) { const f32x4 a = *(const f32x4*)p, b = *(const f32x4*)(p + 4); v[0] = a.x; v[1] = a.y; v[2] = a.z; v[3] = a.w; v[4] = b.x; v[5] = b.y; v[6] = b.z; v[7] = b.w; }
__device__ __forceinline__ void st8f(float* p, const float (&v)[8]) { *(f32x4*)p = (f32x4){v[0], v[1], v[2], v[3]}; *(f32x4*)(p + 4) = (f32x4){v[4], v[5], v[6], v[7]}; }
__device__ __forceinline__ void st8f_nt(float* p, const float (&v)[8]) { __builtin_nontemporal_store((f32x4){v[0], v[1], v[2], v[3]}, (f32x4*)p); __builtin_nontemporal_store((f32x4){v[4], v[5], v[6], v[7]}, (f32x4*)(p + 4)); }
__device__ __forceinline__ float wave_sum(float v) {
#pragma unroll
    for (int o = 1; o < 64; o <<= 1) v += __shfl_xor(v, o);
    return v;
}
__device__ __forceinline__ float sumsq8(const float (&v)[8]) { float s = 0.f;
#pragma unroll
    for (int e = 0; e < 8; ++e) s += v[e] * v[e];
    return s; }

#define XB_TMO      128
#define XB_XCNT(j)  (256  + 64 * (j))
#define XB_XSUB(j)  (1280 + 64 * (j))
#define XB_XGEN(j)  (2304 + 64 * (j))
#define XB_TOP      3328
#define XB_TOPGEN   3392
#define XCD_BAR_WORDS 3456
#define XB_SPIN_CAP (1u << 18)
__device__ __forceinline__ unsigned xb_ld(unsigned* p)              { return __hip_atomic_load(p, __ATOMIC_RELAXED, __HIP_MEMORY_SCOPE_AGENT); }
__device__ __forceinline__ unsigned xb_add(unsigned* p, unsigned v) { return __hip_atomic_fetch_add(p, v, __ATOMIC_RELAXED, __HIP_MEMORY_SCOPE_AGENT); }
__device__ __forceinline__ unsigned xb_xcc_id() { return (unsigned)__builtin_amdgcn_s_getreg((3 << 11) | 20) & 0xFu; }
#define XB_SPIN(cond, bar) do { unsigned _sp = 0; while (cond) { __builtin_amdgcn_s_sleep(1); \
    if ((++_sp & 255u) == 0u) { if (xb_ld(&(bar)[XB_TMO])) break; if (_sp > XB_SPIN_CAP) { atomicAdd(&(bar)[XB_TMO], 1u); break; } } } } while (0)
struct XcdBarrier { unsigned* bar; unsigned x; volatile LAS unsigned* st; };
__device__ __forceinline__ XcdBarrier xcd_barrier_post(unsigned* bar, volatile LAS unsigned* st) {
    XcdBarrier b; b.bar = bar; b.x = xb_xcc_id(); b.st = st;
    if (threadIdx.x == 0) (void)xb_add(&bar[XB_XCNT(b.x)], 1u);
    return b;
}
__device__ __forceinline__ void xcd_barrier_complete(unsigned* bar, unsigned x, unsigned& nloc, unsigned& nx) {
    const unsigned G = gridDim.x * gridDim.y * gridDim.z;
    unsigned sum, cnt, mine, sp = 0u;
    for (;;) {
        sum = 0u; cnt = 0u; mine = 0u;
#pragma unroll
        for (unsigned j = 0; j < 16; ++j) { const unsigned c = xb_ld(&bar[XB_XCNT(j)]); sum += c; cnt += (c > 0u) ? 1u : 0u; mine = (j == x) ? c : mine; }
        if (sum == G) break;
        __builtin_amdgcn_s_sleep(1);
        if ((++sp & 255u) == 0u) { if (xb_ld(&bar[XB_TMO])) break; if (sp > XB_SPIN_CAP) { atomicAdd(&bar[XB_TMO], 1u); break; } }
    }
    nloc = mine > 0u ? mine : 1u; nx = cnt > 0u ? cnt : 1u;
}
__device__ __forceinline__ void xcd_barrier(const XcdBarrier& b) {
    asm volatile("s_waitcnt vmcnt(0)" ::: "memory");
    __syncthreads();
    if (threadIdx.x == 0) {
        unsigned* bar = b.bar;
        __builtin_amdgcn_s_waitcnt(0);
        unsigned nloc = b.st[0], nx = b.st[1];
        if (nloc == 0u) { xcd_barrier_complete(bar, b.x, nloc, nx); b.st[0] = nloc; b.st[1] = nx; }
        const unsigned old = xb_add(&bar[XB_XSUB(b.x)], 1u);
        const unsigned gen = old / nloc;
        if (old + 1u == (gen + 1u) * nloc) {
            __builtin_amdgcn_fence(__ATOMIC_RELEASE, "agent");
            asm volatile("s_waitcnt vmcnt(0)" ::: "memory");
            const unsigned og = xb_add(&bar[XB_TOP], 1u);
            const unsigned tg = og / nx;
            if (og + 1u == (tg + 1u) * nx) xb_add(&bar[XB_TOPGEN], 1u);
            else XB_SPIN(xb_ld(&bar[XB_TOPGEN]) == tg, bar);
            __builtin_amdgcn_fence(__ATOMIC_ACQUIRE, "agent");
            xb_add(&bar[XB_XGEN(b.x)], 1u);
            asm volatile("s_waitcnt vmcnt(0)" ::: "memory");
        } else {
            XB_SPIN(xb_ld(&bar[XB_XGEN(b.x)]) == gen, bar);
            __builtin_amdgcn_fence(__ATOMIC_ACQUIRE, "agent");
            asm volatile("s_waitcnt vmcnt(0)" ::: "memory");
        }
    }
    __syncthreads();
}

namespace pg8 {
constexpr int BM = 256, BK = 64, HALF = 128, HTB = HALF * BK * 2, NXCD = 8, WGM = 8;
__host__ __device__ __forceinline__ int lds_byte(int r, int c) { return r * 128 + ((((c >> 3) ^ ((r >> 1) & 7))) << 4) + (c & 7) * 2; }
__host__ __device__ __forceinline__ void stage_rc(int b, int& R, int& C) { R = b >> 7; const int slot = (b & 127) >> 4; C = (slot ^ ((R >> 1) & 7)) * 8; }
__host__ __device__ __forceinline__ int perm32(int rho) { const int n = rho >> 4, i = rho & 15; return 8 * (i >> 2) + 4 * n + (i & 3); }
struct Unit { int pm, pn, koff, nt; };
struct Gemm { const bf16* A; const bf16* Bt; int M, N, K, lda, ldb; };
struct StaticOrder {
    int nM, nN, nwg, G, c, nt, wgm;
    __device__ void init(int M_, int N_, int K_, int G_, int c_, int wgm_ = WGM) { nM = M_ / BM; nN = N_ / BM; nwg = nM * nN; G = G_; c = c_; nt = K_ / BK; wgm = wgm_; }
    __device__ bool next(int i, Unit& u) const {
        const long L = (long)i * G + c; if (L >= nwg) return false;
        int wgid = (int)L; { const int q = nwg / NXCD, r = nwg % NXCD, xcd = wgid % NXCD, off = wgid / NXCD; wgid = (xcd < r ? xcd * (q + 1) : r * (q + 1) + (xcd - r) * q) + off; }
        const int nig = wgm * nN, gid = wgid / nig, fm = gid * wgm, gsz = (nM - fm) < wgm ? (nM - fm) : wgm;
        u.pm = fm + ((wgid % nig) % gsz); u.pn = (wgid % nig) / gsz; u.koff = 0; u.nt = nt; return true;
    }
};
struct CombinedOrder {
    StaticOrder S0; int pmS, nN, np, KS;
    __device__ void init(int Mmain, int N_, int K_, int NS_, int G_, int c_) { S0.init(Mmain, N_, K_, G_, c_, 4); pmS = Mmain / BM; nN = N_ / BM; np = nN * NS_; KS = K_ / NS_; }
    __device__ bool next(int i, Unit& u) const { const long L = (long)i * S0.G + S0.c; if (L < S0.nwg) return S0.next(i, u);
        const int p = (int)(L - S0.nwg); if (p >= np) return false; u.pm = pmS; u.pn = p % nN; u.koff = (p / nN) * KS; u.nt = KS / BK; return true; }
};
template <class Epi, class Order>
__device__ __forceinline__ void gemm_phase(LAS unsigned char* lds, const Gemm g, const Order& S, const Epi& E) {
    const int tid = fresh_tid(), wid = __builtin_amdgcn_readfirstlane(tid >> 6), lane = tid & 63, wr = wid >> 2, wc = wid & 3, fr = lane & 15, fq = lane >> 4;
    unsigned voffA[2], voffB[2];
#pragma unroll
    for (int i = 0; i < 2; ++i) { int R, C; stage_rc(tid * 16 + i * 8192, R, C); const int Rb = 64 * (R >> 5) + perm32(R & 31);
        voffA[i] = (unsigned)(R * g.lda + C) * 2u; voffB[i] = (unsigned)(Rb * g.ldb + C) * 2u; }
    const size_t kstep = (size_t)(BK * 2);
    const size_t hstepA = (size_t)HALF * g.lda * 2, hstepB = (size_t)32 * g.ldb * 2;
    const size_t tstepA = 2 * hstepA, tstepB = (size_t)BM * g.ldb * 2;
    const unsigned ldsw = (unsigned)wid * 1024u;
    const int aoff = lds_byte(wr * 64 + fr, fq * 8), boff = lds_byte(wc * 32 + fr, fq * 8), aoff1 = aoff ^ 64, boff1 = boff ^ 64;
#define PG8_SA(b, h) (((b) * 2 + (h)) * HTB)
#define PG8_SB(b, h) ((4 + (b) * 2 + (h)) * HTB)
#define PG8_STAGE(bufoff, gbase, voff) do { _Pragma("unroll") for (int _i = 0; _i < 2; ++_i) \
        __builtin_amdgcn_global_load_lds((const unsigned*)((const char*)(gbase) + (voff)[_i]), (LAS unsigned*)(lds + (bufoff) + ldsw + _i * 8192), 16, 0, 0); } while (0)
#define PG8_LDA(dst, b, h) do { _Pragma("unroll") for (int m = 0; m < 4; ++m) _Pragma("unroll") for (int k = 0; k < 2; ++k) dst[m][k] = *(const LAS bf16x8*)(lds + PG8_SA(b, h) + (k ? aoff1 : aoff) + m * 2048); } while (0)
#define PG8_LDB(dst, b, h) do { _Pragma("unroll") for (int n = 0; n < 2; ++n) _Pragma("unroll") for (int k = 0; k < 2; ++k) dst[n][k] = *(const LAS bf16x8*)(lds + PG8_SB(b, h) + (k ? boff1 : boff) + n * 2048); } while (0)
#define PG8_MMA(ai, bj, At, Bt) do { __builtin_amdgcn_s_setprio(1); _Pragma("unroll") for (int m = 0; m < 4; ++m) _Pragma("unroll") for (int n = 0; n < 2; ++n) _Pragma("unroll") for (int k = 0; k < 2; ++k) \
        acc[ai][bj][m][n] = __builtin_amdgcn_mfma_f32_16x16x32_bf16(Bt[n][k], At[m][k], acc[ai][bj][m][n], 0, 0, 0); __builtin_amdgcn_s_setprio(0); } while (0)
#define PG8_WAIT_V(n) asm volatile("s_waitcnt vmcnt(" #n ")" ::: "memory")
#define PG8_WAIT_L(n) asm volatile("s_waitcnt lgkmcnt(" #n ")" ::: "memory")
#define PG8_BAR __builtin_amdgcn_s_barrier()
#define PG8_SCHED __builtin_amdgcn_sched_barrier(0)
    Unit cur, nxt; int ui = 0;
    if (!S.next(0, cur)) return;
    f32x4 acc[2][2][4][2];
#pragma unroll
    for (int a = 0; a < 2; ++a)
#pragma unroll
        for (int b = 0; b < 2; ++b)
#pragma unroll
            for (int m = 0; m < 4; ++m)
#pragma unroll
                for (int n = 0; n < 2; ++n) acc[a][b][m][n] = (f32x4){0.f, 0.f, 0.f, 0.f};
    bf16x8 At[4][2], B0[2][2], B1[2][2];
    const char* cA = (const char*)g.A + (size_t)cur.pm * tstepA + (size_t)cur.koff * 2; const char* cB = (const char*)g.Bt + (size_t)cur.pn * tstepB + (size_t)cur.koff * 2;
    PG8_STAGE(PG8_SB(0, 0), cB, voffB); PG8_STAGE(PG8_SB(0, 1), cB + hstepB, voffB); PG8_STAGE(PG8_SA(0, 0), cA, voffA); PG8_STAGE(PG8_SA(0, 1), cA + hstepA, voffA);
    if (wr == 1) PG8_BAR;
    PG8_WAIT_V(2); PG8_BAR;
    PG8_STAGE(PG8_SB(1, 0), cB + kstep, voffB); PG8_STAGE(PG8_SA(1, 0), cA + kstep, voffA); PG8_STAGE(PG8_SB(1, 1), cB + hstepB + kstep, voffB);
    PG8_WAIT_V(6); PG8_BAR;
    for (;;) {
        const bool has_next = S.next(ui + 1, nxt);
        const char* nA = has_next ? (const char*)g.A + (size_t)nxt.pm * tstepA + (size_t)nxt.koff * 2 : cA; const char* nB = has_next ? (const char*)g.Bt + (size_t)nxt.pn * tstepB + (size_t)nxt.koff * 2 : cB;
        const int nt = cur.nt;
        for (int t = 0; t < nt; t += 2) {
            if constexpr (Epi::HOOK) { if (t == 8 || t == 24) E.mid(acc, cur, wr, wc, fr, fq, t); }
            const bool last = (t == nt - 2);
            const char* a1 = cA + (size_t)(t + 1) * kstep;
            const char* a2 = last ? nA : cA + (size_t)(t + 2) * kstep; const char* b2 = last ? nB : cB + (size_t)(t + 2) * kstep;
            const char* a3 = a2 + kstep; const char* b3 = b2 + kstep;
            PG8_LDB(B0, 0, 0); PG8_LDB(B1, 0, 1); PG8_SCHED; PG8_LDA(At, 0, 0); PG8_STAGE(PG8_SA(1, 1), a1 + hstepA, voffA);
            PG8_WAIT_V(8); PG8_WAIT_L(0); PG8_BAR; PG8_MMA(0, 0, At, B0); PG8_MMA(0, 1, At, B1); PG8_BAR; PG8_SCHED;
            PG8_LDA(At, 0, 1); PG8_STAGE(PG8_SB(0, 0), b2, voffB); PG8_STAGE(PG8_SB(0, 1), b2 + hstepB, voffB); PG8_STAGE(PG8_SA(0, 0), a2, voffA);
            PG8_WAIT_V(8); PG8_WAIT_L(0); PG8_BAR; PG8_MMA(1, 0, At, B0); PG8_MMA(1, 1, At, B1); PG8_BAR; PG8_SCHED;
            PG8_LDB(B0, 1, 0); PG8_LDB(B1, 1, 1); PG8_SCHED; PG8_LDA(At, 1, 0); PG8_STAGE(PG8_SA(0, 1), a2 + hstepA, voffA);
            PG8_WAIT_V(8); PG8_WAIT_L(0); PG8_BAR; PG8_MMA(0, 0, At, B0); PG8_MMA(0, 1, At, B1); PG8_BAR; PG8_SCHED;
            PG8_LDA(At, 1, 1); PG8_STAGE(PG8_SB(1, 0), b3, voffB); PG8_STAGE(PG8_SB(1, 1), b3 + hstepB, voffB); PG8_STAGE(PG8_SA(1, 0), a3, voffA);
            PG8_WAIT_V(8); PG8_WAIT_L(0); PG8_BAR; PG8_MMA(1, 0, At, B0); PG8_MMA(1, 1, At, B1); PG8_BAR; PG8_SCHED;
        }
        if (wr == 0) PG8_BAR;
        E(acc, cur, wr, wc, fr, fq);
        if (!has_next) break;
#pragma unroll
        for (int a = 0; a < 2; ++a)
#pragma unroll
            for (int b = 0; b < 2; ++b)
#pragma unroll
                for (int m = 0; m < 4; ++m)
#pragma unroll
                    for (int n = 0; n < 2; ++n) acc[a][b][m][n] = (f32x4){0.f, 0.f, 0.f, 0.f};
        cur = nxt; cA = nA; cB = nB; ++ui;
        if (wr == 1) PG8_BAR;
    }
    PG8_WAIT_V(0);
    PG8_BAR;
#undef PG8_SA
#undef PG8_SB
#undef PG8_STAGE
#undef PG8_LDA
#undef PG8_LDB
#undef PG8_MMA
#undef PG8_WAIT_V
#undef PG8_WAIT_L
#undef PG8_BAR
#undef PG8_SCHED
}

#define EPI_LOOP_BEGIN const int row0 = u.pm * BM + wr * 64 + fr, col0 = u.pn * BM + wc * 64 + 8 * fq; \
    _Pragma("unroll") for (int ai = 0; ai < 2; ++ai) _Pragma("unroll") for (int m = 0; m < 4; ++m) { const size_t row = (size_t)(row0 + ai * HALF + m * 16); \
    _Pragma("unroll") for (int bj = 0; bj < 2; ++bj) { const int col = col0 + bj * 32; f32x4 v0 = acc[ai][bj][m][0], v1 = acc[ai][bj][m][1];
#define EPI_LOOP_END } }
__device__ __forceinline__ u32x4 pk8(f32x4 v0, f32x4 v1) { u32x4 w; w.x = cvtpk(v0[0], v0[1]); w.y = cvtpk(v0[2], v0[3]); w.z = cvtpk(v1[0], v1[1]); w.w = cvtpk(v1[2], v1[3]); return w; }
__device__ __forceinline__ float sigm(float v) { return __builtin_amdgcn_rcpf(1.f + __builtin_amdgcn_exp2f(-1.4426950408889634f * v)); }

template <bool NT> __device__ __forceinline__ void st_lines(LAS unsigned char* scr, u32x4 w0, u32x4 w1, bf16* tile, size_t ldc, int fr, int fq) {
    const int lane = fq * 16 + fr, rr = lane >> 3, c = lane & 7;
    *(LAS u32x4*)(scr + fr * 128 + ((fq ^ (fr & 7)) << 4)) = w0;
    *(LAS u32x4*)(scr + fr * 128 + (((4 + fq) ^ (fr & 7)) << 4)) = w1;
    const u32x4 a = *(const LAS u32x4*)(scr + rr * 128 + ((c ^ rr) << 4)), b = *(const LAS u32x4*)(scr + (8 + rr) * 128 + ((c ^ rr) << 4));
    bf16* d = tile + (size_t)rr * ldc + c * 8;
    if constexpr (NT) { __builtin_nontemporal_store(a, (u32x4*)d); __builtin_nontemporal_store(b, (u32x4*)(d + 8 * ldc)); }
    else { *(u32x4*)d = a; *(u32x4*)(d + 8 * ldc) = b; }
}
struct EpiIn {
    static constexpr bool HOOK = false;
    bf16* Z; bf16* G; const float* bg; LAS unsigned char* scr;
    __device__ __forceinline__ void operator()(const f32x4 (&acc)[2][2][4][2], const Unit& u, int wr, int wc, int fr, int fq) const {
        const bool isg = u.pn * BM >= NZ;
        const int colw = u.pn * BM + wc * 64 - (isg ? NZ : 0);
        bf16* base = (isg ? G : Z) + (size_t)(u.pm * BM + wr * 64) * (isg ? NGATE : NZ) + colw; const size_t ldc = isg ? NGATE : NZ;
        LAS unsigned char* sw = scr + (wr * 4 + wc) * 2048;
        f32x4 b00, b01, b10, b11;
        if (isg) { const float* bp = bg + colw + 8 * fq; b00 = *(const f32x4*)bp; b01 = *(const f32x4*)(bp + 4); b10 = *(const f32x4*)(bp + 32); b11 = *(const f32x4*)(bp + 36); }
#pragma unroll
        for (int ai = 0; ai < 2; ++ai)
#pragma unroll
            for (int m = 0; m < 4; ++m) {
                f32x4 v0 = acc[ai][0][m][0], v1 = acc[ai][0][m][1], v2 = acc[ai][1][m][0], v3 = acc[ai][1][m][1];
                if (isg) { v0 += b00; v1 += b01; v2 += b10; v3 += b11;
#pragma unroll
                    for (int e = 0; e < 4; ++e) { v0[e] = sigm(v0[e]); v1[e] = sigm(v1[e]); v2[e] = sigm(v2[e]); v3[e] = sigm(v3[e]); } }
                st_lines<true>(sw, pk8(v0, v1), pk8(v2, v3), base + (size_t)(ai * HALF + m * 16) * ldc, ldc, fr, fq); }
    }
};
struct EpiPlain {
    static constexpr bool HOOK = false;
    bf16* O; int ldc; LAS unsigned char* scr;
    __device__ __forceinline__ void operator()(const f32x4 (&acc)[2][2][4][2], const Unit& u, int wr, int wc, int fr, int fq) const {
        bf16* base = O + (size_t)(u.pm * BM + wr * 64) * ldc + u.pn * BM + wc * 64; LAS unsigned char* sw = scr + (wr * 4 + wc) * 2048;
#pragma unroll
        for (int ai = 0; ai < 2; ++ai)
#pragma unroll
            for (int m = 0; m < 4; ++m)
                st_lines<false>(sw, pk8(acc[ai][0][m][0], acc[ai][0][m][1]), pk8(acc[ai][1][m][0], acc[ai][1][m][1]), base + (size_t)(ai * HALF + m * 16) * ldc, (size_t)ldc, fr, fq);
    }
};
struct EpiMerge {
    static constexpr bool HOOK = true;
    const bf16* G; bf16* Ob; LAS unsigned char* scr;
    __device__ __forceinline__ void mid(f32x4 (&acc)[2][2][4][2], const Unit& u, int wr, int wc, int fr, int fq, int t) const {
        const __amdgpu_buffer_rsrc_t rs = __builtin_amdgcn_make_buffer_rsrc((void*)G, 0, (int)((size_t)M * NGATE * 2), 0x00020000);
        const int gx = (t == 8) ? 0 : DM;
        const int voff = ((u.pm * BM + wr * 64 + fr) * NGATE + u.pn * BM + wc * 64 + 8 * fq + gx) * 2;
#pragma unroll
        for (int ai = 0; ai < 2; ++ai) {
            u32x4 wa[4][2], wb[4][2];
#pragma unroll
            for (int m = 0; m < 4; ++m)
#pragma unroll
                for (int bj = 0; bj < 2; ++bj) { const int so = ((ai * HALF + m * 16) * NGATE + bj * 32) * 2;
                    wa[m][bj] = __builtin_amdgcn_raw_buffer_load_b128(rs, voff, so, 0); wb[m][bj] = __builtin_amdgcn_raw_buffer_load_b128(rs, voff, so + DM * 2, 0); }
#pragma unroll
            for (int m = 0; m < 4; ++m)
#pragma unroll
                for (int bj = 0; bj < 2; ++bj) {
                    float a[8], b[8]; unpack8(wa[m][bj], a); unpack8(wb[m][bj], b);
#pragma unroll
                    for (int e = 0; e < 8; ++e) a[e] = a[e] * __builtin_amdgcn_rcpf(fmaxf(b[e], 1e-30f));
                    f32x4& v0 = acc[ai][bj][m][0]; f32x4& v1 = acc[ai][bj][m][1];
                    v0[0] *= a[0]; v0[1] *= a[1]; v0[2] *= a[2]; v0[3] *= a[3]; v1[0] *= a[4]; v1[1] *= a[5]; v1[2] *= a[6]; v1[3] *= a[7]; }
            SBAR(); }
    }
    __device__ __forceinline__ void operator()(const f32x4 (&acc)[2][2][4][2], const Unit& u, int wr, int wc, int fr, int fq) const {
        bf16* base = Ob + (size_t)(u.pm * BM + wr * 64) * DM + u.pn * BM + wc * 64; LAS unsigned char* sw = scr + (wr * 4 + wc) * 2048;
        const bf16* gb = G + (size_t)(u.pm * BM + wr * 64 + fr) * NGATE + 2 * DM + u.pn * BM + wc * 64 + 8 * fq;
        u32x4 gq[2][4][2];
#pragma unroll
        for (int ai = 0; ai < 2; ++ai)
#pragma unroll
            for (int m = 0; m < 4; ++m) { const bf16* gp = gb + (size_t)(ai * HALF + m * 16) * NGATE; gq[ai][m][0] = *(const u32x4*)gp; gq[ai][m][1] = *(const u32x4*)(gp + 32); }
#pragma unroll
        for (int ai = 0; ai < 2; ++ai)
#pragma unroll
            for (int m = 0; m < 4; ++m) {
                float g0[8], g1[8]; unpack8(gq[ai][m][0], g0); unpack8(gq[ai][m][1], g1);
                f32x4 v0 = acc[ai][0][m][0], v1 = acc[ai][0][m][1], v2 = acc[ai][1][m][0], v3 = acc[ai][1][m][1];
                v0[0] *= g0[0]; v0[1] *= g0[1]; v0[2] *= g0[2]; v0[3] *= g0[3]; v1[0] *= g0[4]; v1[1] *= g0[5]; v1[2] *= g0[6]; v1[3] *= g0[7];
                v2[0] *= g1[0]; v2[1] *= g1[1]; v2[2] *= g1[2]; v2[3] *= g1[3]; v3[0] *= g1[4]; v3[1] *= g1[5]; v3[2] *= g1[6]; v3[3] *= g1[7];
                st_lines<false>(sw, pk8(v0, v1), pk8(v2, v3), base + (size_t)(ai * HALF + m * 16) * DM, (size_t)DM, fr, fq); }
    }
};
struct EpiResidSplit {
    static constexpr bool HOOK = false;
    float* X; float* P; int pmS, KS; LAS unsigned char* scr;
    __device__ __forceinline__ void operator()(const f32x4 (&acc)[2][2][4][2], const Unit& u, int wr, int wc, int fr, int fq) const {
        const bool piece = u.pm >= pmS;
        float* base = (piece ? P + (size_t)(u.koff / KS) * (MS * DM) - (size_t)u.pm * BM * DM : X) + (size_t)(u.pm * BM + wr * 64) * DM + u.pn * BM + wc * 64;
        LAS unsigned char* sw = scr + (wr * 4 + wc) * 2048;
        const int lane = fq * 16 + fr, rr = lane >> 3, c = lane & 7;
        float* drow = base + (size_t)rr * DM + c * 4;
#define RS_OFF(st) ((size_t)((((st) >> 3) & 1) * HALF + (((st) >> 1) & 3) * 16) * DM + ((st) & 1) * 32)
        f32x4 xa[2][4], xb[2][4];
        if (!piece) {
#pragma unroll
            for (int q = 0; q < 4; ++q) { const float* d = drow + RS_OFF(q); xa[0][q] = *(const f32x4*)d; xb[0][q] = *(const f32x4*)(d + 8 * DM); } }
#pragma unroll
        for (int bt = 0; bt < 4; ++bt) {
            if (!piece && bt < 3) {
#pragma unroll
                for (int q = 0; q < 4; ++q) { const float* d = drow + RS_OFF(4 * (bt + 1) + q); xa[(bt + 1) & 1][q] = *(const f32x4*)d; xb[(bt + 1) & 1][q] = *(const f32x4*)(d + 8 * DM); } }
#pragma unroll
            for (int q = 0; q < 4; ++q) { const int st = 4 * bt + q, ai = (st >> 3) & 1, m = (st >> 1) & 3, bj = st & 1;
                *(LAS f32x4*)(sw + fr * 128 + (((2 * fq) ^ (fr & 7)) << 4)) = acc[ai][bj][m][0];
                *(LAS f32x4*)(sw + fr * 128 + (((2 * fq + 1) ^ (fr & 7)) << 4)) = acc[ai][bj][m][1];
                f32x4 a = *(const LAS f32x4*)(sw + rr * 128 + ((c ^ rr) << 4)), b = *(const LAS f32x4*)(sw + (8 + rr) * 128 + ((c ^ rr) << 4));
                float* d = drow + RS_OFF(st);
                if (!piece) { a += xa[bt & 1][q]; b += xb[bt & 1][q]; }
                *(f32x4*)d = a; *(f32x4*)(d + 8 * DM) = b; }
        }
#undef RS_OFF
    }
};
struct EpiUp {
    static constexpr bool HOOK = false;
    bf16* U; LAS unsigned char* scr;
    __device__ __forceinline__ void operator()(const f32x4 (&acc)[2][2][4][2], const Unit& u, int wr, int wc, int fr, int fq) const {
        bf16* base = U + (size_t)(u.pm * BM + wr * 64) * DFF + u.pn * BM + wc * 64; LAS unsigned char* sw = scr + (wr * 4 + wc) * 2048;
#pragma unroll
        for (int ai = 0; ai < 2; ++ai)
#pragma unroll
            for (int m = 0; m < 4; ++m) {
                f32x4 v0 = acc[ai][0][m][0], v1 = acc[ai][0][m][1], v2 = acc[ai][1][m][0], v3 = acc[ai][1][m][1];
#pragma unroll
                for (int e = 0; e < 4; ++e) { const float a = fmaxf(v0[e], 0.f), b = fmaxf(v1[e], 0.f), c = fmaxf(v2[e], 0.f), d = fmaxf(v3[e], 0.f); v0[e] = a * a; v1[e] = b * b; v2[e] = c * c; v3[e] = d * d; }
                st_lines<true>(sw, pk8(v0, v1), pk8(v2, v3), base + (size_t)(ai * HALF + m * 16) * DFF, (size_t)DFF, fr, fq); }
    }
};
}

namespace att {
__device__ __forceinline__ int crow(int r, int hi) { return (r & 3) + 8 * (r >> 2) + 4 * hi; }
__device__ __forceinline__ int v_st(int k, int c) { const int kk = (k & ~0xC) | ((k & 4) << 1) | ((k & 8) >> 1); return ((kk >> 3) * 4 + (c >> 5)) * 512 + ((kk & 7) * 32 + (c & 31)) * 2; }
__device__ __forceinline__ int v_rd_base(int lane) { return ((lane & 3) << 3) | (((lane >> 2) & 3) << 6) | (((lane >> 4) & 1) << 5) | (((lane >> 5) & 1) << 8); }
constexpr int v_rd_off(int d0, int ks, int half) { return d0 * 512 + ks * 4096 + half * 2048; }
template <int OFF> __device__ __forceinline__ s16x4 tr_read(unsigned vb) {
    s16x4 r; asm volatile("ds_read_b64_tr_b16 %0, %1 offset:%2" : "=&v"(r) : "v"(vb), "i"(OFF) : "memory"); return r;
}
template <int DQK> struct Cn {
    static constexpr float SCALE = DQK == 64 ? 0.125f : (DQK == 128 ? 0.08838834764831845f : 0.07216878364870323f);
    static constexpr float C = SCALE * 1.4426950408889634f;
    static constexpr float THRR = 8.f / SCALE;
};
template <int DQK> __device__ __forceinline__ int kswz(int row) { return (DQK == 128 ? (row & 15) : ((row >> 1) & 7)) << 4; }
template <int DQK>
__device__ __forceinline__ void qkt_h(f32x16& p, const f32x16& cinit, const LAS char* Ks, int rowbase, const bf16x8* qr, int r32, int hi) {
    constexpr int KRB = DQK * 2;
    p = cinit;
    const int sw = kswz<DQK>(r32);
#pragma unroll
    for (int d0 = 0; d0 < DQK / 16; ++d0) { const int cb = (d0 * 2 + hi) * 16;
        const bf16x8 b = *(const LAS bf16x8*)(Ks + (rowbase + r32) * KRB + (cb ^ sw));
        p = __builtin_amdgcn_mfma_f32_32x32x16_bf16(b, qr[d0], p, 0, 0, 0); }
}
template <int DQK>
__device__ __forceinline__ void smx_h(f32x16& p, float negB, float& l_acc, bf16x8& paA, bf16x8& paB) {
#pragma unroll
    for (int r = 0; r < 16; ++r) p[r] = __builtin_amdgcn_exp2f(p[r]);
    float s0 = (p[0] + p[1]) + (p[2] + p[3]), s1 = (p[4] + p[5]) + (p[6] + p[7]), s2 = (p[8] + p[9]) + (p[10] + p[11]), s3 = (p[12] + p[13]) + (p[14] + p[15]);
    l_acc += (s0 + s1) + (s2 + s3);
#define PK4(P, BASE, OUT) do { unsigned a0 = cvtpk(P[BASE + 0], P[BASE + 1]), a1 = cvtpk(P[BASE + 2], P[BASE + 3]);   \
    unsigned b0 = cvtpk(P[BASE + 4], P[BASE + 5]), b1 = cvtpk(P[BASE + 6], P[BASE + 7]);                              \
    auto r0 = __builtin_amdgcn_permlane32_swap(a0, b0, false, false); auto r1 = __builtin_amdgcn_permlane32_swap(a1, b1, false, false); \
    u32x4 w = {r0[0], r1[0], r0[1], r1[1]}; OUT = __builtin_bit_cast(bf16x8, w); } while (0)
    PK4(p, 0, paA); PK4(p, 8, paB);
#undef PK4
}
template <int D0, int KS0> __device__ __forceinline__ void pv_half_one(f32x16& od, unsigned vb, bf16x8 paA, bf16x8 paB) {
    s16x4 l0 = tr_read<v_rd_off(D0, KS0, 0)>(vb), h0 = tr_read<v_rd_off(D0, KS0, 1)>(vb), l1 = tr_read<v_rd_off(D0, KS0 + 1, 0)>(vb), h1 = tr_read<v_rd_off(D0, KS0 + 1, 1)>(vb);
    asm volatile("s_waitcnt lgkmcnt(0)" : "+v"(l0), "+v"(h0), "+v"(l1), "+v"(h1) :: "memory");
#define PK(L, H) (bf16x8){L[0], L[1], L[2], L[3], H[0], H[1], H[2], H[3]}
    od = __builtin_amdgcn_mfma_f32_32x32x16_bf16(paA, PK(l0, h0), od, 0, 0, 0);
    od = __builtin_amdgcn_mfma_f32_32x32x16_bf16(paB, PK(l1, h1), od, 0, 0, 0);
#undef PK
}
template <int KS0> __device__ __forceinline__ void pv_half(f32x16* o, unsigned vb, bf16x8 paA, bf16x8 paB) {
#define TR4(D0) s16x4 l0_##D0 = tr_read<v_rd_off(D0, KS0, 0)>(vb), h0_##D0 = tr_read<v_rd_off(D0, KS0, 1)>(vb), l1_##D0 = tr_read<v_rd_off(D0, KS0 + 1, 0)>(vb), h1_##D0 = tr_read<v_rd_off(D0, KS0 + 1, 1)>(vb)
    TR4(0); TR4(1); TR4(2); TR4(3);
#undef TR4
    asm volatile("s_waitcnt lgkmcnt(0)" : "+v"(l0_0), "+v"(h0_0), "+v"(l1_0), "+v"(h1_0), "+v"(l0_1), "+v"(h0_1), "+v"(l1_1), "+v"(h1_1),
                                          "+v"(l0_2), "+v"(h0_2), "+v"(l1_2), "+v"(h1_2), "+v"(l0_3), "+v"(h0_3), "+v"(l1_3), "+v"(h1_3) :: "memory");
#define PK(L, H) (bf16x8){L[0], L[1], L[2], L[3], H[0], H[1], H[2], H[3]}
#define MM(D0) o[D0] = __builtin_amdgcn_mfma_f32_32x32x16_bf16(paA, PK(l0_##D0, h0_##D0), o[D0], 0, 0, 0); o[D0] = __builtin_amdgcn_mfma_f32_32x32x16_bf16(paB, PK(l1_##D0, h1_##D0), o[D0], 0, 0, 0)
    MM(0); MM(1); MM(2); MM(3);
#undef MM
#undef PK
}
struct VFrag { s16x4 l0[4], h0[4], l1[4], h1[4]; };
template <int KS0> __device__ __forceinline__ void pv_issue(VFrag& f, unsigned vb) {
    f.l0[0] = tr_read<v_rd_off(0, KS0, 0)>(vb); f.h0[0] = tr_read<v_rd_off(0, KS0, 1)>(vb); f.l1[0] = tr_read<v_rd_off(0, KS0 + 1, 0)>(vb); f.h1[0] = tr_read<v_rd_off(0, KS0 + 1, 1)>(vb);
    f.l0[1] = tr_read<v_rd_off(1, KS0, 0)>(vb); f.h0[1] = tr_read<v_rd_off(1, KS0, 1)>(vb); f.l1[1] = tr_read<v_rd_off(1, KS0 + 1, 0)>(vb); f.h1[1] = tr_read<v_rd_off(1, KS0 + 1, 1)>(vb);
    f.l0[2] = tr_read<v_rd_off(2, KS0, 0)>(vb); f.h0[2] = tr_read<v_rd_off(2, KS0, 1)>(vb); f.l1[2] = tr_read<v_rd_off(2, KS0 + 1, 0)>(vb); f.h1[2] = tr_read<v_rd_off(2, KS0 + 1, 1)>(vb);
    f.l0[3] = tr_read<v_rd_off(3, KS0, 0)>(vb); f.h0[3] = tr_read<v_rd_off(3, KS0, 1)>(vb); f.l1[3] = tr_read<v_rd_off(3, KS0 + 1, 0)>(vb); f.h1[3] = tr_read<v_rd_off(3, KS0 + 1, 1)>(vb);
}
__device__ __forceinline__ void pv_wait(VFrag& f) {
    asm volatile("s_waitcnt lgkmcnt(0)" : "+v"(f.l0[0]), "+v"(f.h0[0]), "+v"(f.l1[0]), "+v"(f.h1[0]), "+v"(f.l0[1]), "+v"(f.h0[1]), "+v"(f.l1[1]), "+v"(f.h1[1]),
                                          "+v"(f.l0[2]), "+v"(f.h0[2]), "+v"(f.l1[2]), "+v"(f.h1[2]), "+v"(f.l0[3]), "+v"(f.h0[3]), "+v"(f.l1[3]), "+v"(f.h1[3]) :: "memory");
}
__device__ __forceinline__ void pv_mma(f32x16* o, const VFrag& f, bf16x8 paA, bf16x8 paB) {
#define PK(L, H) (bf16x8){L[0], L[1], L[2], L[3], H[0], H[1], H[2], H[3]}
#pragma unroll
    for (int d = 0; d < 4; ++d) { o[d] = __builtin_amdgcn_mfma_f32_32x32x16_bf16(paA, PK(f.l0[d], f.h0[d]), o[d], 0, 0, 0); o[d] = __builtin_amdgcn_mfma_f32_32x32x16_bf16(paB, PK(f.l1[d], f.h1[d]), o[d], 0, 0, 0); }
#undef PK
}
struct UnitP {
    const bf16* Q; int ldq; int nq;
    const bf16* K; int ldk; const bf16* V; int ldv;
    void* O; int ldo;
    int NT;
    int kvalid;
    int lo_base, lo_step, hi_base, hi_step;
    int qpos0, kpos0; const float* tab;
    float negB;
    int fix_lo, fix_hi;
};
constexpr int LDS_ATT_V = 0, LDS_ATT_K = 49152, LDS_ATT_WS = RING_BYTES + 1024, LDS_ATT_TAB = LDS_ATT_WS + 2048, LDS_ATT_END = LDS_ATT_TAB + 1088;
static_assert(LDS_ATT_K + 3 * 24576 <= RING_BYTES && LDS_ATT_WS >= MISC_OFF + 128 && LDS_ATT_END <= EPI_OFF, "attention LDS");

template <int DQK, bool F32OUT, bool BIAS, bool PIPE2>
__device__ __forceinline__ void attn_unit(const UnitP& P, LAS char* lds) {
    constexpr int NQ = DQK / 16, KRB = DQK * 2, KCH = DQK / 8, KP = DQK / 64;
    constexpr int SHM_V = 16384, SHM_K = 64 * DQK * 2;
    constexpr float NEGINF = -__builtin_huge_valf();
    const int tid = fresh_tid(), wid = __builtin_amdgcn_readfirstlane(tid >> 6), lane = tid & 63, r32 = lane & 31, hi = lane >> 5;
    LAS char* V_lds = lds + LDS_ATT_V; LAS char* K_lds = lds + LDS_ATT_K;
    LAS float* ws = (LAS float*)(lds + LDS_ATT_WS) + wid * 64; LAS float* li_l = ws; LAS float* al_l = ws + 32;
    LAS float* tblS = (LAS float*)(lds + LDS_ATT_TAB);
    const int NT = P.NT, kvalid = P.kvalid;
    int lo_w = P.lo_base + P.lo_step * (wid >> 1); lo_w = lo_w < 0 ? 0 : lo_w;
    const int hi_w = P.hi_base + P.hi_step * (wid >> 1);
    float l_reg = 0.f; const float negB = P.negB; f32x16 o[4] = {}; bf16x8 qr[NQ];
    { int qrow = wid * 32 + r32; qrow = qrow < P.nq ? qrow : P.nq - 1;
      const bf16* Qw = P.Q + (size_t)qrow * P.ldq + hi * 8;
#pragma unroll
      for (int d0 = 0; d0 < NQ; ++d0) qr[d0] = *(const bf16x8*)(Qw + d0 * 16); }
    unsigned voffV[2], voffK[KP];
#pragma unroll
    for (int i = 0; i < 2; ++i) { const int b_ = (tid + 512 * i) * 16, st = b_ >> 9, kk = (st >> 2) * 8 + ((b_ & 511) >> 6), c = (st & 3) * 32 + ((b_ & 63) >> 1), k = (kk & ~0xC) | ((kk & 4) << 1) | ((kk & 8) >> 1);
        voffV[i] = (unsigned)(k * P.ldv + c) * 2u; }
#pragma unroll
    for (int p = 0; p < KP; ++p) { const int G = tid + 512 * p, row = G / KCH, slot = G % KCH, g = slot ^ (kswz<DQK>(row) >> 4); voffK[p] = (unsigned)(row * P.ldk + g * 8) * 2u; }
    const unsigned vb0 = (unsigned)(uintptr_t)V_lds + (unsigned)v_rd_base(lane);
    const bf16* Kh = P.K; const bf16* Vh = P.V; const int ldk = P.ldk, ldv = P.ldv;
#define DMA(b, k0) do { const char* vsrc_ = (const char*)(Vh + (size_t)(k0) * ldv); const char* ksrc_ = (const char*)(Kh + (size_t)(k0) * ldk); \
    _Pragma("unroll") for (int i = 0; i < 2; ++i) __builtin_amdgcn_global_load_lds((const unsigned*)(vsrc_ + voffV[i]), (LAS unsigned*)(V_lds + (b) * SHM_V + wid * 1024 + i * 8192), 16, 0, 0); \
    _Pragma("unroll") for (int p = 0; p < KP; ++p) __builtin_amdgcn_global_load_lds((const unsigned*)(ksrc_ + voffK[p]), (LAS unsigned*)(K_lds + (b) * SHM_K + wid * 1024 + p * 8192), 16, 0, 0); } while (0)
#define FIXUP(p0, p1, jt) do { \
    if ((jt) < P.fix_lo || (jt) >= P.fix_hi) { int kv_ = kvalid, lo_ = lo_w, hi_ = hi_w; asm volatile("; masked-tile path" : "+s"(kv_), "+s"(lo_), "+s"(hi_) :: "memory");     \
      if ((jt) < lo_ || (jt) > hi_) { _Pragma("unroll") for (int r = 0; r < 16; ++r) { p0[r] = NEGINF; p1[r] = NEGINF; } } \
      else if (((jt) + 1) * 64 > kv_) { _Pragma("unroll") for (int r = 0; r < 16; ++r) { const int key = (jt) * 64 + crow(r, hi); if (key >= kv_) p0[r] = NEGINF; if (key + 32 >= kv_) p1[r] = NEGINF; } } } \
    if constexpr (BIAS) { if ((jt) >= lo_w && (jt) <= hi_w) { const int kb_ = P.kpos0 + (jt) * 64, qw_ = P.qpos0 + wid * 32; \
        if (qw_ - (kb_ + 63) >= 128) { const float c_ = tblS[256]; _Pragma("unroll") for (int r = 0; r < 16; ++r) { p0[r] += c_; p1[r] += c_; } } \
        else { const int dq_ = qw_ + r32 - kb_; _Pragma("unroll") for (int r = 0; r < 16; ++r) { int d0_ = dq_ - crow(r, hi), d1_ = d0_ - 32; \
            d0_ = d0_ < -128 ? -128 : (d0_ > 128 ? 128 : d0_); d1_ = d1_ < -128 ? -128 : (d1_ > 128 ? 128 : d1_); p0[r] += tblS[d0_ + 128]; p1[r] += tblS[d1_ + 128]; } } } } \
    } while (0)
    f32x16 pA0, pA1; bf16x8 pa0, pa1, pa2, pa3;
    DMA(0, 0); if (1 < NT) DMA(1, 64);
    if constexpr (BIAS) { if (tid < 257) tblS[tid] = P.tab[tid] * 1.4426950408889634f; }
    if (1 < NT) { if constexpr (KP == 1) asm volatile("s_waitcnt vmcnt(3)" ::: "memory"); else if constexpr (KP == 2) asm volatile("s_waitcnt vmcnt(4)" ::: "memory"); else asm volatile("s_waitcnt vmcnt(5)" ::: "memory"); }
    else asm volatile("s_waitcnt vmcnt(0)" ::: "memory");
    asm volatile("s_waitcnt lgkmcnt(0)\n\ts_barrier" ::: "memory");
    if constexpr (!PIPE2) {
#define FIXUP_H(p, jt, kofs) do { \
    if ((jt) < P.fix_lo || (jt) >= P.fix_hi) { int kv_ = kvalid, lo_ = lo_w, hi_ = hi_w; asm volatile("; masked-tile path" : "+s"(kv_), "+s"(lo_), "+s"(hi_) :: "memory"); \
      if ((jt) < lo_ || (jt) > hi_) { _Pragma("unroll") for (int r = 0; r < 16; ++r) p[r] = NEGINF; } \
      else if (((jt) + 1) * 64 > kv_) { _Pragma("unroll") for (int r = 0; r < 16; ++r) { if ((jt) * 64 + (kofs) + crow(r, hi) >= kv_) p[r] = NEGINF; } } } \
    if constexpr (BIAS) { if ((jt) >= lo_w && (jt) <= hi_w) { const int kb_ = P.kpos0 + (jt) * 64 + (kofs), qw_ = P.qpos0 + wid * 32; \
        if (qw_ - (kb_ + 31) >= 128) { const float c_ = tblS[256]; _Pragma("unroll") for (int r = 0; r < 16; ++r) p[r] += c_; } \
        else { const int dq_ = qw_ + r32 - kb_; _Pragma("unroll") for (int r = 0; r < 16; ++r) { int d0_ = dq_ - crow(r, hi); d0_ = d0_ < -128 ? -128 : (d0_ > 128 ? 128 : d0_); p[r] += tblS[d0_ + 128]; } } } } \
    } while (0)
        static_assert(!PIPE2, "q is pre-scaled: only the half-tile loop is current");
        f32x16 cinit;
#pragma unroll
        for (int r = 0; r < 16; ++r) cinit[r] = negB;
        const bool wave_on = wid * 32 < P.nq;
        int bsel = 0;
        for (int j = 0; j < NT; ++j) {
            const int bn1 = bsel == 2 ? 0 : bsel + 1, bn2 = bn1 == 2 ? 0 : bn1 + 1;
            if (j + 2 < NT) DMA(bn2, (j + 2) * 64);
            if (wave_on && j >= lo_w && j <= hi_w) {
            SBAR(); qkt_h<DQK>(pA0, cinit, K_lds + bsel * SHM_K, 0, qr, r32, hi);
            FIXUP_H(pA0, j, 0);
            SBAR(); qkt_h<DQK>(pA1, cinit, K_lds + bsel * SHM_K, 32, qr, r32, hi); smx_h<DQK>(pA0, negB, l_reg, pa0, pa1);
            FIXUP_H(pA1, j, 32);
            if constexpr (true) {
                VFrag f0, f2; SBAR(); pv_issue<0>(f0, vb0 + bsel * SHM_V); pv_wait(f0); pv_issue<2>(f2, vb0 + bsel * SHM_V);
                pv_mma(o, f0, pa0, pa1); smx_h<DQK>(pA1, negB, l_reg, pa2, pa3);
                SBAR(); pv_wait(f2); pv_mma(o, f2, pa2, pa3); SBAR();
            } else {
            SBAR(); pv_half<0>(o, vb0 + bsel * SHM_V, pa0, pa1); smx_h<DQK>(pA1, negB, l_reg, pa2, pa3);
            SBAR(); pv_half<2>(o, vb0 + bsel * SHM_V, pa2, pa3); SBAR();
            }
            }
            if (j + 2 < NT) { if constexpr (KP == 1) asm volatile("s_waitcnt vmcnt(3) lgkmcnt(0)\n\ts_barrier" ::: "memory"); else if constexpr (KP == 2) asm volatile("s_waitcnt vmcnt(4) lgkmcnt(0)\n\ts_barrier" ::: "memory"); else asm volatile("s_waitcnt vmcnt(5) lgkmcnt(0)\n\ts_barrier" ::: "memory"); }
            else asm volatile("s_waitcnt vmcnt(0) lgkmcnt(0)\n\ts_barrier" ::: "memory");
            bsel = bn1;
        }
#undef FIXUP_H
    }
    { auto rr = __builtin_amdgcn_permlane32_swap(__float_as_uint(l_reg), __float_as_uint(l_reg), false, false); l_reg = __uint_as_float(rr[0]) + __uint_as_float(rr[1]); }
    if (hi == 0) li_l[r32] = l_reg; asm volatile("s_waitcnt lgkmcnt(0)" ::: "memory");
    float rli[16];
#pragma unroll
    for (int r = 0; r < 16; ++r) rli[r] = __builtin_amdgcn_rcpf(li_l[crow(r, hi)]);
    const int nq = P.nq, ldo = P.ldo;
#pragma unroll
    for (int r = 0; r < 16; ++r) { const int orow = wid * 32 + crow(r, hi);
        if (orow < nq) {
            if constexpr (F32OUT) { float* Ow = (float*)P.O + (size_t)orow * ldo + r32;
#pragma unroll
                for (int d0 = 0; d0 < 4; ++d0) Ow[d0 * 32] = o[d0][r] * rli[r]; }
            else { bf16* Ow = (bf16*)P.O + (size_t)orow * ldo + r32;
#pragma unroll
                for (int d0 = 0; d0 < 4; ++d0) Ow[d0 * 32] = (bf16)(cvtpk(o[d0][r] * rli[r], 0.f) & 0xffffu); }
        } }
    __syncthreads();
#undef DMA
#undef FIXUP
}
}

template <class T> __device__ __forceinline__ T* launder(T* p) { asm volatile("" : "+s"(p)); return p; }
struct Frame {
    LAS unsigned char* lds;
    int tid, lane, wave, vcu, G, bx;
    int gw, NGW;
    float* out; unsigned char* ws;
};
struct Args { const float* in[31]; float* out; unsigned char* ws; int ph_lo, ph_hi; int use_bar, pad; };
typedef const __attribute__((address_space(4))) Args* ArgsP;
__device__ __forceinline__ ArgsP fresh_args() { ArgsP p = (ArgsP)__builtin_amdgcn_kernarg_segment_ptr(); asm volatile("" : "+s"(p)); return p; }
enum { I_XP = 0, I_XS, I_CAK, I_CAV, I_CBC, I_CBP, I_CCK, I_CCV, I_ANORM, I_WIN, I_BGATE, I_AQN, I_AKN, I_ALAM, I_ASUB, I_BQAN, I_BKVN, I_WQB, I_WKVB, I_BQN, I_BKN, I_CQN, I_CKN, I_CBIAS,
       I_WBRA, I_WBRB, I_WBRC, I_WO, I_MNORM, I_WUP, I_WDN };

__device__ __forceinline__ void transpose_item(const float* W, int K, int N, bf16* WT, int ldw, int gap_at, int gap, LAS float* scr, int item, int lane) {
    const int nblk = N / 32, kb = item / nblk, nb = item % nblk, k0 = 64 * kb, n0 = 32 * nb;
    float t[32];
#pragma unroll
    for (int i = 0; i < 32; ++i) t[i] = W[(size_t)(k0 + 2 * i + (lane >> 5)) * N + n0 + (lane & 31)];
#pragma unroll
    for (int i = 0; i < 32; ++i) scr[(2 * i + (lane >> 5)) * 33 + (lane & 31)] = t[i];
    LDS_WAIT(); asm volatile("" ::: "memory");
    const int c = lane & 7; const int roff = (n0 >= gap_at) ? gap : 0;
#pragma unroll
    for (int j = 0; j < 4; ++j) { const int n = (lane >> 3) + 8 * j; const LAS float* s = scr + (8 * c) * 33 + n;
        u32x4 o; o.x = cvtpk(s[0 * 33], s[1 * 33]); o.y = cvtpk(s[2 * 33], s[3 * 33]); o.z = cvtpk(s[4 * 33], s[5 * 33]); o.w = cvtpk(s[6 * 33], s[7 * 33]);
        *(u32x4*)(WT + (size_t)(roff + n0 + n) * ldw + k0 + 8 * c) = o; }
    LDS_WAIT(); asm volatile("" ::: "memory");
}

__device__ __forceinline__ void rmsnorm_rows(const Frame& F, ArgsP A, const float* g, bf16* H, bool first, const float* slab, int ns) {
    float* X = F.out + OUT_Y;
    if (!first) {
        LAS float* part = (LAS float*)(F.lds + EPI_OFF);
        for (int rs = F.vcu; rs < MS; rs += F.G) {
            const size_t off = (size_t)rs * DM + 256 * F.wave + 4 * F.lane;
            f32x4 v = *(const f32x4*)(X + (size_t)MP * DM + off);
            const float* sp = slab + off;
            for (int k = 0; k < ns; k += 8) { f32x4 t[8];
#pragma unroll
                for (int q = 0; q < 8; ++q) t[q] = *(const f32x4*)(sp + (size_t)(k + q) * MS * DM);
#pragma unroll
                for (int q = 0; q < 8; ++q) v += t[q]; }
            const float ps = wave_sum((v.x * v.x + v.y * v.y) + (v.z * v.z + v.w * v.w));
            __syncthreads();
            if (F.lane == 0) part[F.wave] = ps;
            __syncthreads();
            float tot = 0.f;
#pragma unroll
            for (int w = 0; w < 8; ++w) tot += part[w];
            const float rstd = rsqrtf(tot * (1.f / DM) + EPS);
            const f32x4 gg = *(const f32x4*)(g + 256 * F.wave + 4 * F.lane);
            u32x2 w; w.x = cvtpk(v.x * rstd * gg.x, v.y * rstd * gg.y); w.y = cvtpk(v.z * rstd * gg.z, v.w * rstd * gg.w);
            *(u32x2*)(H + (size_t)MP * DM + off) = w;
            *(f32x4*)(X + (size_t)MP * DM + off) = v;
        }
    }
    constexpr int RU = 4;
    const int Rn = first ? M : MP;
    f32x4 gg[8];
#pragma unroll
    for (int j = 0; j < 8; ++j) gg[j] = *(const f32x4*)(g + 4 * F.lane + 256 * j);
    for (int row0 = F.gw; row0 < Rn; row0 += RU * F.NGW) {
        f32x4 v[RU][8];
#pragma unroll
        for (int u = 0; u < RU; ++u) { const int row = row0 + u * F.NGW;
            if (row < Rn) { const float* xr = first ? (row < MP ? A->in[I_XP] + (size_t)row * DM : A->in[I_XS] + (size_t)(row - MP) * DM) : X + (size_t)row * DM;
#pragma unroll
                for (int j = 0; j < 8; ++j) v[u][j] = *(const f32x4*)(xr + 4 * F.lane + 256 * j); } }
#pragma unroll
        for (int u = 0; u < RU; ++u) { const int row = row0 + u * F.NGW;
            if (row < Rn) {
                float ss = 0.f;
#pragma unroll
                for (int j = 0; j < 8; ++j) ss += (v[u][j].x * v[u][j].x + v[u][j].y * v[u][j].y) + (v[u][j].z * v[u][j].z + v[u][j].w * v[u][j].w);
                const float rstd = rsqrtf(wave_sum(ss) * (1.f / DM) + EPS);
#pragma unroll
                for (int j = 0; j < 8; ++j) {
                    u32x2 w; w.x = cvtpk(v[u][j].x * rstd * gg[j].x, v[u][j].y * rstd * gg[j].y); w.y = cvtpk(v[u][j].z * rstd * gg[j].z, v[u][j].w * rstd * gg[j].w);
                    *(u32x2*)(H + (size_t)row * DM + 4 * F.lane + 256 * j) = w;
                    if (first) *(f32x4*)(X + (size_t)row * DM + 4 * F.lane + 256 * j) = v[u][j]; } } }
    }
}
__device__ __forceinline__ void final_combine(const Frame& F, const float* slab, int ns) {
    float* X = F.out + OUT_Y;
    for (int rs = F.vcu; rs < MS; rs += F.G) {
        const size_t off = (size_t)rs * DM + 256 * F.wave + 4 * F.lane;
        f32x4 v = *(const f32x4*)(X + (size_t)MP * DM + off);
        const float* sp = slab + off;
        for (int k = 0; k < ns; k += 8) { f32x4 t[8];
#pragma unroll
            for (int q = 0; q < 8; ++q) t[q] = *(const f32x4*)(sp + (size_t)(k + q) * MS * DM);
#pragma unroll
            for (int q = 0; q < 8; ++q) v += t[q]; }
        *(f32x4*)(X + (size_t)MP * DM + off) = v;
    }
}
__device__ __forceinline__ void pre_weights(const Frame& F, ArgsP A, int l, unsigned char* wsw, int gw, int NGW, int it_lo = 0, int it_hi = 1 << 30) {
    LAS float* scr = (LAS float*)(F.lds + F.wave * 16384);
    constexpr int I_IN = (DM / 64) * (INCOLS / 32), I_QB = (512 / 64) * (1536 / 32), I_KVB = (256 / 64) * (2048 / 32), I_BA = (512 / 64) * (DM / 32), I_BB = (1024 / 64) * (DM / 32),
                  I_O = (DM / 64) * (DM / 32), I_UP = (DM / 64) * (DFF / 32), I_DN = (DFF / 64) * (DM / 32);
    constexpr int NITEMS = I_IN + I_QB + I_KVB + 2 * I_BA + I_BB + I_O + I_UP + I_DN;
    const int it_end = it_hi < NITEMS ? it_hi : NITEMS;
    for (int it = it_lo + gw; it < it_end; it += NGW) {
        int r = it;
        if (r < I_IN) { transpose_item(A->in[I_WIN] + (size_t)l * DM * INCOLS, DM, INCOLS, (bf16*)(wsw + WS_WIN), DM, 2368, 192, scr, r, F.lane); continue; } r -= I_IN;
        if (r < I_QB) { transpose_item(A->in[I_WQB] + (size_t)l * 512 * 1536, 512, 1536, (bf16*)(wsw + WS_WQB), 512, 1 << 30, 0, scr, r, F.lane); continue; } r -= I_QB;
        if (r < I_KVB) { transpose_item(A->in[I_WKVB] + (size_t)l * 256 * 2048, 256, 2048, (bf16*)(wsw + WS_WKVB), 256, 1 << 30, 0, scr, r, F.lane); continue; } r -= I_KVB;
        if (r < I_BA) { transpose_item(A->in[I_WBRA] + (size_t)l * 512 * DM, 512, DM, (bf16*)(wsw + WS_WBR), DM, 1 << 30, 0, scr, r, F.lane); continue; } r -= I_BA;
        if (r < I_BB) { transpose_item(A->in[I_WBRB] + (size_t)l * 1024 * DM, 1024, DM, (bf16*)(wsw + WS_WBR) + 512, DM, 1 << 30, 0, scr, r, F.lane); continue; } r -= I_BB;
        if (r < I_BA) { transpose_item(A->in[I_WBRC] + (size_t)l * 512 * DM, 512, DM, (bf16*)(wsw + WS_WBR) + 1536, DM, 1 << 30, 0, scr, r, F.lane); continue; } r -= I_BA;
        if (r < I_O) { transpose_item(A->in[I_WO] + (size_t)l * DM * DM, DM, DM, (bf16*)(wsw + WS_WO), DM, 1 << 30, 0, scr, r, F.lane); continue; } r -= I_O;
        if (r < I_UP) { transpose_item(A->in[I_WUP] + (size_t)l * DM * DFF, DM, DFF, (bf16*)(wsw + WS_WUP), DM, 1 << 30, 0, scr, r, F.lane); continue; } r -= I_UP;
        transpose_item(A->in[I_WDN] + (size_t)l * DFF * DM, DFF, DM, (bf16*)(wsw + WS_WDN), DFF, 1 << 30, 0, scr, r, F.lane);
    }
    const int gt = gw * 64 + F.lane, NGT = NGW * 64;
    if (it_lo == 0) {
        bf16* wz = (bf16*)(wsw + WS_WIN) + (size_t)2368 * DM;
        for (int i = gt; i < 192 * DM / 8; i += NGT) *(u32x4*)(wz + (size_t)i * 8) = (u32x4){0u, 0u, 0u, 0u};
    }
}
__device__ __forceinline__ void pre_caches(const Frame& F, ArgsP A, int l, int gw, int NGW) {
    unsigned char* ws = F.ws; const int gt = gw * 64 + F.lane, NGT = NGW * 64;
    {
        bf16* KA = (bf16*)(ws + WS_KA); bf16* VA = (bf16*)(ws + WS_VA); bf16* CKV = (bf16*)(ws + WS_CKV); float* KPE = (float*)(ws + WS_KPE); bf16* KC = (bf16*)(ws + WS_KC); bf16* VC = (bf16*)(ws + WS_VC);
        const float* cak = A->in[I_CAK] + (size_t)l * DECB * PAST * 512; const float* cav = A->in[I_CAV] + (size_t)l * DECB * PAST * 512;
        const float* cbc = A->in[I_CBC] + (size_t)l * DECB * PAST * 256; const float* cbp = A->in[I_CBP] + (size_t)l * DECB * PAST * 64;
        const float* cck = A->in[I_CCK] + (size_t)l * DECB * CPAST * 512; const float* ccv = A->in[I_CCV] + (size_t)l * DECB * CPAST * 512;
        for (int i0 = gt; i0 < DECB * PAST * 512 / 8; i0 += 4 * NGT) { f32x4 ka[4][2], va[4][2];
#pragma unroll
            for (int u = 0; u < 4; ++u) { const int i = i0 + u * NGT; if (i < DECB * PAST * 512 / 8) { const float* pk = cak + (size_t)i * 8; const float* pv = cav + (size_t)i * 8;
                ka[u][0] = *(const f32x4*)pk; ka[u][1] = *(const f32x4*)(pk + 4); va[u][0] = *(const f32x4*)pv; va[u][1] = *(const f32x4*)(pv + 4); } }
#pragma unroll
            for (int u = 0; u < 4; ++u) { const int i = i0 + u * NGT; if (i < DECB * PAST * 512 / 8) { const int c = (i & 63) * 8, rr = i >> 6, b = rr >> 11, p = rr & 2047; const size_t d = ((size_t)MP + b * SROWS + p) * 512 + c;
                *(u32x4*)(KA + d) = pg8::pk8(ka[u][0], ka[u][1]); *(u32x4*)(VA + d) = pg8::pk8(va[u][0], va[u][1]); } } }
        for (int i0 = gt; i0 < DECB * PAST * 256 / 8; i0 += 4 * NGT) { f32x4 ka[4][2];
#pragma unroll
            for (int u = 0; u < 4; ++u) { const int i = i0 + u * NGT; if (i < DECB * PAST * 256 / 8) { const float* pk = cbc + (size_t)i * 8; ka[u][0] = *(const f32x4*)pk; ka[u][1] = *(const f32x4*)(pk + 4); } }
#pragma unroll
            for (int u = 0; u < 4; ++u) { const int i = i0 + u * NGT; if (i < DECB * PAST * 256 / 8) { const int c = (i & 31) * 8, rr = i >> 5, b = rr >> 11, p = rr & 2047; const size_t d = ((size_t)MP + b * SROWS + p) * 256 + c;
                *(u32x4*)(CKV + d) = pg8::pk8(ka[u][0], ka[u][1]); } } }
        for (int i = gt; i < DECB * PAST * 64 / 8; i += NGT) { const int c = (i & 7) * 8, rr = i >> 3, b = rr >> 11, p = rr & 2047; const size_t d = ((size_t)MP + b * SROWS + p) * 64 + c;
            float v[8]; ld8f(cbp + (size_t)i * 8, v); st8f(KPE + d, v); }
        for (int i0 = gt; i0 < DECB * CPAST * 512 / 8; i0 += 4 * NGT) { f32x4 ka[4][2], va[4][2];
#pragma unroll
            for (int u = 0; u < 4; ++u) { const int i = i0 + u * NGT; if (i < DECB * CPAST * 512 / 8) { const float* pk = cck + (size_t)i * 8; const float* pv = ccv + (size_t)i * 8;
                ka[u][0] = *(const f32x4*)pk; ka[u][1] = *(const f32x4*)(pk + 4); va[u][0] = *(const f32x4*)pv; va[u][1] = *(const f32x4*)(pv + 4); } }
#pragma unroll
            for (int u = 0; u < 4; ++u) { const int i = i0 + u * NGT; if (i < DECB * CPAST * 512 / 8) { const int c = (i & 63) * 8, rr = i >> 6, b = rr >> 9, p = rr & 511; const size_t d = ((size_t)MP + b * CROWS + p) * 512 + c;
                *(u32x4*)(KC + d) = pg8::pk8(ka[u][0], ka[u][1]); *(u32x4*)(VC + d) = pg8::pk8(va[u][0], va[u][1]); } } }
        const u32x4 z4 = (u32x4){0u, 0u, 0u, 0u};
        for (int i = gt; i < DECB * 112 * 64; i += NGT) { const int c = (i & 63) * 8, rr = i >> 6, b = rr / 112, p = rr % 112;
            const size_t d = ((size_t)MP + b * SROWS + PAST + DECS + p) * 512 + c; *(u32x4*)(KA + d) = z4; *(u32x4*)(VA + d) = z4;
            const size_t dc = ((size_t)MP + b * CROWS + CPAST + DECS + p) * 512 + c; *(u32x4*)(KC + dc) = z4; *(u32x4*)(VC + dc) = z4; }
        for (int i = gt; i < DECB * 112 * 32; i += NGT) { const int c = (i & 31) * 8, rr = i >> 5, b = rr / 112, p = rr % 112;
            const size_t d = ((size_t)MP + b * SROWS + PAST + DECS + p) * 256 + c; *(u32x4*)(CKV + d) = z4; }
        for (int i = gt; i < DECB * 112 * 16; i += NGT) { const int c = (i & 15) * 4, rr = i >> 4, b = rr / 112, p = rr % 112;
            const size_t d = ((size_t)MP + b * SROWS + PAST + DECS + p) * 64 + c; *(f32x4*)(KPE + d) = (f32x4){0.f, 0.f, 0.f, 0.f}; }
    }
}
constexpr size_t WS_SLAB_O = WS_R2, WS_SLAB_DN = WS_R2 + 64 * MiB;
constexpr int NS_O = 16, NS_DN = 32;
static_assert(NS_O % 8 == 0 && NS_DN % 8 == 0 && (size_t)NS_O * MS * DM * 4 <= 64 * MiB && (size_t)NS_DN * MS * DM * 4 <= 64 * MiB && WS_SLAB_DN + 64 * MiB <= WS_OALL, "slabs");
constexpr int WCUT1 = 13000, WCUT2 = 26500;
constexpr size_t WS_WSET1 = 1823 * MiB;
static_assert(WS_WDN + WS_WSET1 + (size_t)DM * DFF * 2 <= 2032 * MiB && WS_WIN + WS_WSET1 >= WS_END, "second weight set");
__device__ __forceinline__ void phase_pre(const Frame& F, ArgsP A, int l) {
    if (l == 0) { pre_weights(F, A, 0, F.ws, F.gw, F.NGW); pre_caches(F, A, 0, F.gw, F.NGW); }
    rmsnorm_rows(F, A, A->in[I_ANORM] + (size_t)l * DM, (bf16*)(F.ws + WS_R3), l == 0, (const float*)(F.ws + WS_SLAB_DN), NS_DN);
}

__device__ __forceinline__ float rope_inv(int lane) { return __builtin_amdgcn_exp2f(-(float)(lane & 31) * (18.931568569324174f / 32.f)); }
__device__ __forceinline__ void rope_cs(int pos, float inv, float& cs, float& sn) {
    const float a = (float)pos * inv; const float k = rintf(a * 0.15915494309189535f);
    float r = fmaf(-k, 6.28125f, a); r = fmaf(-k, 1.9353071795864769e-3f, r);
    const float rev = r * 0.15915494309189535f;
    cs = __builtin_amdgcn_cosf(rev); sn = __builtin_amdgcn_sinf(rev);
}

__device__ __forceinline__ void phase_post_in(const Frame& F, ArgsP A, int l) {
    unsigned char* ws = F.ws; const int lane = F.lane;
    const bf16* Z = (const bf16*)(ws + WS_R1);
    bf16* QA = (bf16*)(ws + WS_QA); bf16* KA = (bf16*)(ws + WS_KA); bf16* VA = (bf16*)(ws + WS_VA); bf16* CQ = (bf16*)(ws + WS_CQ); bf16* CKV = (bf16*)(ws + WS_CKV); float* KPE = (float*)(ws + WS_KPE);
    bf16* QC = (bf16*)(ws + WS_QC); bf16* KC = (bf16*)(ws + WS_KC); bf16* VC = (bf16*)(ws + WS_VC);
    const float inv = rope_inv(lane);
    float gq[8], gk[8], gqa[8], gkv[8], gcq[8], gck[8];
    ld8f(A->in[I_AQN] + l * 64 + 8 * (lane & 7), gq); ld8f(A->in[I_AKN] + l * 64 + 8 * (lane & 7), gk);
    ld8f(A->in[I_BQAN] + l * 512 + 8 * lane, gqa); ld8f(A->in[I_BKVN] + l * 256 + 8 * (lane & 31), gkv);
    ld8f(A->in[I_CQN] + l * 128 + 8 * (lane & 15), gcq); ld8f(A->in[I_CKN] + l * 128 + 8 * (lane & 15), gck);
    u32x4 zc[8], zn[8];
    if (F.gw < M) {
#pragma unroll
        for (int q = 0; q < 8; ++q) zc[q] = *(const u32x4*)(Z + (size_t)F.gw * NZ + 8 * lane + 512 * q); }
    for (int row = F.gw; row < M; row += F.NGW) {
        { const int nrow = row + F.NGW;
          if (nrow < M) {
#pragma unroll
              for (int q = 0; q < 8; ++q) zn[q] = *(const u32x4*)(Z + (size_t)nrow * NZ + 8 * lane + 512 * q); } }
        const bool samp = row >= MP; int b, t, pos;
        if (!samp) { b = row >> 14; t = row & (SEQ - 1); pos = t; } else { const int r = row - MP; b = r >> 4; t = r & 15; pos = PAST + t; }
        const size_t kvrow = samp ? (size_t)MP + b * SROWS + PAST + t : (size_t)row;
        const size_t ccrow = samp ? (size_t)MP + b * CROWS + CPAST + t : (size_t)row;
        float* o_ak = F.out + (samp ? OUT_AK_S + ((size_t)l * MS + (row - MP)) * 512 : OUT_AK_P + ((size_t)l * MP + row) * 512) + 8 * lane;
        float* o_av = F.out + (samp ? OUT_AV_S + ((size_t)l * MS + (row - MP)) * 512 : OUT_AV_P + ((size_t)l * MP + row) * 512) + 8 * lane;
        float* o_bc = F.out + (samp ? OUT_BC_S + ((size_t)l * MS + (row - MP)) * 256 : OUT_BC_P + ((size_t)l * MP + row) * 256) + 8 * (lane & 31);
        float* o_bp = F.out + (samp ? OUT_BP_S + ((size_t)l * MS + (row - MP)) * 64 : OUT_BP_P + ((size_t)l * MP + row) * 64) + 8 * (lane & 7);
        const bool cout = samp || t >= SEQ - 512;
        float* o_ck = F.out + (samp ? OUT_CK_S + ((size_t)l * MS + (row - MP)) * 512 : OUT_CK_P + (((size_t)l * NBATCH + b) * 512 + (t - (SEQ - 512))) * 512) + 8 * lane;
        float* o_cv = F.out + (samp ? OUT_CV_S + ((size_t)l * MS + (row - MP)) * 512 : OUT_CV_P + (((size_t)l * NBATCH + b) * 512 + (t - (SEQ - 512))) * 512) + 8 * lane;
        float cs, sn; rope_cs(pos, inv, cs, sn);
        float v[8], y[8];
#pragma unroll
        for (int seg = 0; seg < 2; ++seg) {
            unpack8(zc[seg], v);
            float ss = sumsq8(v); ss += __shfl_xor(ss, 1); ss += __shfl_xor(ss, 2); ss += __shfl_xor(ss, 4);
            const float rstd = rsqrtf(ss * (1.f / 64) + EPS);
#pragma unroll
            for (int e = 0; e < 8; ++e) y[e] = v[e] * rstd * (seg == 0 ? gq[e] : gk[e]);
#pragma unroll
            for (int e = 0; e < 8; ++e) { const float part = __shfl_xor(y[e], 1), c = __shfl(cs, 4 * e), s = __shfl(sn, 4 * e);
                if ((lane & 7) == 0) y[e] = y[e] * c - part * s; else if ((lane & 7) == 1) y[e] = y[e] * c + part * s; }
            if (seg == 0) { float yq[8];
#pragma unroll
                for (int e = 0; e < 8; ++e) yq[e] = y[e] * att::Cn<64>::C;
                *(u32x4*)(QA + (size_t)row * 512 + 8 * lane) = pack8(yq); }
            else { *(u32x4*)(KA + kvrow * 512 + 8 * lane) = pack8(y); st8f_nt(o_ak, y); }
        }
        { const u32x4 w = zc[2]; *(u32x4*)(VA + kvrow * 512 + 8 * lane) = w; unpack8(w, v); st8f_nt(o_av, v); }
        { unpack8(zc[3], v); const float rstd = rsqrtf(wave_sum(sumsq8(v)) * (1.f / 512) + EPS);
#pragma unroll
          for (int e = 0; e < 8; ++e) y[e] = v[e] * rstd * gqa[e];
          *(u32x4*)(CQ + (size_t)row * 512 + 8 * lane) = pack8(y); }
        { unpack8(zc[4], v);
          float ss = sumsq8(v); ss += __shfl_xor(ss, 1); ss += __shfl_xor(ss, 2); ss += __shfl_xor(ss, 4); ss += __shfl_xor(ss, 8); ss += __shfl_xor(ss, 16);
          const float rstd = rsqrtf(ss * (1.f / 256) + EPS);
          const int i = lane & 7;
#pragma unroll
          for (int e = 0; e < 8; ++e) { const float part = __shfl_xor(v[e], 4); const int fi = 8 * (i & 3) + e; const float c = __shfl(cs, fi), s = __shfl(sn, fi);
              y[e] = (lane < 32) ? v[e] * rstd * gkv[e] : ((i < 4) ? v[e] * c - part * s : v[e] * c + part * s); }
          if (lane < 32) { *(u32x4*)(CKV + kvrow * 256 + 8 * lane) = pack8(y); st8f_nt(o_bc, y); }
          else if (lane < 40) { st8f(KPE + kvrow * 64 + 8 * i, y); st8f_nt(o_bp, y); } }
#pragma unroll
        for (int seg = 0; seg < 2; ++seg) {
            unpack8(zc[5 + seg], v);
            float ss = sumsq8(v); ss += __shfl_xor(ss, 1); ss += __shfl_xor(ss, 2); ss += __shfl_xor(ss, 4); ss += __shfl_xor(ss, 8);
            const float rstd = rsqrtf(ss * (1.f / 128) + EPS);
#pragma unroll
            for (int e = 0; e < 8; ++e) y[e] = v[e] * rstd * (seg == 0 ? gcq[e] * att::Cn<128>::C : gck[e]);
            if (seg == 0) *(u32x4*)(QC + (size_t)row * 512 + 8 * lane) = pack8(y);
            else { *(u32x4*)(KC + ccrow * 512 + 8 * lane) = pack8(y); if (cout) st8f_nt(o_ck, y); }
        }
        { const u32x4 w = zc[7]; *(u32x4*)(VC + ccrow * 512 + 8 * lane) = w; if (cout) { unpack8(w, v); st8f_nt(o_cv, v); } }
#pragma unroll
        for (int q = 0; q < 8; ++q) zc[q] = zn[q];
    }
}

__device__ __forceinline__ void phase_post_b(const Frame& F, ArgsP A, int l) {
    unsigned char* ws = F.ws; const int lane = F.lane, h = lane >> 3, i = lane & 7;
    const bf16* QBR = (const bf16*)(ws + WS_R2); const bf16* KVR = (const bf16*)(ws + WS_R1); const float* KPE = (const float*)(ws + WS_KPE);
    bf16* QB = (bf16*)(ws + WS_QB); bf16* KB = (bf16*)(ws + WS_R3);
    const float inv = rope_inv(lane);
    float g0[8], g1[8], g2[8];
    ld8f(A->in[I_BQN] + l * 192 + 8 * i, g0); ld8f(A->in[I_BQN] + l * 192 + 64 + 8 * i, g1); ld8f(A->in[I_BQN] + l * 192 + 128 + 8 * i, g2);
    constexpr int RU = 4;
    for (int row0 = F.gw; row0 < M; row0 += RU * F.NGW) {
        u32x4 w0[RU], w1[RU], w2[RU];
#pragma unroll
        for (int u = 0; u < RU; ++u) { const int row = row0 + u * F.NGW;
            if (row < M) { const bf16* src = QBR + (size_t)row * 1536 + 192 * h + 8 * i; w0[u] = *(const u32x4*)src; w1[u] = *(const u32x4*)(src + 64); w2[u] = *(const u32x4*)(src + 128); } }
#pragma unroll
        for (int u = 0; u < RU; ++u) { const int row = row0 + u * F.NGW;
            if (row < M) {
                const int pos = row < MP ? (row & (SEQ - 1)) : PAST + ((row - MP) & 15);
                float cs, sn; rope_cs(pos, inv, cs, sn);
                float v0[8], v1[8], v2[8]; unpack8(w0[u], v0); unpack8(w1[u], v1); unpack8(w2[u], v2);
#pragma unroll
                for (int e = 0; e < 8; ++e) { const float part = __shfl_xor(v2[e], 4); const int fi = 8 * (i & 3) + e; const float c = __shfl(cs, fi), s = __shfl(sn, fi);
                    v2[e] = (i < 4) ? v2[e] * c - part * s : v2[e] * c + part * s; }
                float ss = sumsq8(v0) + sumsq8(v1) + sumsq8(v2); ss += __shfl_xor(ss, 1); ss += __shfl_xor(ss, 2); ss += __shfl_xor(ss, 4);
                const float rstd = rsqrtf(ss * (1.f / 192) + EPS);
#pragma unroll
                for (int e = 0; e < 8; ++e) { v0[e] *= rstd * g0[e] * att::Cn<192>::C; v1[e] *= rstd * g1[e] * att::Cn<192>::C; v2[e] *= rstd * g2[e] * att::Cn<192>::C; }
                bf16* dst = QB + (size_t)row * 1536 + 192 * h + 8 * i;
                *(u32x4*)dst = pack8(v0); *(u32x4*)(dst + 64) = pack8(v1); *(u32x4*)(dst + 128) = pack8(v2); } }
    }
    ld8f(A->in[I_BKN] + l * 192 + 8 * i, g0); ld8f(A->in[I_BKN] + l * 192 + 64 + 8 * i, g1); ld8f(A->in[I_BKN] + l * 192 + 128 + 8 * i, g2);
    for (int row0 = F.gw; row0 < M2; row0 += RU * F.NGW) {
        u32x4 w0[RU], w1[RU]; f32x4 p0[RU], p1[RU];
#pragma unroll
        for (int u = 0; u < RU; ++u) { const int row = row0 + u * F.NGW;
            if (row < M2) { const bf16* src = KVR + (size_t)row * 2048 + 256 * h + 8 * i; w0[u] = *(const u32x4*)src; w1[u] = *(const u32x4*)(src + 64);
                const float* kp = KPE + (size_t)row * 64 + 8 * i; p0[u] = *(const f32x4*)kp; p1[u] = *(const f32x4*)(kp + 4); } }
#pragma unroll
        for (int u = 0; u < RU; ++u) { const int row = row0 + u * F.NGW;
            if (row < M2) {
                float v0[8], v1[8], v2[8]; unpack8(w0[u], v0); unpack8(w1[u], v1);
                v2[0] = p0[u].x; v2[1] = p0[u].y; v2[2] = p0[u].z; v2[3] = p0[u].w; v2[4] = p1[u].x; v2[5] = p1[u].y; v2[6] = p1[u].z; v2[7] = p1[u].w;
                float ss = sumsq8(v0) + sumsq8(v1) + sumsq8(v2); ss += __shfl_xor(ss, 1); ss += __shfl_xor(ss, 2); ss += __shfl_xor(ss, 4);
                const float rstd = rsqrtf(ss * (1.f / 192) + EPS);
#pragma unroll
                for (int e = 0; e < 8; ++e) { v0[e] *= rstd * g0[e]; v1[e] *= rstd * g1[e]; v2[e] *= rstd * g2[e]; }
                bf16* dst = KB + (size_t)row * 1536 + 192 * h + 8 * i;
                *(u32x4*)dst = pack8(v0); *(u32x4*)(dst + 64) = pack8(v1); *(u32x4*)(dst + 128) = pack8(v2); } }
    }
}

__device__ __forceinline__ void phase_post_a(const Frame& F, ArgsP A, int l) {
    unsigned char* ws = F.ws; const int lane = F.lane, h = lane >> 4, i = lane & 15;
    const float* OAR = (const float*)(ws + WS_R2); bf16* OA = (bf16*)(ws + WS_OALL);
    const float* lf = A->in[I_ALAM] + l * 256;
    const float s1 = wave_sum(lf[lane] * lf[64 + lane]), s2 = wave_sum(lf[128 + lane] * lf[192 + lane]);
    const float lam_init = 0.8f - 0.6f * expf(-0.3f * (float)l);
    const float lam = expf(s1) - expf(s2) + lam_init, og = 1.f - lam_init;
    float g[8]; ld8f(A->in[I_ASUB] + l * 128 + 8 * i, g);
    constexpr int RU = 4;
    for (int row0 = F.gw; row0 < M; row0 += RU * F.NGW) {
        f32x4 a0[RU], a1[RU], b0[RU], b1[RU];
#pragma unroll
        for (int u = 0; u < RU; ++u) { const int row = row0 + u * F.NGW;
            if (row < M) { const float* src = OAR + (size_t)row * 1024 + 256 * h + 8 * i; a0[u] = *(const f32x4*)src; a1[u] = *(const f32x4*)(src + 4); b0[u] = *(const f32x4*)(src + 128); b1[u] = *(const f32x4*)(src + 132); } }
#pragma unroll
        for (int u = 0; u < RU; ++u) { const int row = row0 + u * F.NGW;
            if (row < M) {
                float d[8];
                d[0] = a0[u].x - lam * b0[u].x; d[1] = a0[u].y - lam * b0[u].y; d[2] = a0[u].z - lam * b0[u].z; d[3] = a0[u].w - lam * b0[u].w;
                d[4] = a1[u].x - lam * b1[u].x; d[5] = a1[u].y - lam * b1[u].y; d[6] = a1[u].z - lam * b1[u].z; d[7] = a1[u].w - lam * b1[u].w;
                float ss = sumsq8(d); ss += __shfl_xor(ss, 1); ss += __shfl_xor(ss, 2); ss += __shfl_xor(ss, 4); ss += __shfl_xor(ss, 8);
                const float rstd = rsqrtf(ss * (1.f / 128) + EPS) * og;
#pragma unroll
                for (int e = 0; e < 8; ++e) d[e] *= rstd * g[e];
                *(u32x4*)(OA + (size_t)row * 2048 + 128 * h + 8 * i) = pack8(d); } }
    }
}

__device__ __forceinline__ float wave_absmax(const float* g, int n, int lane) {
    float m = 0.f;
    for (int i = lane; i < n; i += 64) m = fmaxf(m, fabsf(g[i]));
#pragma unroll
    for (int o = 1; o < 64; o <<= 1) m = fmaxf(m, __shfl_xor(m, o));
    return __uint_as_float(__builtin_amdgcn_readfirstlane(__float_as_uint(m)));
}
__device__ __forceinline__ void phase_attn(const Frame& F, ArgsP A, int l) {
    unsigned char* ws = F.ws; LAS char* lds = (LAS char*)F.lds;
    const bf16* QA = (const bf16*)(ws + WS_QA); const bf16* KA = (const bf16*)(ws + WS_KA); const bf16* VA = (const bf16*)(ws + WS_VA);
    const bf16* QB = (const bf16*)(ws + WS_QB); const bf16* KB = (const bf16*)(ws + WS_R3); const bf16* KVR = (const bf16*)(ws + WS_R1);
    const bf16* QC = (const bf16*)(ws + WS_QC); const bf16* KC = (const bf16*)(ws + WS_KC); const bf16* VC = (const bf16*)(ws + WS_VC);
    float* OAR = (float*)(ws + WS_R2); bf16* OB = (bf16*)(ws + WS_OALL) + 512; bf16* OC = (bf16*)(ws + WS_OALL) + 1536;
    const float negB_A = -1.4426950408889634f * 1.02f * 8.f * wave_absmax(A->in[I_AQN] + l * 64, 64, F.lane) * wave_absmax(A->in[I_AKN] + l * 64, 64, F.lane);
    const float negB_B = -1.4426950408889634f * 1.02f * 13.856406460551018f * wave_absmax(A->in[I_BQN] + l * 192, 192, F.lane) * wave_absmax(A->in[I_BKN] + l * 192, 192, F.lane);
    const float negB_C = -1.4426950408889634f * (1.02f * 11.313708498984761f * wave_absmax(A->in[I_CQN] + l * 128, 128, F.lane) * wave_absmax(A->in[I_CKN] + l * 128, 128, F.lane)
                                                + wave_absmax(A->in[I_CBIAS] + (size_t)l * 4 * 257, 4 * 257, F.lane));
#ifndef ATTM
#define ATTM 7
#endif
    if (ATTM & 1) for (int n = F.vcu; n < 1024 + 128; n += F.G) {
        att::UnitP P; P.ldq = 512; P.ldk = 512; P.ldv = 512; P.ldo = 1024; P.qpos0 = 0; P.kpos0 = 0; P.tab = nullptr; P.lo_base = 0; P.lo_step = 0;
        if (n < 1024) { const int v = n & 255, slot = n >> 8, x = v >> 5, j = v & 31, combo = 2 * x + (slot >> 1), b = combo >> 3, vh = combo & 7, i = (slot & 1) ? j : 63 - j;
            const size_t qrow = (size_t)b * SEQ + 256 * i, krow = (size_t)b * SEQ;
            P.Q = QA + qrow * 512 + 64 * vh; P.nq = 256; P.K = KA + krow * 512 + 64 * vh; P.V = VA + krow * 512 + 128 * (vh >> 1); P.O = OAR + qrow * 1024 + 128 * vh;
            P.NT = 4 * i + 4; P.kvalid = P.NT * 64; P.hi_base = 4 * i; P.hi_step = 1; P.fix_lo = 0; P.fix_hi = P.NT - 3;
        } else { const int s = n - 1024, b = s >> 3, vh = s & 7; const size_t qrow = (size_t)MP + 16 * b, krow = (size_t)MP + (size_t)b * SROWS;
            P.Q = QA + qrow * 512 + 64 * vh; P.nq = 16; P.K = KA + krow * 512 + 64 * vh; P.V = VA + krow * 512 + 128 * (vh >> 1); P.O = OAR + qrow * 1024 + 128 * vh;
            P.NT = SROWS / 64; P.kvalid = PAST + DECS; P.hi_base = SROWS / 64; P.hi_step = 0; P.fix_lo = 0; P.fix_hi = (PAST + DECS) / 64; }
        P.negB = negB_A; att::attn_unit<64, true, false, false>(P, lds);
    }
    if (ATTM & 2) for (int n = F.vcu; n < 1024 + 256; n += F.G) {
        att::UnitP P; P.ldq = 1536; P.ldk = 1536; P.ldv = 2048; P.ldo = 2048; P.qpos0 = 0; P.kpos0 = 0; P.tab = nullptr; P.lo_base = 0; P.lo_step = 0;
        if (n < 1024) { const int v = n & 255, slot = n >> 8, x = v >> 5, j = v & 31, combo = 2 * x + (slot >> 1), b = combo >> 3, hh = combo & 7, i = (slot & 1) ? j : 63 - j;
            const size_t qrow = (size_t)b * SEQ + 256 * i, krow = (size_t)b * SEQ;
            P.Q = QB + qrow * 1536 + 192 * hh; P.nq = 256; P.K = KB + krow * 1536 + 192 * hh; P.V = KVR + krow * 2048 + 256 * hh + 128; P.O = OB + qrow * 2048 + 128 * hh;
            P.NT = 4 * i + 4; P.kvalid = P.NT * 64; P.hi_base = 4 * i; P.hi_step = 1; P.fix_lo = 0; P.fix_hi = P.NT - 3;
        } else { const int s = n - 1024 - 128; if (s < 0) continue; const int b = s >> 3, hh = s & 7; const size_t qrow = (size_t)MP + 16 * b, krow = (size_t)MP + (size_t)b * SROWS;
            P.Q = QB + qrow * 1536 + 192 * hh; P.nq = 16; P.K = KB + krow * 1536 + 192 * hh; P.V = KVR + krow * 2048 + 256 * hh + 128; P.O = OB + qrow * 2048 + 128 * hh;
            P.NT = SROWS / 64; P.kvalid = PAST + DECS; P.hi_base = SROWS / 64; P.hi_step = 0; P.fix_lo = 0; P.fix_hi = (PAST + DECS) / 64; }
        P.negB = negB_B; att::attn_unit<192, false, false, false>(P, lds);
    }
    if (ATTM & 4) for (int n = F.vcu; n < 512 + 64; n += F.G) {
        att::UnitP P; P.ldq = 512; P.ldk = 512; P.ldv = 512; P.ldo = 2048;
        if (n < 512) { const int v = n & 255, slot = n >> 8, x = v >> 5, j = v & 31, b = x >> 2, hh = x & 3, i = j + 32 * slot, c0 = 4 * i, T0 = c0 >= 8 ? c0 - 8 : 0;
            const size_t qrow = (size_t)b * SEQ + 256 * i, krow = (size_t)b * SEQ + 64 * T0;
            P.Q = QC + qrow * 512 + 128 * hh; P.nq = 256; P.K = KC + krow * 512 + 128 * hh; P.V = VC + krow * 512 + 128 * hh; P.O = OC + qrow * 2048 + 128 * hh;
            P.NT = c0 + 4 - T0; P.kvalid = P.NT * 64; P.hi_base = c0 - T0; P.hi_step = 1; P.lo_base = c0 - 8 - T0; P.lo_step = 1; P.qpos0 = 256 * i; P.kpos0 = 64 * T0; P.fix_lo = 3; P.fix_hi = P.NT - 3;
            P.tab = A->in[I_CBIAS] + ((size_t)l * 4 + hh) * 257;
        } else { const int s = n - 512, b = s >> 2, hh = s & 3; const size_t qrow = (size_t)MP + 16 * b, krow = (size_t)MP + (size_t)b * CROWS;
            P.Q = QC + qrow * 512 + 128 * hh; P.nq = 16; P.K = KC + krow * 512 + 128 * hh; P.V = VC + krow * 512 + 128 * hh; P.O = OC + qrow * 2048 + 128 * hh;
            P.NT = CROWS / 64; P.kvalid = CPAST + DECS; P.hi_base = CROWS / 64; P.hi_step = 0; P.lo_base = 0; P.lo_step = 0; P.qpos0 = PAST; P.kpos0 = PAST - CPAST; P.fix_lo = 0; P.fix_hi = (CPAST + DECS) / 64;
            P.tab = A->in[I_CBIAS] + ((size_t)l * 4 + hh) * 257; }
        P.negB = negB_C; att::attn_unit<128, false, true, false>(P, lds);
    }
}

constexpr int NPH = 12, NPHASES = NPH * DEPTH + 1;

template <int l>
__device__ __forceinline__ void layer_body(Frame& F, LAS unsigned char* lds0, volatile LAS unsigned* MISC, const int lo, const int hi) {
#ifndef PHM
#define PHM 0xfff
#endif
#define IN(k) (((PHM >> ((k) % NPH)) & 1) && lo <= (k) && (k) < hi)
#define SEAM(k) do { if (IN(k) && IN((k) + 1)) { XcdBarrier b2; b2.bar = (unsigned*)(fresh_args()->ws + WS_CTL) + CW_BAR; b2.x = xb_xcc_id(); b2.st = MISC + 8; xcd_barrier(b2); } } while (0)
    bf16 *H, *Zb, *GT, *U; float* X;
#define FRESH() do { Ap = fresh_args(); F.tid = fresh_tid(); F.lane = F.tid & 63; F.wave = __builtin_amdgcn_readfirstlane(F.tid >> 6); \
    { int bx_ = blockIdx.x, G_ = gridDim.x; asm volatile("" : "+s"(bx_), "+s"(G_)); F.bx = bx_; F.G = G_; F.vcu = (G_ % 8 == 0) ? (bx_ % 8) * (G_ / 8) + bx_ / 8 : bx_; F.gw = F.vcu * 8 + F.wave; F.NGW = G_ * 8; } \
    { unsigned lb_ = 0; asm volatile("" : "+s"(lb_)); F.lds = lds0 + lb_; } \
    F.ws = Ap->ws; F.out = Ap->out; ws = F.ws; H = (bf16*)(ws + WS_R3); Zb = (bf16*)(ws + WS_R1); GT = (bf16*)(ws + WS_GATES); U = (bf16*)(ws + WS_R1); X = F.out + OUT_Y; } while (0)
    ArgsP Ap; unsigned char* ws;
    constexpr size_t WSET = (l & 1) ? WS_WSET1 : 0, WSET_NEXT = (l & 1) ? 0 : WS_WSET1;
        const int pb = NPH * l;
        if (IN(pb + 0)) { FRESH(); phase_pre(F, Ap, l); } SEAM(pb + 0);
        if (IN(pb + 1)) {
            FRESH(); ArgsP A = Ap;
            pg8::Gemm g{H, (const bf16*)(ws + WSET + WS_WIN), M, NIN, DM, DM, DM}; pg8::StaticOrder S; S.init(M, NIN, DM, F.G, F.bx, 4);
            pg8::EpiIn E{Zb, GT, A->in[I_BGATE] + (size_t)l * NGATE, F.lds + EPI_OFF};
            pg8::gemm_phase(F.lds, g, S, E);
            if (l + 1 < DEPTH) { const int nlast = ((M / 256) * (NIN / 256)) % F.G;
                if (nlast != 0 && F.bx >= nlast) pre_weights(F, Ap, l + 1, ws + WSET_NEXT, (F.bx - nlast) * 8 + F.wave, (F.G - nlast) * 8, 0, WCUT1); }
        } SEAM(pb + 1);
        if (IN(pb + 2)) { FRESH(); phase_post_in(F, Ap, l); } SEAM(pb + 2);
        if (IN(pb + 3)) {
            FRESH();
#pragma unroll 1
            for (int gi = 0; gi < 2; ++gi) {
                const bf16* Ain = (const bf16*)(ws + (gi == 0 ? WS_CQ : WS_CKV)); const bf16* Bt = (const bf16*)(ws + WSET + (gi == 0 ? WS_WQB : WS_WKVB));
                const int Mg = gi == 0 ? M : M2, Ng = gi == 0 ? 1536 : 2048, Kg = gi == 0 ? 512 : 256;
                pg8::Gemm g{Ain, Bt, Mg, Ng, Kg, Kg, Kg}; pg8::StaticOrder S; S.init(Mg, Ng, Kg, F.G, gi == 0 ? F.bx : (F.bx + F.G / 2) % F.G);
                pg8::EpiPlain E{(bf16*)(ws + (gi == 0 ? WS_R2 : WS_R1)), Ng, F.lds + EPI_OFF}; pg8::gemm_phase(F.lds, g, S, E);
            }
        } SEAM(pb + 3);
        if (IN(pb + 4)) { FRESH(); phase_post_b(F, Ap, l); } SEAM(pb + 4);
        if (IN(pb + 5)) { FRESH(); phase_attn(F, Ap, l); } SEAM(pb + 5);
        if (IN(pb + 6)) { FRESH(); phase_post_a(F, Ap, l); } SEAM(pb + 6);
        if (IN(pb + 7)) {
            FRESH();
            pg8::Gemm g{(const bf16*)(ws + WS_OALL), (const bf16*)(ws + WSET + WS_WBR), M, DM, DM, DM, DM}; pg8::StaticOrder S; S.init(M, DM, DM, F.G, F.bx, 4);
            pg8::EpiMerge E{GT, H, F.lds + EPI_OFF}; pg8::gemm_phase(F.lds, g, S, E);
            if (l + 1 < DEPTH) { const int nlast = ((M / 256) * (DM / 256)) % F.G;
                if (nlast != 0 && F.bx >= nlast) pre_caches(F, Ap, l + 1, (F.bx - nlast) * 8 + F.wave, (F.G - nlast) * 8); else if (nlast == 0) pre_caches(F, Ap, l + 1, F.gw, F.NGW); }
        } SEAM(pb + 7);
        if (IN(pb + 8)) {
            FRESH();
            { pg8::Gemm g{H, (const bf16*)(ws + WSET + WS_WO), M, DM, DM, DM, DM}; pg8::CombinedOrder S; S.init(MP, DM, DM, NS_O, F.G, F.bx);
              pg8::EpiResidSplit E{X, (float*)(ws + WS_SLAB_O), MP / 256, DM / NS_O, F.lds + EPI_OFF}; pg8::gemm_phase(F.lds, g, S, E); }
        } SEAM(pb + 8);
        if (IN(pb + 9)) { FRESH(); rmsnorm_rows(F, Ap, Ap->in[I_MNORM] + (size_t)l * DM, H, false, (const float*)(ws + WS_SLAB_O), NS_O); } SEAM(pb + 9);
        if (IN(pb + 10)) {
            FRESH();
            pg8::Gemm g{H, (const bf16*)(ws + WSET + WS_WUP), M, DFF, DM, DM, DM}; pg8::StaticOrder S; S.init(M, DFF, DM, F.G, F.bx, 4);
            pg8::EpiUp E{U, F.lds + EPI_OFF}; pg8::gemm_phase(F.lds, g, S, E);
            if (l + 1 < DEPTH) { const int nlast = ((M / 256) * (DFF / 256)) % F.G;
                if (nlast != 0 && F.bx >= nlast) pre_weights(F, Ap, l + 1, ws + WSET_NEXT, (F.bx - nlast) * 8 + F.wave, (F.G - nlast) * 8, WCUT1, WCUT2); }
        } SEAM(pb + 10);
        if (IN(pb + 11)) {
            FRESH();
            { pg8::Gemm g{U, (const bf16*)(ws + WSET + WS_WDN), M, DM, DFF, DFF, DFF}; pg8::CombinedOrder S; S.init(MP, DM, DFF, NS_DN, F.G, F.bx);
              pg8::EpiResidSplit E{X, (float*)(ws + WS_SLAB_DN), MP / 256, DFF / NS_DN, F.lds + EPI_OFF}; pg8::gemm_phase(F.lds, g, S, E); }
            if (l + 1 < DEPTH) { const int n1 = ((M / 256) * (NIN / 256)) % F.G, n2 = ((M / 256) * (DFF / 256)) % F.G;
                pre_weights(F, Ap, l + 1, ws + WSET_NEXT, F.gw, F.NGW, n1 != 0 ? (n2 != 0 ? WCUT2 : WCUT1) : 0, 1 << 30); }
        } SEAM(pb + 11);
    #undef IN
#undef SEAM
#undef FRESH
}

__global__ void __launch_bounds__(512, 2) fwd(Args args) {
    extern __shared__ __attribute__((aligned(16))) unsigned char lds_raw[];
    Frame F;
    F.lds = (LAS unsigned char*)lds_raw;
    F.tid = threadIdx.x; F.lane = F.tid & 63; F.wave = __builtin_amdgcn_readfirstlane(F.tid >> 6);
    F.G = gridDim.x; { const int bx = blockIdx.x; F.vcu = (F.G % 8 == 0) ? (bx % 8) * (F.G / 8) + bx / 8 : bx; }
    F.gw = F.vcu * 8 + F.wave; F.NGW = F.G * 8;
    F.out = args.out; F.ws = args.ws;
    unsigned char* ws = args.ws;
    volatile LAS unsigned* MISC = (volatile LAS unsigned*)(F.lds + MISC_OFF);
    for (int u = F.tid; u < (LDS_BYTES - LDSCTL_OFF) / 4; u += 512) ((LAS unsigned*)(F.lds + LDSCTL_OFF))[u] = 0u;
    __syncthreads();
    XcdBarrier bar; bar.bar = (unsigned*)(ws + WS_CTL) + CW_BAR; bar.x = 0; bar.st = nullptr;
    if (args.use_bar) bar = xcd_barrier_post((unsigned*)(ws + WS_CTL) + CW_BAR, MISC + 8);
    const int lo = args.ph_lo, hi = args.ph_hi;
    layer_body<0>(F, (LAS unsigned char*)lds_raw, MISC, lo, hi);
    layer_body<1>(F, (LAS unsigned char*)lds_raw, MISC, lo, hi);
    layer_body<2>(F, (LAS unsigned char*)lds_raw, MISC, lo, hi);
    layer_body<3>(F, (LAS unsigned char*)lds_raw, MISC, lo, hi);
    if (lo <= NPH * DEPTH && NPH * DEPTH < hi) {
        ArgsP Ap = fresh_args(); F.tid = fresh_tid(); F.lane = F.tid & 63; F.ws = Ap->ws; F.out = Ap->out;
        final_combine(F, (const float*)(F.ws + WS_SLAB_DN), NS_DN);
    }
}

extern "C" void kernel_launch(void* const* d_in, const int* in_sizes, int n_in, void* d_out, int out_size, void* d_ws, size_t ws_size, hipStream_t stream) {
    static int grid = 0;
    if (grid == 0) {
        if (n_in != 31 || (size_t)out_size != OUT_END || ws_size < WS_END) { fprintf(stderr, "kernel_launch: shape mismatch (n_in %d, out %d, ws %zu)\n", n_in, out_size, ws_size); grid = -1; return; }
        int dev = 0, cus = 0;
        if (hipGetDevice(&dev) != hipSuccess || hipDeviceGetAttribute(&cus, hipDeviceAttributeMultiprocessorCount, dev) != hipSuccess) { grid = -1; return; }
        if (hipFuncSetAttribute((const void*)fwd, hipFuncAttributeMaxDynamicSharedMemorySize, LDS_BYTES) != hipSuccess) { fprintf(stderr, "kernel_launch: hipFuncSetAttribute failed\n"); grid = -1; return; }
        int per_cu = 0;
        if (hipOccupancyMaxActiveBlocksPerMultiprocessor(&per_cu, (const void*)fwd, 512, LDS_BYTES) != hipSuccess || per_cu < 1) fprintf(stderr, "kernel_launch: occupancy query reports %d\n", per_cu);
        (void)hipGetLastError();
        grid = cus;
    }
    if (grid < 0) return;
    (void)hipMemsetAsync((char*)d_ws + WS_CTL, 0, CTL_ZERO_BYTES, stream);
    Args a{};
    for (int i = 0; i < 31; ++i) a.in[i] = (const float*)d_in[i];
    a.out = (float*)d_out; a.ws = (unsigned char*)d_ws; a.pad = 0;
#if MK_SPLIT
    for (int p = 0; p < NPHASES; ++p) { a.ph_lo = p; a.ph_hi = p + 1; a.use_bar = 0; hipLaunchKernelGGL(fwd, dim3(grid), dim3(512), LDS_BYTES, stream, a); }
#else
    a.ph_lo = 0; a.ph_hi = NPHASES; a.use_bar = 1; hipLaunchKernelGGL(fwd, dim3(grid), dim3(512), LDS_BYTES, stream, a);
#endif
}
```

```cpp
#include <hip/hip_runtime.h>
#include <cstdio>
#include <cstdint>
#include <cmath>

#ifndef MK_SPLIT
#define MK_SPLIT 0
#endif

#define GAS __attribute__((address_space(1)))
#define LAS __attribute__((address_space(3)))
typedef unsigned short bf16;
typedef short bf16x8 __attribute__((ext_vector_type(8)));
typedef short s16x4 __attribute__((ext_vector_type(4)));
typedef float f32x4 __attribute__((ext_vector_type(4)));
typedef float f32x16 __attribute__((ext_vector_type(16)));
typedef unsigned u32x4 __attribute__((ext_vector_type(4)));
typedef unsigned u32x2 __attribute__((ext_vector_type(2)));

constexpr int DM = 2048, SEQ = 16384, NBATCH = 2, DEPTH = 4, DECB = 16, DECS = 16, PAST = 2048;
constexpr int MP = NBATCH * SEQ, MS = DECB * DECS, M = MP + MS;
constexpr int SROWS = 2176, CROWS = 640, CPAST = 512;
constexpr int M2 = MP + DECB * SROWS;
constexpr int MC = MP + DECB * CROWS;
constexpr int NIN = 10240, NZ = 4096, NGATE = 6144, DFF = 8192, INCOLS = 10048;
constexpr float EPS = 1e-6f;
static_assert(M % 256 == 0 && M2 % 256 == 0, "row counts are whole 256-row panels");

constexpr size_t OUT_Y = 0;
constexpr size_t OUT_AK_P = OUT_Y + (size_t)M * DM;
constexpr size_t OUT_AV_P = OUT_AK_P + (size_t)DEPTH * MP * 512;
constexpr size_t OUT_BC_P = OUT_AV_P + (size_t)DEPTH * MP * 512;
constexpr size_t OUT_BP_P = OUT_BC_P + (size_t)DEPTH * MP * 256;
constexpr size_t OUT_CK_P = OUT_BP_P + (size_t)DEPTH * MP * 64;
constexpr size_t OUT_CV_P = OUT_CK_P + (size_t)DEPTH * NBATCH * 512 * 512;
constexpr size_t OUT_AK_S = OUT_CV_P + (size_t)DEPTH * NBATCH * 512 * 512;
constexpr size_t OUT_AV_S = OUT_AK_S + (size_t)DEPTH * MS * 512;
constexpr size_t OUT_BC_S = OUT_AV_S + (size_t)DEPTH * MS * 512;
constexpr size_t OUT_BP_S = OUT_BC_S + (size_t)DEPTH * MS * 256;
constexpr size_t OUT_CK_S = OUT_BP_S + (size_t)DEPTH * MS * 64;
constexpr size_t OUT_CV_S = OUT_CK_S + (size_t)DEPTH * MS * 512;
constexpr size_t OUT_END = OUT_CV_S + (size_t)DEPTH * MS * 512;
static_assert(OUT_END == 250413056ull, "output size");

constexpr size_t MiB = 1u << 20;
constexpr size_t WS_CTL = 0, CTL_ZERO_BYTES = 1 * MiB;
constexpr size_t WS_WIN = 1 * MiB;
constexpr size_t WS_WQB = 41 * MiB;
constexpr size_t WS_WKVB = 43 * MiB;
constexpr size_t WS_WBR = 44 * MiB;
constexpr size_t WS_WO = 52 * MiB;
constexpr size_t WS_WUP = 60 * MiB;
constexpr size_t WS_WDN = 92 * MiB;
constexpr size_t WS_R3 = 124 * MiB;
constexpr size_t WS_R1 = 322 * MiB;
constexpr size_t WS_GATES = 586 * MiB;
constexpr size_t WS_QA = 973 * MiB;
constexpr size_t WS_KA = 1006 * MiB;
constexpr size_t WS_VA = 1072 * MiB;
constexpr size_t WS_CQ = 1138 * MiB;
constexpr size_t WS_CKV = 1171 * MiB;
constexpr size_t WS_KPE = 1204 * MiB;
constexpr size_t WS_QC = 1221 * MiB;
constexpr size_t WS_KC = 1254 * MiB;
constexpr size_t WS_VC = 1296 * MiB;
constexpr size_t WS_R2 = 1338 * MiB;
constexpr size_t WS_OALL = 1596 * MiB;
constexpr size_t WS_QB = 1727 * MiB;
constexpr size_t WS_END = 1824 * MiB;
static_assert(WS_WIN + (size_t)NIN * DM * 2 <= WS_WQB && WS_WDN + (size_t)DM * DFF * 2 <= WS_R3, "weights");
static_assert(WS_R3 + (size_t)M2 * 1536 * 2 <= WS_R1 && WS_R1 + (size_t)M2 * 2048 * 2 <= WS_GATES && WS_GATES + (size_t)M * NGATE * 2 <= WS_QA, "R3/R1/gates");
static_assert(WS_R1 + (size_t)M * DFF * 2 <= WS_QA, "u overlay");
static_assert(WS_QA + (size_t)M * 512 * 2 <= WS_KA && WS_KA + (size_t)M2 * 512 * 2 <= WS_VA && WS_VA + (size_t)M2 * 512 * 2 <= WS_CQ, "A");
static_assert(WS_CQ + (size_t)M * 512 * 2 <= WS_CKV && WS_CKV + (size_t)M2 * 256 * 2 <= WS_KPE && WS_KPE + (size_t)M2 * 64 * 4 <= WS_QC, "B");
static_assert(WS_QC + (size_t)M * 512 * 2 <= WS_KC && WS_KC + (size_t)MC * 512 * 2 <= WS_VC && WS_VC + (size_t)MC * 512 * 2 <= WS_R2, "C");
static_assert(WS_R2 + (size_t)M * 2048 * 4 <= WS_OALL && WS_OALL + (size_t)M * 2048 * 2 <= WS_QB && WS_QB + (size_t)M * 1536 * 2 <= WS_END, "tail");

constexpr int CW_BAR = 4096;

constexpr int RING_BYTES = 131072;
constexpr int LDSCTL_OFF = RING_BYTES, MISC_OFF = LDSCTL_OFF + 320;
constexpr int LDS_BYTES = 155648;
constexpr int EPI_OFF = RING_BYTES + 8192;
static_assert(EPI_OFF + 8 * 2048 <= LDS_BYTES, "epilogue staging");

#define LDS_WAIT() asm volatile("s_waitcnt lgkmcnt(0)" ::: "memory")
#define VM_WAIT() asm volatile("s_waitcnt vmcnt(0)" ::: "memory")
#define SBAR() __builtin_amdgcn_sched_barrier(0)
__device__ __forceinline__ int fresh_tid() { int t = threadIdx.x; asm volatile("" : "+v"(t)); return t; }
__device__ __forceinline__ unsigned cvtpk(float lo, float hi) { unsigned r; asm volatile("v_cvt_pk_bf16_f32 %0, %1, %2" : "=v"(r) : "v"(lo), "v"(hi)); return r; }
__device__ __forceinline__ float bf_lo(unsigned u) { return __uint_as_float(u << 16); }
__device__ __forceinline__ float bf_hi(unsigned u) { return __uint_as_float(u & 0xffff0000u); }
__device__ __forceinline__ void unpack8(u32x4 w, float (&v)[8]) { v[0] = bf_lo(w.x); v[1] = bf_hi(w.x); v[2] = bf_lo(w.y); v[3] = bf_hi(w.y); v[4] = bf_lo(w.z); v[5] = bf_hi(w.z); v[6] = bf_lo(w.w); v[7] = bf_hi(w.w); }
__device__ __forceinline__ u32x4 pack8(const float (&v)[8]) { u32x4 w; w.x = cvtpk(v[0], v[1]); w.y = cvtpk(v[2], v[3]); w.z = cvtpk(v[4], v[5]); w.w = cvtpk(v[6], v[7]); return w; }
__device__ __forceinline__ void ld8bf(const bf16* p, float (&v)[8]) { unpack8(*(const u32x4*)p, v); }
__device__ __forceinline__ void ld8f(const float* p, float (&v)[8]) { const f32x4 a = *(const f32x4*)p, b = *(const f32x4*)(p + 4); v[0] = a.x; v[1] = a.y; v[2] = a.z; v[3] = a.w; v[4] = b.x; v[5] = b.y; v[6] = b.z; v[7] = b.w; }
__device__ __forceinline__ void st8f(float* p, const float (&v)[8]) { *(f32x4*)p = (f32x4){v[0], v[1], v[2], v[3]}; *(f32x4*)(p + 4) = (f32x4){v[4], v[5], v[6], v[7]}; }
__device__ __forceinline__ void st8f_nt(float* p, const float (&v)[8]) { __builtin_nontemporal_store((f32x4){v[0], v[1], v[2], v[3]}, (f32x4*)p); __builtin_nontemporal_store((f32x4){v[4], v[5], v[6], v[7]}, (f32x4*)(p + 4)); }
__device__ __forceinline__ float wave_sum(float v) {
#pragma unroll
    for (int o = 1; o < 64; o <<= 1) v += __shfl_xor(v, o);
    return v;
}
__device__ __forceinline__ float sumsq8(const float (&v)[8]) { float s = 0.f;
#pragma unroll
    for (int e = 0; e < 8; ++e) s += v[e] * v[e];
    return s; }

#define XB_TMO      128
#define XB_XCNT(j)  (256  + 64 * (j))
#define XB_XSUB(j)  (1280 + 64 * (j))
#define XB_XGEN(j)  (2304 + 64 * (j))
#define XB_TOP      3328
#define XB_TOPGEN   3392
#define XCD_BAR_WORDS 3456
#define XB_SPIN_CAP (1u << 18)
__device__ __forceinline__ unsigned xb_ld(unsigned* p)              { return __hip_atomic_load(p, __ATOMIC_RELAXED, __HIP_MEMORY_SCOPE_AGENT); }
__device__ __forceinline__ unsigned xb_add(unsigned* p, unsigned v) { return __hip_atomic_fetch_add(p, v, __ATOMIC_RELAXED, __HIP_MEMORY_SCOPE_AGENT); }
__device__ __forceinline__ unsigned xb_xcc_id() { return (unsigned)__builtin_amdgcn_s_getreg((3 << 11) | 20) & 0xFu; }
#define XB_SPIN(cond, bar) do { unsigned _sp = 0; while (cond) { __builtin_amdgcn_s_sleep(1); \
    if ((++_sp & 255u) == 0u) { if (xb_ld(&(bar)[XB_TMO])) break; if (_sp > XB_SPIN_CAP) { atomicAdd(&(bar)[XB_TMO], 1u); break; } } } } while (0)
struct XcdBarrier { unsigned* bar; unsigned x; volatile LAS unsigned* st; };
__device__ __forceinline__ XcdBarrier xcd_barrier_post(unsigned* bar, volatile LAS unsigned* st) {
    XcdBarrier b; b.bar = bar; b.x = xb_xcc_id(); b.st = st;
    if (threadIdx.x == 0) (void)xb_add(&bar[XB_XCNT(b.x)], 1u);
    return b;
}
__device__ __forceinline__ void xcd_barrier_complete(unsigned* bar, unsigned x, unsigned& nloc, unsigned& nx) {
    const unsigned G = gridDim.x * gridDim.y * gridDim.z;
    unsigned sum, cnt, mine, sp = 0u;
    for (;;) {
        sum = 0u; cnt = 0u; mine = 0u;
#pragma unroll
        for (unsigned j = 0; j < 16; ++j) { const unsigned c = xb_ld(&bar[XB_XCNT(j)]); sum += c; cnt += (c > 0u) ? 1u : 0u; mine = (j == x) ? c : mine; }
        if (sum == G) break;
        __builtin_amdgcn_s_sleep(1);
        if ((++sp & 255u) == 0u) { if (xb_ld(&bar[XB_TMO])) break; if (sp > XB_SPIN_CAP) { atomicAdd(&bar[XB_TMO], 1u); break; } }
    }
    nloc = mine > 0u ? mine : 1u; nx = cnt > 0u ? cnt : 1u;
}
__device__ __forceinline__ void xcd_barrier(const XcdBarrier& b) {
    asm volatile("s_waitcnt vmcnt(0)" ::: "memory");
    __syncthreads();
    if (threadIdx.x == 0) {
        unsigned* bar = b.bar;
        __builtin_amdgcn_s_waitcnt(0);
        unsigned nloc = b.st[0], nx = b.st[1];
        if (nloc == 0u) { xcd_barrier_complete(bar, b.x, nloc, nx); b.st[0] = nloc; b.st[1] = nx; }
        const unsigned old = xb_add(&bar[XB_XSUB(b.x)], 1u);
        const unsigned gen = old / nloc;
        if (old + 1u == (gen + 1u) * nloc) {
            __builtin_amdgcn_fence(__ATOMIC_RELEASE, "agent");
            asm volatile("s_waitcnt vmcnt(0)" ::: "memory");
            const unsigned og = xb_add(&bar[XB_TOP], 1u);
            const unsigned tg = og / nx;
            if (og + 1u == (tg + 1u) * nx) xb_add(&bar[XB_TOPGEN], 1u);
            else XB_SPIN(xb_ld(&bar[XB_TOPGEN]) == tg, bar);
            __builtin_amdgcn_fence(__ATOMIC_ACQUIRE, "agent");
            xb_add(&bar[XB_XGEN(b.x)], 1u);
            asm volatile("s_waitcnt vmcnt(0)" ::: "memory");
        } else {
            XB_SPIN(xb_ld(&bar[XB_XGEN(b.x)]) == gen, bar);
            __builtin_amdgcn_fence(__ATOMIC_ACQUIRE, "agent");
            asm volatile("s_waitcnt vmcnt(0)" ::: "memory");
        }
    }
    __syncthreads();
}

namespace pg8 {
constexpr int BM = 256, BK = 64, HALF = 128, HTB = HALF * BK * 2, NXCD = 8, WGM = 8;
__host__ __device__ __forceinline__ int lds_byte(int r, int c) { return r * 128 + ((((c >> 3) ^ ((r >> 1) & 7))) << 4) + (c & 7) * 2; }
__host__ __device__ __forceinline__ void stage_rc(int b, int& R, int& C) { R = b >> 7; const int slot = (b & 127) >> 4; C = (slot ^ ((R >> 1) & 7)) * 8; }
__host__ __device__ __forceinline__ int perm32(int rho) { const int n = rho >> 4, i = rho & 15; return 8 * (i >> 2) + 4 * n + (i & 3); }
struct Unit { int pm, pn, koff, nt; };
struct Gemm { const bf16* A; const bf16* Bt; int M, N, K, lda, ldb; };
struct StaticOrder {
    int nM, nN, nwg, G, c, nt, wgm;
    __device__ void init(int M_, int N_, int K_, int G_, int c_, int wgm_ = WGM) { nM = M_ / BM; nN = N_ / BM; nwg = nM * nN; G = G_; c = c_; nt = K_ / BK; wgm = wgm_; }
    __device__ bool next(int i, Unit& u) const {
        const long L = (long)i * G + c; if (L >= nwg) return false;
        int wgid = (int)L; { const int q = nwg / NXCD, r = nwg % NXCD, xcd = wgid % NXCD, off = wgid / NXCD; wgid = (xcd < r ? xcd * (q + 1) : r * (q + 1) + (xcd - r) * q) + off; }
        const int nig = wgm * nN, gid = wgid / nig, fm = gid * wgm, gsz = (nM - fm) < wgm ? (nM - fm) : wgm;
        u.pm = fm + ((wgid % nig) % gsz); u.pn = (wgid % nig) / gsz; u.koff = 0; u.nt = nt; return true;
    }
};
struct CombinedOrder {
    StaticOrder S0; int pmS, nN, np, KS;
    __device__ void init(int Mmain, int N_, int K_, int NS_, int G_, int c_) { S0.init(Mmain, N_, K_, G_, c_, 4); pmS = Mmain / BM; nN = N_ / BM; np = nN * NS_; KS = K_ / NS_; }
    __device__ bool next(int i, Unit& u) const { const long L = (long)i * S0.G + S0.c; if (L < S0.nwg) return S0.next(i, u);
        const int p = (int)(L - S0.nwg); if (p >= np) return false; u.pm = pmS; u.pn = p % nN; u.koff = (p / nN) * KS; u.nt = KS / BK; return true; }
};
template <class Epi, class Order>
__device__ __forceinline__ void gemm_phase(LAS unsigned char* lds, const Gemm g, const Order& S, const Epi& E) {
    const int tid = fresh_tid(), wid = __builtin_amdgcn_readfirstlane(tid >> 6), lane = tid & 63, wr = wid >> 2, wc = wid & 3, fr = lane & 15, fq = lane >> 4;
    unsigned voffA[2], voffB[2];
#pragma unroll
    for (int i = 0; i < 2; ++i) { int R, C; stage_rc(tid * 16 + i * 8192, R, C); const int Rb = 64 * (R >> 5) + perm32(R & 31);
        voffA[i] = (unsigned)(R * g.lda + C) * 2u; voffB[i] = (unsigned)(Rb * g.ldb + C) * 2u; }
    const size_t kstep = (size_t)(BK * 2);
    const size_t hstepA = (size_t)HALF * g.lda * 2, hstepB = (size_t)32 * g.ldb * 2;
    const size_t tstepA = 2 * hstepA, tstepB = (size_t)BM * g.ldb * 2;
    const unsigned ldsw = (unsigned)wid * 1024u;
    const int aoff = lds_byte(wr * 64 + fr, fq * 8), boff = lds_byte(wc * 32 + fr, fq * 8), aoff1 = aoff ^ 64, boff1 = boff ^ 64;
#define PG8_SA(b, h) (((b) * 2 + (h)) * HTB)
#define PG8_SB(b, h) ((4 + (b) * 2 + (h)) * HTB)
#define PG8_STAGE(bufoff, gbase, voff) do { _Pragma("unroll") for (int _i = 0; _i < 2; ++_i) \
        __builtin_amdgcn_global_load_lds((const unsigned*)((const char*)(gbase) + (voff)[_i]), (LAS unsigned*)(lds + (bufoff) + ldsw + _i * 8192), 16, 0, 0); } while (0)
#define PG8_LDA(dst, b, h) do { _Pragma("unroll") for (int m = 0; m < 4; ++m) _Pragma("unroll") for (int k = 0; k < 2; ++k) dst[m][k] = *(const LAS bf16x8*)(lds + PG8_SA(b, h) + (k ? aoff1 : aoff) + m * 2048); } while (0)
#define PG8_LDB(dst, b, h) do { _Pragma("unroll") for (int n = 0; n < 2; ++n) _Pragma("unroll") for (int k = 0; k < 2; ++k) dst[n][k] = *(const LAS bf16x8*)(lds + PG8_SB(b, h) + (k ? boff1 : boff) + n * 2048); } while (0)
#define PG8_MMA(ai, bj, At, Bt) do { __builtin_amdgcn_s_setprio(1); _Pragma("unroll") for (int m = 0; m < 4; ++m) _Pragma("unroll") for (int n = 0; n < 2; ++n) _Pragma("unroll") for (int k = 0; k < 2; ++k) \
        acc[ai][bj][m][n] = __builtin_amdgcn_mfma_f32_16x16x32_bf16(Bt[n][k], At[m][k], acc[ai][bj][m][n], 0, 0, 0); __builtin_amdgcn_s_setprio(0); } while (0)
#define PG8_WAIT_V(n) asm volatile("s_waitcnt vmcnt(" #n ")" ::: "memory")
#define PG8_WAIT_L(n) asm volatile("s_waitcnt lgkmcnt(" #n ")" ::: "memory")
#define PG8_BAR __builtin_amdgcn_s_barrier()
#define PG8_SCHED __builtin_amdgcn_sched_barrier(0)
    Unit cur, nxt; int ui = 0;
    if (!S.next(0, cur)) return;
    f32x4 acc[2][2][4][2];
#pragma unroll
    for (int a = 0; a < 2; ++a)
#pragma unroll
        for (int b = 0; b < 2; ++b)
#pragma unroll
            for (int m = 0; m < 4; ++m)
#pragma unroll
                for (int n = 0; n < 2; ++n) acc[a][b][m][n] = (f32x4){0.f, 0.f, 0.f, 0.f};
    bf16x8 At[4][2], B0[2][2], B1[2][2];
    const char* cA = (const char*)g.A + (size_t)cur.pm * tstepA + (size_t)cur.koff * 2; const char* cB = (const char*)g.Bt + (size_t)cur.pn * tstepB + (size_t)cur.koff * 2;
    PG8_STAGE(PG8_SB(0, 0), cB, voffB); PG8_STAGE(PG8_SB(0, 1), cB + hstepB, voffB); PG8_STAGE(PG8_SA(0, 0), cA, voffA); PG8_STAGE(PG8_SA(0, 1), cA + hstepA, voffA);
    if (wr == 1) PG8_BAR;
    PG8_WAIT_V(2); PG8_BAR;
    PG8_STAGE(PG8_SB(1, 0), cB + kstep, voffB); PG8_STAGE(PG8_SA(1, 0), cA + kstep, voffA); PG8_STAGE(PG8_SB(1, 1), cB + hstepB + kstep, voffB);
    PG8_WAIT_V(6); PG8_BAR;
    for (;;) {
        const bool has_next = S.next(ui + 1, nxt);
        const char* nA = has_next ? (const char*)g.A + (size_t)nxt.pm * tstepA + (size_t)nxt.koff * 2 : cA; const char* nB = has_next ? (const char*)g.Bt + (size_t)nxt.pn * tstepB + (size_t)nxt.koff * 2 : cB;
        const int nt = cur.nt;
        for (int t = 0; t < nt; t += 2) {
            if constexpr (Epi::HOOK) { if (t == 8 || t == 24) E.mid(acc, cur, wr, wc, fr, fq, t); }
            const bool last = (t == nt - 2);
            const char* a1 = cA + (size_t)(t + 1) * kstep;
            const char* a2 = last ? nA : cA + (size_t)(t + 2) * kstep; const char* b2 = last ? nB : cB + (size_t)(t + 2) * kstep;
            const char* a3 = a2 + kstep; const char* b3 = b2 + kstep;
            PG8_LDB(B0, 0, 0); PG8_LDB(B1, 0, 1); PG8_SCHED; PG8_LDA(At, 0, 0); PG8_STAGE(PG8_SA(1, 1), a1 + hstepA, voffA);
            PG8_WAIT_V(8); PG8_WAIT_L(0); PG8_BAR; PG8_MMA(0, 0, At, B0); PG8_MMA(0, 1, At, B1); PG8_BAR; PG8_SCHED;
            PG8_LDA(At, 0, 1); PG8_STAGE(PG8_SB(0, 0), b2, voffB); PG8_STAGE(PG8_SB(0, 1), b2 + hstepB, voffB); PG8_STAGE(PG8_SA(0, 0), a2, voffA);
            PG8_WAIT_V(8); PG8_WAIT_L(0); PG8_BAR; PG8_MMA(1, 0, At, B0); PG8_MMA(1, 1, At, B1); PG8_BAR; PG8_SCHED;
            PG8_LDB(B0, 1, 0); PG8_LDB(B1, 1, 1); PG8_SCHED; PG8_LDA(At, 1, 0); PG8_STAGE(PG8_SA(0, 1), a2 + hstepA, voffA);
            PG8_WAIT_V(8); PG8_WAIT_L(0); PG8_BAR; PG8_MMA(0, 0, At, B0); PG8_MMA(0, 1, At, B1); PG8_BAR; PG8_SCHED;
            PG8_LDA(At, 1, 1); PG8_STAGE(PG8_SB(1, 0), b3, voffB); PG8_STAGE(PG8_SB(1, 1), b3 + hstepB, voffB); PG8_STAGE(PG8_SA(1, 0), a3, voffA);
            PG8_WAIT_V(8); PG8_WAIT_L(0); PG8_BAR; PG8_MMA(1, 0, At, B0); PG8_MMA(1, 1, At, B1); PG8_BAR; PG8_SCHED;
        }
        if (wr == 0) PG8_BAR;
        E(acc, cur, wr, wc, fr, fq);
        if (!has_next) break;
#pragma unroll
        for (int a = 0; a < 2; ++a)
#pragma unroll
            for (int b = 0; b < 2; ++b)
#pragma unroll
                for (int m = 0; m < 4; ++m)
#pragma unroll
                    for (int n = 0; n < 2; ++n) acc[a][b][m][n] = (f32x4){0.f, 0.f, 0.f, 0.f};
        cur = nxt; cA = nA; cB = nB; ++ui;
        if (wr == 1) PG8_BAR;
    }
    PG8_WAIT_V(0);
    PG8_BAR;
#undef PG8_SA
#undef PG8_SB
#undef PG8_STAGE
#undef PG8_LDA
#undef PG8_LDB
#undef PG8_MMA
#undef PG8_WAIT_V
#undef PG8_WAIT_L
#undef PG8_BAR
#undef PG8_SCHED
}

#define EPI_LOOP_BEGIN const int row0 = u.pm * BM + wr * 64 + fr, col0 = u.pn * BM + wc * 64 + 8 * fq; \
    _Pragma("unroll") for (int ai = 0; ai < 2; ++ai) _Pragma("unroll") for (int m = 0; m < 4; ++m) { const size_t row = (size_t)(row0 + ai * HALF + m * 16); \
    _Pragma("unroll") for (int bj = 0; bj < 2; ++bj) { const int col = col0 + bj * 32; f32x4 v0 = acc[ai][bj][m][0], v1 = acc[ai][bj][m][1];
#define EPI_LOOP_END } }
__device__ __forceinline__ u32x4 pk8(f32x4 v0, f32x4 v1) { u32x4 w; w.x = cvtpk(v0[0], v0[1]); w.y = cvtpk(v0[2], v0[3]); w.z = cvtpk(v1[0], v1[1]); w.w = cvtpk(v1[2], v1[3]); return w; }
__device__ __forceinline__ float sigm(float v) { return __builtin_amdgcn_rcpf(1.f + __builtin_amdgcn_exp2f(-1.4426950408889634f * v)); }

template <bool NT> __device__ __forceinline__ void st_lines(LAS unsigned char* scr, u32x4 w0, u32x4 w1, bf16* tile, size_t ldc, int fr, int fq) {
    const int lane = fq * 16 + fr, rr = lane >> 3, c = lane & 7;
    *(LAS u32x4*)(scr + fr * 128 + ((fq ^ (fr & 7)) << 4)) = w0;
    *(LAS u32x4*)(scr + fr * 128 + (((4 + fq) ^ (fr & 7)) << 4)) = w1;
    const u32x4 a = *(const LAS u32x4*)(scr + rr * 128 + ((c ^ rr) << 4)), b = *(const LAS u32x4*)(scr + (8 + rr) * 128 + ((c ^ rr) << 4));
    bf16* d = tile + (size_t)rr * ldc + c * 8;
    if constexpr (NT) { __builtin_nontemporal_store(a, (u32x4*)d); __builtin_nontemporal_store(b, (u32x4*)(d + 8 * ldc)); }
    else { *(u32x4*)d = a; *(u32x4*)(d + 8 * ldc) = b; }
}
struct EpiIn {
    static constexpr bool HOOK = false;
    bf16* Z; bf16* G; const float* bg; LAS unsigned char* scr;
    __device__ __forceinline__ void operator()(const f32x4 (&acc)[2][2][4][2], const Unit& u, int wr, int wc, int fr, int fq) const {
        const bool isg = u.pn * BM >= NZ;
        const int colw = u.pn * BM + wc * 64 - (isg ? NZ : 0);
        bf16* base = (isg ? G : Z) + (size_t)(u.pm * BM + wr * 64) * (isg ? NGATE : NZ) + colw; const size_t ldc = isg ? NGATE : NZ;
        LAS unsigned char* sw = scr + (wr * 4 + wc) * 2048;
        f32x4 b00, b01, b10, b11;
        if (isg) { const float* bp = bg + colw + 8 * fq; b00 = *(const f32x4*)bp; b01 = *(const f32x4*)(bp + 4); b10 = *(const f32x4*)(bp + 32); b11 = *(const f32x4*)(bp + 36); }
#pragma unroll
        for (int ai = 0; ai < 2; ++ai)
#pragma unroll
            for (int m = 0; m < 4; ++m) {
                f32x4 v0 = acc[ai][0][m][0], v1 = acc[ai][0][m][1], v2 = acc[ai][1][m][0], v3 = acc[ai][1][m][1];
                if (isg) { v0 += b00; v1 += b01; v2 += b10; v3 += b11;
#pragma unroll
                    for (int e = 0; e < 4; ++e) { v0[e] = sigm(v0[e]); v1[e] = sigm(v1[e]); v2[e] = sigm(v2[e]); v3[e] = sigm(v3[e]); } }
                st_lines<true>(sw, pk8(v0, v1), pk8(v2, v3), base + (size_t)(ai * HALF + m * 16) * ldc, ldc, fr, fq); }
    }
};
struct EpiPlain {
    static constexpr bool HOOK = false;
    bf16* O; int ldc; LAS unsigned char* scr;
    __device__ __forceinline__ void operator()(const f32x4 (&acc)[2][2][4][2], const Unit& u, int wr, int wc, int fr, int fq) const {
        bf16* base = O + (size_t)(u.pm * BM + wr * 64) * ldc + u.pn * BM + wc * 64; LAS unsigned char* sw = scr + (wr * 4 + wc) * 2048;
#pragma unroll
        for (int ai = 0; ai < 2; ++ai)
#pragma unroll
            for (int m = 0; m < 4; ++m)
                st_lines<false>(sw, pk8(acc[ai][0][m][0], acc[ai][0][m][1]), pk8(acc[ai][1][m][0], acc[ai][1][m][1]), base + (size_t)(ai * HALF + m * 16) * ldc, (size_t)ldc, fr, fq);
    }
};
struct EpiMerge {
    static constexpr bool HOOK = true;
    const bf16* G; bf16* Ob; LAS unsigned char* scr;
    __device__ __forceinline__ void mid(f32x4 (&acc)[2][2][4][2], const Unit& u, int wr, int wc, int fr, int fq, int t) const {
        const __amdgpu_buffer_rsrc_t rs = __builtin_amdgcn_make_buffer_rsrc((void*)G, 0, (int)((size_t)M * NGATE * 2), 0x00020000);
        const int gx = (t == 8) ? 0 : DM;
        const int voff = ((u.pm * BM + wr * 64 + fr) * NGATE + u.pn * BM + wc * 64 + 8 * fq + gx) * 2;
#pragma unroll
        for (int ai = 0; ai < 2; ++ai) {
            u32x4 wa[4][2], wb[4][2];
#pragma unroll
            for (int m = 0; m < 4; ++m)
#pragma unroll
                for (int bj = 0; bj < 2; ++bj) { const int so = ((ai * HALF + m * 16) * NGATE + bj * 32) * 2;
                    wa[m][bj] = __builtin_amdgcn_raw_buffer_load_b128(rs, voff, so, 0); wb[m][bj] = __builtin_amdgcn_raw_buffer_load_b128(rs, voff, so + DM * 2, 0); }
#pragma unroll
            for (int m = 0; m < 4; ++m)
#pragma unroll
                for (int bj = 0; bj < 2; ++bj) {
                    float a[8], b[8]; unpack8(wa[m][bj], a); unpack8(wb[m][bj], b);
#pragma unroll
                    for (int e = 0; e < 8; ++e) a[e] = a[e] * __builtin_amdgcn_rcpf(fmaxf(b[e], 1e-30f));
                    f32x4& v0 = acc[ai][bj][m][0]; f32x4& v1 = acc[ai][bj][m][1];
                    v0[0] *= a[0]; v0[1] *= a[1]; v0[2] *= a[2]; v0[3] *= a[3]; v1[0] *= a[4]; v1[1] *= a[5]; v1[2] *= a[6]; v1[3] *= a[7]; }
            SBAR(); }
    }
    __device__ __forceinline__ void operator()(const f32x4 (&acc)[2][2][4][2], const Unit& u, int wr, int wc, int fr, int fq) const {
        bf16* base = Ob + (size_t)(u.pm * BM + wr * 64) * DM + u.pn * BM + wc * 64; LAS unsigned char* sw = scr + (wr * 4 + wc) * 2048;
        const bf16* gb = G + (size_t)(u.pm * BM + wr * 64 + fr) * NGATE + 2 * DM + u.pn * BM + wc * 64 + 8 * fq;
        u32x4 gq[2][4][2];
#pragma unroll
        for (int ai = 0; ai < 2; ++ai)
#pragma unroll
            for (int m = 0; m < 4; ++m) { const bf16* gp = gb + (size_t)(ai * HALF + m * 16) * NGATE; gq[ai][m][0] = *(const u32x4*)gp; gq[ai][m][1] = *(const u32x4*)(gp + 32); }
#pragma unroll
        for (int ai = 0; ai < 2; ++ai)
#pragma unroll
            for (int m = 0; m < 4; ++m) {
                float g0[8], g1[8]; unpack8(gq[ai][m][0], g0); unpack8(gq[ai][m][1], g1);
                f32x4 v0 = acc[ai][0][m][0], v1 = acc[ai][0][m][1], v2 = acc[ai][1][m][0], v3 = acc[ai][1][m][1];
                v0[0] *= g0[0]; v0[1] *= g0[1]; v0[2] *= g0[2]; v0[3] *= g0[3]; v1[0] *= g0[4]; v1[1] *= g0[5]; v1[2] *= g0[6]; v1[3] *= g0[7];
                v2[0] *= g1[0]; v2[1] *= g1[1]; v2[2] *= g1[2]; v2[3] *= g1[3]; v3[0] *= g1[4]; v3[1] *= g1[5]; v3[2] *= g1[6]; v3[3] *= g1[7];
                st_lines<false>(sw, pk8(v0, v1), pk8(v2, v3), base + (size_t)(ai * HALF + m * 16) * DM, (size_t)DM, fr, fq); }
    }
};
struct EpiResidSplit {
    static constexpr bool HOOK = false;
    float* X; float* P; int pmS, KS; LAS unsigned char* scr;
    __device__ __forceinline__ void operator()(const f32x4 (&acc)[2][2][4][2], const Unit& u, int wr, int wc, int fr, int fq) const {
        const bool piece = u.pm >= pmS;
        float* base = (piece ? P + (size_t)(u.koff / KS) * (MS * DM) - (size_t)u.pm * BM * DM : X) + (size_t)(u.pm * BM + wr * 64) * DM + u.pn * BM + wc * 64;
        LAS unsigned char* sw = scr + (wr * 4 + wc) * 2048;
        const int lane = fq * 16 + fr, rr = lane >> 3, c = lane & 7;
        float* drow = base + (size_t)rr * DM + c * 4;
#define RS_OFF(st) ((size_t)((((st) >> 3) & 1) * HALF + (((st) >> 1) & 3) * 16) * DM + ((st) & 1) * 32)
        f32x4 xa[2][4], xb[2][4];
        if (!piece) {
#pragma unroll
            for (int q = 0; q < 4; ++q) { const float* d = drow + RS_OFF(q); xa[0][q] = *(const f32x4*)d; xb[0][q] = *(const f32x4*)(d + 8 * DM); } }
#pragma unroll
        for (int bt = 0; bt < 4; ++bt) {
            if (!piece && bt < 3) {
#pragma unroll
                for (int q = 0; q < 4; ++q) { const float* d = drow + RS_OFF(4 * (bt + 1) + q); xa[(bt + 1) & 1][q] = *(const f32x4*)d; xb[(bt + 1) & 1][q] = *(const f32x4*)(d + 8 * DM); } }
#pragma unroll
            for (int q = 0; q < 4; ++q) { const int st = 4 * bt + q, ai = (st >> 3) & 1, m = (st >> 1) & 3, bj = st & 1;
                *(LAS f32x4*)(sw + fr * 128 + (((2 * fq) ^ (fr & 7)) << 4)) = acc[ai][bj][m][0];
                *(LAS f32x4*)(sw + fr * 128 + (((2 * fq + 1) ^ (fr & 7)) << 4)) = acc[ai][bj][m][1];
                f32x4 a = *(const LAS f32x4*)(sw + rr * 128 + ((c ^ rr) << 4)), b = *(const LAS f32x4*)(sw + (8 + rr) * 128 + ((c ^ rr) << 4));
                float* d = drow + RS_OFF(st);
                if (!piece) { a += xa[bt & 1][q]; b += xb[bt & 1][q]; }
                *(f32x4*)d = a; *(f32x4*)(d + 8 * DM) = b; }
        }
#undef RS_OFF
    }
};
struct EpiUp {
    static constexpr bool HOOK = false;
    bf16* U; LAS unsigned char* scr;
    __device__ __forceinline__ void operator()(const f32x4 (&acc)[2][2][4][2], const Unit& u, int wr, int wc, int fr, int fq) const {
        bf16* base = U + (size_t)(u.pm * BM + wr * 64) * DFF + u.pn * BM + wc * 64; LAS unsigned char* sw = scr + (wr * 4 + wc) * 2048;
#pragma unroll
        for (int ai = 0; ai < 2; ++ai)
#pragma unroll
            for (int m = 0; m < 4; ++m) {
                f32x4 v0 = acc[ai][0][m][0], v1 = acc[ai][0][m][1], v2 = acc[ai][1][m][0], v3 = acc[ai][1][m][1];
#pragma unroll
                for (int e = 0; e < 4; ++e) { const float a = fmaxf(v0[e], 0.f), b = fmaxf(v1[e], 0.f), c = fmaxf(v2[e], 0.f), d = fmaxf(v3[e], 0.f); v0[e] = a * a; v1[e] = b * b; v2[e] = c * c; v3[e] = d * d; }
                st_lines<true>(sw, pk8(v0, v1), pk8(v2, v3), base + (size_t)(ai * HALF + m * 16) * DFF, (size_t)DFF, fr, fq); }
    }
};
}

namespace att {
__device__ __forceinline__ int crow(int r, int hi) { return (r & 3) + 8 * (r >> 2) + 4 * hi; }
__device__ __forceinline__ int v_st(int k, int c) { const int kk = (k & ~0xC) | ((k & 4) << 1) | ((k & 8) >> 1); return ((kk >> 3) * 4 + (c >> 5)) * 512 + ((kk & 7) * 32 + (c & 31)) * 2; }
__device__ __forceinline__ int v_rd_base(int lane) { return ((lane & 3) << 3) | (((lane >> 2) & 3) << 6) | (((lane >> 4) & 1) << 5) | (((lane >> 5) & 1) << 8); }
constexpr int v_rd_off(int d0, int ks, int half) { return d0 * 512 + ks * 4096 + half * 2048; }
template <int OFF> __device__ __forceinline__ s16x4 tr_read(unsigned vb) {
    s16x4 r; asm volatile("ds_read_b64_tr_b16 %0, %1 offset:%2" : "=&v"(r) : "v"(vb), "i"(OFF) : "memory"); return r;
}
template <int DQK> struct Cn {
    static constexpr float SCALE = DQK == 64 ? 0.125f : (DQK == 128 ? 0.08838834764831845f : 0.07216878364870323f);
    static constexpr float C = SCALE * 1.4426950408889634f;
    static constexpr float THRR = 8.f / SCALE;
};
template <int DQK> __device__ __forceinline__ int kswz(int row) { return (DQK == 128 ? (row & 15) : ((row >> 1) & 7)) << 4; }
template <int DQK>
__device__ __forceinline__ void qkt_h(f32x16& p, const f32x16& cinit, const LAS char* Ks, int rowbase, const bf16x8* qr, int r32, int hi) {
    constexpr int KRB = DQK * 2;
    p = cinit;
    const int sw = kswz<DQK>(r32);
#pragma unroll
    for (int d0 = 0; d0 < DQK / 16; ++d0) { const int cb = (d0 * 2 + hi) * 16;
        const bf16x8 b = *(const LAS bf16x8*)(Ks + (rowbase + r32) * KRB + (cb ^ sw));
        p = __builtin_amdgcn_mfma_f32_32x32x16_bf16(b, qr[d0], p, 0, 0, 0); }
}
template <int DQK>
__device__ __forceinline__ void smx_h(f32x16& p, float negB, float& l_acc, bf16x8& paA, bf16x8& paB) {
#pragma unroll
    for (int r = 0; r < 16; ++r) p[r] = __builtin_amdgcn_exp2f(p[r]);
    float s0 = (p[0] + p[1]) + (p[2] + p[3]), s1 = (p[4] + p[5]) + (p[6] + p[7]), s2 = (p[8] + p[9]) + (p[10] + p[11]), s3 = (p[12] + p[13]) + (p[14] + p[15]);
    l_acc += (s0 + s1) + (s2 + s3);
#define PK4(P, BASE, OUT) do { unsigned a0 = cvtpk(P[BASE + 0], P[BASE + 1]), a1 = cvtpk(P[BASE + 2], P[BASE + 3]);   \
    unsigned b0 = cvtpk(P[BASE + 4], P[BASE + 5]), b1 = cvtpk(P[BASE + 6], P[BASE + 7]);                              \
    auto r0 = __builtin_amdgcn_permlane32_swap(a0, b0, false, false); auto r1 = __builtin_amdgcn_permlane32_swap(a1, b1, false, false); \
    u32x4 w = {r0[0], r1[0], r0[1], r1[1]}; OUT = __builtin_bit_cast(bf16x8, w); } while (0)
    PK4(p, 0, paA); PK4(p, 8, paB);
#undef PK4
}
template <int D0, int KS0> __device__ __forceinline__ void pv_half_one(f32x16& od, unsigned vb, bf16x8 paA, bf16x8 paB) {
    s16x4 l0 = tr_read<v_rd_off(D0, KS0, 0)>(vb), h0 = tr_read<v_rd_off(D0, KS0, 1)>(vb), l1 = tr_read<v_rd_off(D0, KS0 + 1, 0)>(vb), h1 = tr_read<v_rd_off(D0, KS0 + 1, 1)>(vb);
    asm volatile("s_waitcnt lgkmcnt(0)" : "+v"(l0), "+v"(h0), "+v"(l1), "+v"(h1) :: "memory");
#define PK(L, H) (bf16x8){L[0], L[1], L[2], L[3], H[0], H[1], H[2], H[3]}
    od = __builtin_amdgcn_mfma_f32_32x32x16_bf16(paA, PK(l0, h0), od, 0, 0, 0);
    od = __builtin_amdgcn_mfma_f32_32x32x16_bf16(paB, PK(l1, h1), od, 0, 0, 0);
#undef PK
}
template <int KS0> __device__ __forceinline__ void pv_half(f32x16* o, unsigned vb, bf16x8 paA, bf16x8 paB) {
#define TR4(D0) s16x4 l0_##D0 = tr_read<v_rd_off(D0, KS0, 0)>(vb), h0_##D0 = tr_read<v_rd_off(D0, KS0, 1)>(vb), l1_##D0 = tr_read<v_rd_off(D0, KS0 + 1, 0)>(vb), h1_##D0 = tr_read<v_rd_off(D0, KS0 + 1, 1)>(vb)
    TR4(0); TR4(1); TR4(2); TR4(3);
#undef TR4
    asm volatile("s_waitcnt lgkmcnt(0)" : "+v"(l0_0), "+v"(h0_0), "+v"(l1_0), "+v"(h1_0), "+v"(l0_1), "+v"(h0_1), "+v"(l1_1), "+v"(h1_1),
                                          "+v"(l0_2), "+v"(h0_2), "+v"(l1_2), "+v"(h1_2), "+v"(l0_3), "+v"(h0_3), "+v"(l1_3), "+v"(h1_3) :: "memory");
#define PK(L, H) (bf16x8){L[0], L[1], L[2], L[3], H[0], H[1], H[2], H[3]}
#define MM(D0) o[D0] = __builtin_amdgcn_mfma_f32_32x32x16_bf16(paA, PK(l0_##D0, h0_##D0), o[D0], 0, 0, 0); o[D0] = __builtin_amdgcn_mfma_f32_32x32x16_bf16(paB, PK(l1_##D0, h1_##D0), o[D0], 0, 0, 0)
    MM(0); MM(1); MM(2); MM(3);
#undef MM
#undef PK
}
struct VFrag { s16x4 l0[4], h0[4], l1[4], h1[4]; };
template <int KS0> __device__ __forceinline__ void pv_issue(VFrag& f, unsigned vb) {
    f.l0[0] = tr_read<v_rd_off(0, KS0, 0)>(vb); f.h0[0] = tr_read<v_rd_off(0, KS0, 1)>(vb); f.l1[0] = tr_read<v_rd_off(0, KS0 + 1, 0)>(vb); f.h1[0] = tr_read<v_rd_off(0, KS0 + 1, 1)>(vb);
    f.l0[1] = tr_read<v_rd_off(1, KS0, 0)>(vb); f.h0[1] = tr_read<v_rd_off(1, KS0, 1)>(vb); f.l1[1] = tr_read<v_rd_off(1, KS0 + 1, 0)>(vb); f.h1[1] = tr_read<v_rd_off(1, KS0 + 1, 1)>(vb);
    f.l0[2] = tr_read<v_rd_off(2, KS0, 0)>(vb); f.h0[2] = tr_read<v_rd_off(2, KS0, 1)>(vb); f.l1[2] = tr_read<v_rd_off(2, KS0 + 1, 0)>(vb); f.h1[2] = tr_read<v_rd_off(2, KS0 + 1, 1)>(vb);
    f.l0[3] = tr_read<v_rd_off(3, KS0, 0)>(vb); f.h0[3] = tr_read<v_rd_off(3, KS0, 1)>(vb); f.l1[3] = tr_read<v_rd_off(3, KS0 + 1, 0)>(vb); f.h1[3] = tr_read<v_rd_off(3, KS0 + 1, 1)>(vb);
}
__device__ __forceinline__ void pv_wait(VFrag& f) {
    asm volatile("s_waitcnt lgkmcnt(0)" : "+v"(f.l0[0]), "+v"(f.h0[0]), "+v"(f.l1[0]), "+v"(f.h1[0]), "+v"(f.l0[1]), "+v"(f.h0[1]), "+v"(f.l1[1]), "+v"(f.h1[1]),
                                          "+v"(f.l0[2]), "+v"(f.h0[2]), "+v"(f.l1[2]), "+v"(f.h1[2]), "+v"(f.l0[3]), "+v"(f.h0[3]), "+v"(f.l1[3]), "+v"(f.h1[3]) :: "memory");
}
__device__ __forceinline__ void pv_mma(f32x16* o, const VFrag& f, bf16x8 paA, bf16x8 paB) {
#define PK(L, H) (bf16x8){L[0], L[1], L[2], L[3], H[0], H[1], H[2], H[3]}
#pragma unroll
    for (int d = 0; d < 4; ++d) { o[d] = __builtin_amdgcn_mfma_f32_32x32x16_bf16(paA, PK(f.l0[d], f.h0[d]), o[d], 0, 0, 0); o[d] = __builtin_amdgcn_mfma_f32_32x32x16_bf16(paB, PK(f.l1[d], f.h1[d]), o[d], 0, 0, 0); }
#undef PK
}
struct UnitP {
    const bf16* Q; int ldq; int nq;
    const bf16* K; int ldk; const bf16* V; int ldv;
    void* O; int ldo;
    int NT;
    int kvalid;
    int lo_base, lo_step, hi_base, hi_step;
    int qpos0, kpos0; const float* tab;
    float negB;
    int fix_lo, fix_hi;
};
constexpr int LDS_ATT_V = 0, LDS_ATT_K = 49152, LDS_ATT_WS = RING_BYTES + 1024, LDS_ATT_TAB = LDS_ATT_WS + 2048, LDS_ATT_END = LDS_ATT_TAB + 1088;
static_assert(LDS_ATT_K + 3 * 24576 <= RING_BYTES && LDS_ATT_WS >= MISC_OFF + 128 && LDS_ATT_END <= EPI_OFF, "attention LDS");

template <int DQK, bool F32OUT, bool BIAS, bool PIPE2>
__device__ __forceinline__ void attn_unit(const UnitP& P, LAS char* lds) {
    constexpr int NQ = DQK / 16, KRB = DQK * 2, KCH = DQK / 8, KP = DQK / 64;
    constexpr int SHM_V = 16384, SHM_K = 64 * DQK * 2;
    constexpr float NEGINF = -__builtin_huge_valf();
    const int tid = fresh_tid(), wid = __builtin_amdgcn_readfirstlane(tid >> 6), lane = tid & 63, r32 = lane & 31, hi = lane >> 5;
    LAS char* V_lds = lds + LDS_ATT_V; LAS char* K_lds = lds + LDS_ATT_K;
    LAS float* ws = (LAS float*)(lds + LDS_ATT_WS) + wid * 64; LAS float* li_l = ws; LAS float* al_l = ws + 32;
    LAS float* tblS = (LAS float*)(lds + LDS_ATT_TAB);
    const int NT = P.NT, kvalid = P.kvalid;
    int lo_w = P.lo_base + P.lo_step * (wid >> 1); lo_w = lo_w < 0 ? 0 : lo_w;
    const int hi_w = P.hi_base + P.hi_step * (wid >> 1);
    float l_reg = 0.f; const float negB = P.negB; f32x16 o[4] = {}; bf16x8 qr[NQ];
    { int qrow = wid * 32 + r32; qrow = qrow < P.nq ? qrow : P.nq - 1;
      const bf16* Qw = P.Q + (size_t)qrow * P.ldq + hi * 8;
#pragma unroll
      for (int d0 = 0; d0 < NQ; ++d0) qr[d0] = *(const bf16x8*)(Qw + d0 * 16); }
    unsigned voffV[2], voffK[KP];
#pragma unroll
    for (int i = 0; i < 2; ++i) { const int b_ = (tid + 512 * i) * 16, st = b_ >> 9, kk = (st >> 2) * 8 + ((b_ & 511) >> 6), c = (st & 3) * 32 + ((b_ & 63) >> 1), k = (kk & ~0xC) | ((kk & 4) << 1) | ((kk & 8) >> 1);
        voffV[i] = (unsigned)(k * P.ldv + c) * 2u; }
#pragma unroll
    for (int p = 0; p < KP; ++p) { const int G = tid + 512 * p, row = G / KCH, slot = G % KCH, g = slot ^ (kswz<DQK>(row) >> 4); voffK[p] = (unsigned)(row * P.ldk + g * 8) * 2u; }
    const unsigned vb0 = (unsigned)(uintptr_t)V_lds + (unsigned)v_rd_base(lane);
    const bf16* Kh = P.K; const bf16* Vh = P.V; const int ldk = P.ldk, ldv = P.ldv;
#define DMA(b, k0) do { const char* vsrc_ = (const char*)(Vh + (size_t)(k0) * ldv); const char* ksrc_ = (const char*)(Kh + (size_t)(k0) * ldk); \
    _Pragma("unroll") for (int i = 0; i < 2; ++i) __builtin_amdgcn_global_load_lds((const unsigned*)(vsrc_ + voffV[i]), (LAS unsigned*)(V_lds + (b) * SHM_V + wid * 1024 + i * 8192), 16, 0, 0); \
    _Pragma("unroll") for (int p = 0; p < KP; ++p) __builtin_amdgcn_global_load_lds((const unsigned*)(ksrc_ + voffK[p]), (LAS unsigned*)(K_lds + (b) * SHM_K + wid * 1024 + p * 8192), 16, 0, 0); } while (0)
#define FIXUP(p0, p1, jt) do { \
    if ((jt) < P.fix_lo || (jt) >= P.fix_hi) { int kv_ = kvalid, lo_ = lo_w, hi_ = hi_w; asm volatile("; masked-tile path" : "+s"(kv_), "+s"(lo_), "+s"(hi_) :: "memory");     \
      if ((jt) < lo_ || (jt) > hi_) { _Pragma("unroll") for (int r = 0; r < 16; ++r) { p0[r] = NEGINF; p1[r] = NEGINF; } } \
      else if (((jt) + 1) * 64 > kv_) { _Pragma("unroll") for (int r = 0; r < 16; ++r) { const int key = (jt) * 64 + crow(r, hi); if (key >= kv_) p0[r] = NEGINF; if (key + 32 >= kv_) p1[r] = NEGINF; } } } \
    if constexpr (BIAS) { if ((jt) >= lo_w && (jt) <= hi_w) { const int kb_ = P.kpos0 + (jt) * 64, qw_ = P.qpos0 + wid * 32; \
        if (qw_ - (kb_ + 63) >= 128) { const float c_ = tblS[256]; _Pragma("unroll") for (int r = 0; r < 16; ++r) { p0[r] += c_; p1[r] += c_; } } \
        else { const int dq_ = qw_ + r32 - kb_; _Pragma("unroll") for (int r = 0; r < 16; ++r) { int d0_ = dq_ - crow(r, hi), d1_ = d0_ - 32; \
            d0_ = d0_ < -128 ? -128 : (d0_ > 128 ? 128 : d0_); d1_ = d1_ < -128 ? -128 : (d1_ > 128 ? 128 : d1_); p0[r] += tblS[d0_ + 128]; p1[r] += tblS[d1_ + 128]; } } } } \
    } while (0)
    f32x16 pA0, pA1; bf16x8 pa0, pa1, pa2, pa3;
    DMA(0, 0); if (1 < NT) DMA(1, 64);
    if constexpr (BIAS) { if (tid < 257) tblS[tid] = P.tab[tid] * 1.4426950408889634f; }
    if (1 < NT) { if constexpr (KP == 1) asm volatile("s_waitcnt vmcnt(3)" ::: "memory"); else if constexpr (KP == 2) asm volatile("s_waitcnt vmcnt(4)" ::: "memory"); else asm volatile("s_waitcnt vmcnt(5)" ::: "memory"); }
    else asm volatile("s_waitcnt vmcnt(0)" ::: "memory");
    asm volatile("s_waitcnt lgkmcnt(0)\n\ts_barrier" ::: "memory");
    if constexpr (!PIPE2) {
#define FIXUP_H(p, jt, kofs) do { \
    if ((jt) < P.fix_lo || (jt) >= P.fix_hi) { int kv_ = kvalid, lo_ = lo_w, hi_ = hi_w; asm volatile("; masked-tile path" : "+s"(kv_), "+s"(lo_), "+s"(hi_) :: "memory"); \
      if ((jt) < lo_ || (jt) > hi_) { _Pragma("unroll") for (int r = 0; r < 16; ++r) p[r] = NEGINF; } \
      else if (((jt) + 1) * 64 > kv_) { _Pragma("unroll") for (int r = 0; r < 16; ++r) { if ((jt) * 64 + (kofs) + crow(r, hi) >= kv_) p[r] = NEGINF; } } } \
    if constexpr (BIAS) { if ((jt) >= lo_w && (jt) <= hi_w) { const int kb_ = P.kpos0 + (jt) * 64 + (kofs), qw_ = P.qpos0 + wid * 32; \
        if (qw_ - (kb_ + 31) >= 128) { const float c_ = tblS[256]; _Pragma("unroll") for (int r = 0; r < 16; ++r) p[r] += c_; } \
        else { const int dq_ = qw_ + r32 - kb_; _Pragma("unroll") for (int r = 0; r < 16; ++r) { int d0_ = dq_ - crow(r, hi); d0_ = d0_ < -128 ? -128 : (d0_ > 128 ? 128 : d0_); p[r] += tblS[d0_ + 128]; } } } } \
    } while (0)
        static_assert(!PIPE2, "q is pre-scaled: only the half-tile loop is current");
        f32x16 cinit;
#pragma unroll
        for (int r = 0; r < 16; ++r) cinit[r] = negB;
        const bool wave_on = wid * 32 < P.nq;
        int bsel = 0;
        for (int j = 0; j < NT; ++j) {
            const int bn1 = bsel == 2 ? 0 : bsel + 1, bn2 = bn1 == 2 ? 0 : bn1 + 1;
            if (j + 2 < NT) DMA(bn2, (j + 2) * 64);
            if (wave_on && j >= lo_w && j <= hi_w) {
            SBAR(); qkt_h<DQK>(pA0, cinit, K_lds + bsel * SHM_K, 0, qr, r32, hi);
            FIXUP_H(pA0, j, 0);
            SBAR(); qkt_h<DQK>(pA1, cinit, K_lds + bsel * SHM_K, 32, qr, r32, hi); smx_h<DQK>(pA0, negB, l_reg, pa0, pa1);
            FIXUP_H(pA1, j, 32);
            if constexpr (true) {
                VFrag f0, f2; SBAR(); pv_issue<0>(f0, vb0 + bsel * SHM_V); pv_wait(f0); pv_issue<2>(f2, vb0 + bsel * SHM_V);
                pv_mma(o, f0, pa0, pa1); smx_h<DQK>(pA1, negB, l_reg, pa2, pa3);
                SBAR(); pv_wait(f2); pv_mma(o, f2, pa2, pa3); SBAR();
            } else {
            SBAR(); pv_half<0>(o, vb0 + bsel * SHM_V, pa0, pa1); smx_h<DQK>(pA1, negB, l_reg, pa2, pa3);
            SBAR(); pv_half<2>(o, vb0 + bsel * SHM_V, pa2, pa3); SBAR();
            }
            }
            if (j + 2 < NT) { if constexpr (KP == 1) asm volatile("s_waitcnt vmcnt(3) lgkmcnt(0)\n\ts_barrier" ::: "memory"); else if constexpr (KP == 2) asm volatile("s_waitcnt vmcnt(4) lgkmcnt(0)\n\ts_barrier" ::: "memory"); else asm volatile("s_waitcnt vmcnt(5) lgkmcnt(0)\n\ts_barrier" ::: "memory"); }
            else asm volatile("s_waitcnt vmcnt(0) lgkmcnt(0)\n\ts_barrier" ::: "memory");
            bsel = bn1;
        }
#undef FIXUP_H
    }
    { auto rr = __builtin_amdgcn_permlane32_swap(__float_as_uint(l_reg), __float_as_uint(l_reg), false, false); l_reg = __uint_as_float(rr[0]) + __uint_as_float(rr[1]); }
    if (hi == 0) li_l[r32] = l_reg; asm volatile("s_waitcnt lgkmcnt(0)" ::: "memory");
    float rli[16];
#pragma unroll
    for (int r = 0; r < 16; ++r) rli[r] = __builtin_amdgcn_rcpf(li_l[crow(r, hi)]);
    const int nq = P.nq, ldo = P.ldo;
#pragma unroll
    for (int r = 0; r < 16; ++r) { const int orow = wid * 32 + crow(r, hi);
        if (orow < nq) {
            if constexpr (F32OUT) { float* Ow = (float*)P.O + (size_t)orow * ldo + r32;
#pragma unroll
                for (int d0 = 0; d0 < 4; ++d0) Ow[d0 * 32] = o[d0][r] * rli[r]; }
            else { bf16* Ow = (bf16*)P.O + (size_t)orow * ldo + r32;
#pragma unroll
                for (int d0 = 0; d0 < 4; ++d0) Ow[d0 * 32] = (bf16)(cvtpk(o[d0][r] * rli[r], 0.f) & 0xffffu); }
        } }
    __syncthreads();
#undef DMA
#undef FIXUP
}
}

template <class T> __device__ __forceinline__ T* launder(T* p) { asm volatile("" : "+s"(p)); return p; }
struct Frame {
    LAS unsigned char* lds;
    int tid, lane, wave, vcu, G, bx;
    int gw, NGW;
    float* out; unsigned char* ws;
};
struct Args { const float* in[31]; float* out; unsigned char* ws; int ph_lo, ph_hi; int use_bar, pad; };
typedef const __attribute__((address_space(4))) Args* ArgsP;
__device__ __forceinline__ ArgsP fresh_args() { ArgsP p = (ArgsP)__builtin_amdgcn_kernarg_segment_ptr(); asm volatile("" : "+s"(p)); return p; }
enum { I_XP = 0, I_XS, I_CAK, I_CAV, I_CBC, I_CBP, I_CCK, I_CCV, I_ANORM, I_WIN, I_BGATE, I_AQN, I_AKN, I_ALAM, I_ASUB, I_BQAN, I_BKVN, I_WQB, I_WKVB, I_BQN, I_BKN, I_CQN, I_CKN, I_CBIAS,
       I_WBRA, I_WBRB, I_WBRC, I_WO, I_MNORM, I_WUP, I_WDN };

__device__ __forceinline__ void transpose_item(const float* W, int K, int N, bf16* WT, int ldw, int gap_at, int gap, LAS float* scr, int item, int lane) {
    const int nblk = N / 32, kb = item / nblk, nb = item % nblk, k0 = 64 * kb, n0 = 32 * nb;
    float t[32];
#pragma unroll
    for (int i = 0; i < 32; ++i) t[i] = W[(size_t)(k0 + 2 * i + (lane >> 5)) * N + n0 + (lane & 31)];
#pragma unroll
    for (int i = 0; i < 32; ++i) scr[(2 * i + (lane >> 5)) * 33 + (lane & 31)] = t[i];
    LDS_WAIT(); asm volatile("" ::: "memory");
    const int c = lane & 7; const int roff = (n0 >= gap_at) ? gap : 0;
#pragma unroll
    for (int j = 0; j < 4; ++j) { const int n = (lane >> 3) + 8 * j; const LAS float* s = scr + (8 * c) * 33 + n;
        u32x4 o; o.x = cvtpk(s[0 * 33], s[1 * 33]); o.y = cvtpk(s[2 * 33], s[3 * 33]); o.z = cvtpk(s[4 * 33], s[5 * 33]); o.w = cvtpk(s[6 * 33], s[7 * 33]);
        *(u32x4*)(WT + (size_t)(roff + n0 + n) * ldw + k0 + 8 * c) = o; }
    LDS_WAIT(); asm volatile("" ::: "memory");
}

__device__ __forceinline__ void rmsnorm_rows(const Frame& F, ArgsP A, const float* g, bf16* H, bool first, const float* slab, int ns) {
    float* X = F.out + OUT_Y;
    if (!first) {
        LAS float* part = (LAS float*)(F.lds + EPI_OFF);
        for (int rs = F.vcu; rs < MS; rs += F.G) {
            const size_t off = (size_t)rs * DM + 256 * F.wave + 4 * F.lane;
            f32x4 v = *(const f32x4*)(X + (size_t)MP * DM + off);
            const float* sp = slab + off;
            for (int k = 0; k < ns; k += 8) { f32x4 t[8];
#pragma unroll
                for (int q = 0; q < 8; ++q) t[q] = *(const f32x4*)(sp + (size_t)(k + q) * MS * DM);
#pragma unroll
                for (int q = 0; q < 8; ++q) v += t[q]; }
            const float ps = wave_sum((v.x * v.x + v.y * v.y) + (v.z * v.z + v.w * v.w));
            __syncthreads();
            if (F.lane == 0) part[F.wave] = ps;
            __syncthreads();
            float tot = 0.f;
#pragma unroll
            for (int w = 0; w < 8; ++w) tot += part[w];
            const float rstd = rsqrtf(tot * (1.f / DM) + EPS);
            const f32x4 gg = *(const f32x4*)(g + 256 * F.wave + 4 * F.lane);
            u32x2 w; w.x = cvtpk(v.x * rstd * gg.x, v.y * rstd * gg.y); w.y = cvtpk(v.z * rstd * gg.z, v.w * rstd * gg.w);
            *(u32x2*)(H + (size_t)MP * DM + off) = w;
            *(f32x4*)(X + (size_t)MP * DM + off) = v;
        }
    }
    constexpr int RU = 4;
    const int Rn = first ? M : MP;
    f32x4 gg[8];
#pragma unroll
    for (int j = 0; j < 8; ++j) gg[j] = *(const f32x4*)(g + 4 * F.lane + 256 * j);
    for (int row0 = F.gw; row0 < Rn; row0 += RU * F.NGW) {
        f32x4 v[RU][8];
#pragma unroll
        for (int u = 0; u < RU; ++u) { const int row = row0 + u * F.NGW;
            if (row < Rn) { const float* xr = first ? (row < MP ? A->in[I_XP] + (size_t)row * DM : A->in[I_XS] + (size_t)(row - MP) * DM) : X + (size_t)row * DM;
#pragma unroll
                for (int j = 0; j < 8; ++j) v[u][j] = *(const f32x4*)(xr + 4 * F.lane + 256 * j); } }
#pragma unroll
        for (int u = 0; u < RU; ++u) { const int row = row0 + u * F.NGW;
            if (row < Rn) {
                float ss = 0.f;
#pragma unroll
                for (int j = 0; j < 8; ++j) ss += (v[u][j].x * v[u][j].x + v[u][j].y * v[u][j].y) + (v[u][j].z * v[u][j].z + v[u][j].w * v[u][j].w);
                const float rstd = rsqrtf(wave_sum(ss) * (1.f / DM) + EPS);
#pragma unroll
                for (int j = 0; j < 8; ++j) {
                    u32x2 w; w.x = cvtpk(v[u][j].x * rstd * gg[j].x, v[u][j].y * rstd * gg[j].y); w.y = cvtpk(v[u][j].z * rstd * gg[j].z, v[u][j].w * rstd * gg[j].w);
                    *(u32x2*)(H + (size_t)row * DM + 4 * F.lane + 256 * j) = w;
                    if (first) *(f32x4*)(X + (size_t)row * DM + 4 * F.lane + 256 * j) = v[u][j]; } } }
    }
}
__device__ __forceinline__ void final_combine(const Frame& F, const float* slab, int ns) {
    float* X = F.out + OUT_Y;
    for (int rs = F.vcu; rs < MS; rs += F.G) {
        const size_t off = (size_t)rs * DM + 256 * F.wave + 4 * F.lane;
        f32x4 v = *(const f32x4*)(X + (size_t)MP * DM + off);
        const float* sp = slab + off;
        for (int k = 0; k < ns; k += 8) { f32x4 t[8];
#pragma unroll
            for (int q = 0; q < 8; ++q) t[q] = *(const f32x4*)(sp + (size_t)(k + q) * MS * DM);
#pragma unroll
            for (int q = 0; q < 8; ++q) v += t[q]; }
        *(f32x4*)(X + (size_t)MP * DM + off) = v;
    }
}
__device__ __forceinline__ void pre_weights(const Frame& F, ArgsP A, int l, unsigned char* wsw, int gw, int NGW, int it_lo = 0, int it_hi = 1 << 30) {
    LAS float* scr = (LAS float*)(F.lds + F.wave * 16384);
    constexpr int I_IN = (DM / 64) * (INCOLS / 32), I_QB = (512 / 64) * (1536 / 32), I_KVB = (256 / 64) * (2048 / 32), I_BA = (512 / 64) * (DM / 32), I_BB = (1024 / 64) * (DM / 32),
                  I_O = (DM / 64) * (DM / 32), I_UP = (DM / 64) * (DFF / 32), I_DN = (DFF / 64) * (DM / 32);
    constexpr int NITEMS = I_IN + I_QB + I_KVB + 2 * I_BA + I_BB + I_O + I_UP + I_DN;
    const int it_end = it_hi < NITEMS ? it_hi : NITEMS;
    for (int it = it_lo + gw; it < it_end; it += NGW) {
        int r = it;
        if (r < I_IN) { transpose_item(A->in[I_WIN] + (size_t)l * DM * INCOLS, DM, INCOLS, (bf16*)(wsw + WS_WIN), DM, 2368, 192, scr, r, F.lane); continue; } r -= I_IN;
        if (r < I_QB) { transpose_item(A->in[I_WQB] + (size_t)l * 512 * 1536, 512, 1536, (bf16*)(wsw + WS_WQB), 512, 1 << 30, 0, scr, r, F.lane); continue; } r -= I_QB;
        if (r < I_KVB) { transpose_item(A->in[I_WKVB] + (size_t)l * 256 * 2048, 256, 2048, (bf16*)(wsw + WS_WKVB), 256, 1 << 30, 0, scr, r, F.lane); continue; } r -= I_KVB;
        if (r < I_BA) { transpose_item(A->in[I_WBRA] + (size_t)l * 512 * DM, 512, DM, (bf16*)(wsw + WS_WBR), DM, 1 << 30, 0, scr, r, F.lane); continue; } r -= I_BA;
        if (r < I_BB) { transpose_item(A->in[I_WBRB] + (size_t)l * 1024 * DM, 1024, DM, (bf16*)(wsw + WS_WBR) + 512, DM, 1 << 30, 0, scr, r, F.lane); continue; } r -= I_BB;
        if (r < I_BA) { transpose_item(A->in[I_WBRC] + (size_t)l * 512 * DM, 512, DM, (bf16*)(wsw + WS_WBR) + 1536, DM, 1 << 30, 0, scr, r, F.lane); continue; } r -= I_BA;
        if (r < I_O) { transpose_item(A->in[I_WO] + (size_t)l * DM * DM, DM, DM, (bf16*)(wsw + WS_WO), DM, 1 << 30, 0, scr, r, F.lane); continue; } r -= I_O;
        if (r < I_UP) { transpose_item(A->in[I_WUP] + (size_t)l * DM * DFF, DM, DFF, (bf16*)(wsw + WS_WUP), DM, 1 << 30, 0, scr, r, F.lane); continue; } r -= I_UP;
        transpose_item(A->in[I_WDN] + (size_t)l * DFF * DM, DFF, DM, (bf16*)(wsw + WS_WDN), DFF, 1 << 30, 0, scr, r, F.lane);
    }
    const int gt = gw * 64 + F.lane, NGT = NGW * 64;
    if (it_lo == 0) {
        bf16* wz = (bf16*)(wsw + WS_WIN) + (size_t)2368 * DM;
        for (int i = gt; i < 192 * DM / 8; i += NGT) *(u32x4*)(wz + (size_t)i * 8) = (u32x4){0u, 0u, 0u, 0u};
    }
}
__device__ __forceinline__ void pre_caches(const Frame& F, ArgsP A, int l, int gw, int NGW) {
    unsigned char* ws = F.ws; const int gt = gw * 64 + F.lane, NGT = NGW * 64;
    {
        bf16* KA = (bf16*)(ws + WS_KA); bf16* VA = (bf16*)(ws + WS_VA); bf16* CKV = (bf16*)(ws + WS_CKV); float* KPE = (float*)(ws + WS_KPE); bf16* KC = (bf16*)(ws + WS_KC); bf16* VC = (bf16*)(ws + WS_VC);
        const float* cak = A->in[I_CAK] + (size_t)l * DECB * PAST * 512; const float* cav = A->in[I_CAV] + (size_t)l * DECB * PAST * 512;
        const float* cbc = A->in[I_CBC] + (size_t)l * DECB * PAST * 256; const float* cbp = A->in[I_CBP] + (size_t)l * DECB * PAST * 64;
        const float* cck = A->in[I_CCK] + (size_t)l * DECB * CPAST * 512; const float* ccv = A->in[I_CCV] + (size_t)l * DECB * CPAST * 512;
        for (int i0 = gt; i0 < DECB * PAST * 512 / 8; i0 += 4 * NGT) { f32x4 ka[4][2], va[4][2];
#pragma unroll
            for (int u = 0; u < 4; ++u) { const int i = i0 + u * NGT; if (i < DECB * PAST * 512 / 8) { const float* pk = cak + (size_t)i * 8; const float* pv = cav + (size_t)i * 8;
                ka[u][0] = *(const f32x4*)pk; ka[u][1] = *(const f32x4*)(pk + 4); va[u][0] = *(const f32x4*)pv; va[u][1] = *(const f32x4*)(pv + 4); } }
#pragma unroll
            for (int u = 0; u < 4; ++u) { const int i = i0 + u * NGT; if (i < DECB * PAST * 512 / 8) { const int c = (i & 63) * 8, rr = i >> 6, b = rr >> 11, p = rr & 2047; const size_t d = ((size_t)MP + b * SROWS + p) * 512 + c;
                *(u32x4*)(KA + d) = pg8::pk8(ka[u][0], ka[u][1]); *(u32x4*)(VA + d) = pg8::pk8(va[u][0], va[u][1]); } } }
        for (int i0 = gt; i0 < DECB * PAST * 256 / 8; i0 += 4 * NGT) { f32x4 ka[4][2];
#pragma unroll
            for (int u = 0; u < 4; ++u) { const int i = i0 + u * NGT; if (i < DECB * PAST * 256 / 8) { const float* pk = cbc + (size_t)i * 8; ka[u][0] = *(const f32x4*)pk; ka[u][1] = *(const f32x4*)(pk + 4); } }
#pragma unroll
            for (int u = 0; u < 4; ++u) { const int i = i0 + u * NGT; if (i < DECB * PAST * 256 / 8) { const int c = (i & 31) * 8, rr = i >> 5, b = rr >> 11, p = rr & 2047; const size_t d = ((size_t)MP + b * SROWS + p) * 256 + c;
                *(u32x4*)(CKV + d) = pg8::pk8(ka[u][0], ka[u][1]); } } }
        for (int i = gt; i < DECB * PAST * 64 / 8; i += NGT) { const int c = (i & 7) * 8, rr = i >> 3, b = rr >> 11, p = rr & 2047; const size_t d = ((size_t)MP + b * SROWS + p) * 64 + c;
            float v[8]; ld8f(cbp + (size_t)i * 8, v); st8f(KPE + d, v); }
        for (int i0 = gt; i0 < DECB * CPAST * 512 / 8; i0 += 4 * NGT) { f32x4 ka[4][2], va[4][2];
#pragma unroll
            for (int u = 0; u < 4; ++u) { const int i = i0 + u * NGT; if (i < DECB * CPAST * 512 / 8) { const float* pk = cck + (size_t)i * 8; const float* pv = ccv + (size_t)i * 8;
                ka[u][0] = *(const f32x4*)pk; ka[u][1] = *(const f32x4*)(pk + 4); va[u][0] = *(const f32x4*)pv; va[u][1] = *(const f32x4*)(pv + 4); } }
#pragma unroll
            for (int u = 0; u < 4; ++u) { const int i = i0 + u * NGT; if (i < DECB * CPAST * 512 / 8) { const int c = (i & 63) * 8, rr = i >> 6, b = rr >> 9, p = rr & 511; const size_t d = ((size_t)MP + b * CROWS + p) * 512 + c;
                *(u32x4*)(KC + d) = pg8::pk8(ka[u][0], ka[u][1]); *(u32x4*)(VC + d) = pg8::pk8(va[u][0], va[u][1]); } } }
        const u32x4 z4 = (u32x4){0u, 0u, 0u, 0u};
        for (int i = gt; i < DECB * 112 * 64; i += NGT) { const int c = (i & 63) * 8, rr = i >> 6, b = rr / 112, p = rr % 112;
            const size_t d = ((size_t)MP + b * SROWS + PAST + DECS + p) * 512 + c; *(u32x4*)(KA + d) = z4; *(u32x4*)(VA + d) = z4;
            const size_t dc = ((size_t)MP + b * CROWS + CPAST + DECS + p) * 512 + c; *(u32x4*)(KC + dc) = z4; *(u32x4*)(VC + dc) = z4; }
        for (int i = gt; i < DECB * 112 * 32; i += NGT) { const int c = (i & 31) * 8, rr = i >> 5, b = rr / 112, p = rr % 112;
            const size_t d = ((size_t)MP + b * SROWS + PAST + DECS + p) * 256 + c; *(u32x4*)(CKV + d) = z4; }
        for (int i = gt; i < DECB * 112 * 16; i += NGT) { const int c = (i & 15) * 4, rr = i >> 4, b = rr / 112, p = rr % 112;
            const size_t d = ((size_t)MP + b * SROWS + PAST + DECS + p) * 64 + c; *(f32x4*)(KPE + d) = (f32x4){0.f, 0.f, 0.f, 0.f}; }
    }
}
constexpr size_t WS_SLAB_O = WS_R2, WS_SLAB_DN = WS_R2 + 64 * MiB;
constexpr int NS_O = 16, NS_DN = 32;
static_assert(NS_O % 8 == 0 && NS_DN % 8 == 0 && (size_t)NS_O * MS * DM * 4 <= 64 * MiB && (size_t)NS_DN * MS * DM * 4 <= 64 * MiB && WS_SLAB_DN + 64 * MiB <= WS_OALL, "slabs");
constexpr int WCUT1 = 13000, WCUT2 = 26500;
constexpr size_t WS_WSET1 = 1823 * MiB;
static_assert(WS_WDN + WS_WSET1 + (size_t)DM * DFF * 2 <= 2032 * MiB && WS_WIN + WS_WSET1 >= WS_END, "second weight set");
__device__ __forceinline__ void phase_pre(const Frame& F, ArgsP A, int l) {
    if (l == 0) { pre_weights(F, A, 0, F.ws, F.gw, F.NGW); pre_caches(F, A, 0, F.gw, F.NGW); }
    rmsnorm_rows(F, A, A->in[I_ANORM] + (size_t)l * DM, (bf16*)(F.ws + WS_R3), l == 0, (const float*)(F.ws + WS_SLAB_DN), NS_DN);
}

__device__ __forceinline__ float rope_inv(int lane) { return __builtin_amdgcn_exp2f(-(float)(lane & 31) * (18.931568569324174f / 32.f)); }
__device__ __forceinline__ void rope_cs(int pos, float inv, float& cs, float& sn) {
    const float a = (float)pos * inv; const float k = rintf(a * 0.15915494309189535f);
    float r = fmaf(-k, 6.28125f, a); r = fmaf(-k, 1.9353071795864769e-3f, r);
    const float rev = r * 0.15915494309189535f;
    cs = __builtin_amdgcn_cosf(rev); sn = __builtin_amdgcn_sinf(rev);
}

__device__ __forceinline__ void phase_post_in(const Frame& F, ArgsP A, int l) {
    unsigned char* ws = F.ws; const int lane = F.lane;
    const bf16* Z = (const bf16*)(ws + WS_R1);
    bf16* QA = (bf16*)(ws + WS_QA); bf16* KA = (bf16*)(ws + WS_KA); bf16* VA = (bf16*)(ws + WS_VA); bf16* CQ = (bf16*)(ws + WS_CQ); bf16* CKV = (bf16*)(ws + WS_CKV); float* KPE = (float*)(ws + WS_KPE);
    bf16* QC = (bf16*)(ws + WS_QC); bf16* KC = (bf16*)(ws + WS_KC); bf16* VC = (bf16*)(ws + WS_VC);
    const float inv = rope_inv(lane);
    float gq[8], gk[8], gqa[8], gkv[8], gcq[8], gck[8];
    ld8f(A->in[I_AQN] + l * 64 + 8 * (lane & 7), gq); ld8f(A->in[I_AKN] + l * 64 + 8 * (lane & 7), gk);
    ld8f(A->in[I_BQAN] + l * 512 + 8 * lane, gqa); ld8f(A->in[I_BKVN] + l * 256 + 8 * (lane & 31), gkv);
    ld8f(A->in[I_CQN] + l * 128 + 8 * (lane & 15), gcq); ld8f(A->in[I_CKN] + l * 128 + 8 * (lane & 15), gck);
    u32x4 zc[8], zn[8];
    if (F.gw < M) {
#pragma unroll
        for (int q = 0; q < 8; ++q) zc[q] = *(const u32x4*)(Z + (size_t)F.gw * NZ + 8 * lane + 512 * q); }
    for (int row = F.gw; row < M; row += F.NGW) {
        { const int nrow = row + F.NGW;
          if (nrow < M) {
#pragma unroll
              for (int q = 0; q < 8; ++q) zn[q] = *(const u32x4*)(Z + (size_t)nrow * NZ + 8 * lane + 512 * q); } }
        const bool samp = row >= MP; int b, t, pos;
        if (!samp) { b = row >> 14; t = row & (SEQ - 1); pos = t; } else { const int r = row - MP; b = r >> 4; t = r & 15; pos = PAST + t; }
        const size_t kvrow = samp ? (size_t)MP + b * SROWS + PAST + t : (size_t)row;
        const size_t ccrow = samp ? (size_t)MP + b * CROWS + CPAST + t : (size_t)row;
        float* o_ak = F.out + (samp ? OUT_AK_S + ((size_t)l * MS + (row - MP)) * 512 : OUT_AK_P + ((size_t)l * MP + row) * 512) + 8 * lane;
        float* o_av = F.out + (samp ? OUT_AV_S + ((size_t)l * MS + (row - MP)) * 512 : OUT_AV_P + ((size_t)l * MP + row) * 512) + 8 * lane;
        float* o_bc = F.out + (samp ? OUT_BC_S + ((size_t)l * MS + (row - MP)) * 256 : OUT_BC_P + ((size_t)l * MP + row) * 256) + 8 * (lane & 31);
        float* o_bp = F.out + (samp ? OUT_BP_S + ((size_t)l * MS + (row - MP)) * 64 : OUT_BP_P + ((size_t)l * MP + row) * 64) + 8 * (lane & 7);
        const bool cout = samp || t >= SEQ - 512;
        float* o_ck = F.out + (samp ? OUT_CK_S + ((size_t)l * MS + (row - MP)) * 512 : OUT_CK_P + (((size_t)l * NBATCH + b) * 512 + (t - (SEQ - 512))) * 512) + 8 * lane;
        float* o_cv = F.out + (samp ? OUT_CV_S + ((size_t)l * MS + (row - MP)) * 512 : OUT_CV_P + (((size_t)l * NBATCH + b) * 512 + (t - (SEQ - 512))) * 512) + 8 * lane;
        float cs, sn; rope_cs(pos, inv, cs, sn);
        float v[8], y[8];
#pragma unroll
        for (int seg = 0; seg < 2; ++seg) {
            unpack8(zc[seg], v);
            float ss = sumsq8(v); ss += __shfl_xor(ss, 1); ss += __shfl_xor(ss, 2); ss += __shfl_xor(ss, 4);
            const float rstd = rsqrtf(ss * (1.f / 64) + EPS);
#pragma unroll
            for (int e = 0; e < 8; ++e) y[e] = v[e] * rstd * (seg == 0 ? gq[e] : gk[e]);
#pragma unroll
            for (int e = 0; e < 8; ++e) { const float part = __shfl_xor(y[e], 1), c = __shfl(cs, 4 * e), s = __shfl(sn, 4 * e);
                if ((lane & 7) == 0) y[e] = y[e] * c - part * s; else if ((lane & 7) == 1) y[e] = y[e] * c + part * s; }
            if (seg == 0) { float yq[8];
#pragma unroll
                for (int e = 0; e < 8; ++e) yq[e] = y[e] * att::Cn<64>::C;
                *(u32x4*)(QA + (size_t)row * 512 + 8 * lane) = pack8(yq); }
            else { *(u32x4*)(KA + kvrow * 512 + 8 * lane) = pack8(y); st8f_nt(o_ak, y); }
        }
        { const u32x4 w = zc[2]; *(u32x4*)(VA + kvrow * 512 + 8 * lane) = w; unpack8(w, v); st8f_nt(o_av, v); }
        { unpack8(zc[3], v); const float rstd = rsqrtf(wave_sum(sumsq8(v)) * (1.f / 512) + EPS);
#pragma unroll
          for (int e = 0; e < 8; ++e) y[e] = v[e] * rstd * gqa[e];
          *(u32x4*)(CQ + (size_t)row * 512 + 8 * lane) = pack8(y); }
        { unpack8(zc[4], v);
          float ss = sumsq8(v); ss += __shfl_xor(ss, 1); ss += __shfl_xor(ss, 2); ss += __shfl_xor(ss, 4); ss += __shfl_xor(ss, 8); ss += __shfl_xor(ss, 16);
          const float rstd = rsqrtf(ss * (1.f / 256) + EPS);
          const int i = lane & 7;
#pragma unroll
          for (int e = 0; e < 8; ++e) { const float part = __shfl_xor(v[e], 4); const int fi = 8 * (i & 3) + e; const float c = __shfl(cs, fi), s = __shfl(sn, fi);
              y[e] = (lane < 32) ? v[e] * rstd * gkv[e] : ((i < 4) ? v[e] * c - part * s : v[e] * c + part * s); }
          if (lane < 32) { *(u32x4*)(CKV + kvrow * 256 + 8 * lane) = pack8(y); st8f_nt(o_bc, y); }
          else if (lane < 40) { st8f(KPE + kvrow * 64 + 8 * i, y); st8f_nt(o_bp, y); } }
#pragma unroll
        for (int seg = 0; seg < 2; ++seg) {
            unpack8(zc[5 + seg], v);
            float ss = sumsq8(v); ss += __shfl_xor(ss, 1); ss += __shfl_xor(ss, 2); ss += __shfl_xor(ss, 4); ss += __shfl_xor(ss, 8);
            const float rstd = rsqrtf(ss * (1.f / 128) + EPS);
#pragma unroll
            for (int e = 0; e < 8; ++e) y[e] = v[e] * rstd * (seg == 0 ? gcq[e] * att::Cn<128>::C : gck[e]);
            if (seg == 0) *(u32x4*)(QC + (size_t)row * 512 + 8 * lane) = pack8(y);
            else { *(u32x4*)(KC + ccrow * 512 + 8 * lane) = pack8(y); if (cout) st8f_nt(o_ck, y); }
        }
        { const u32x4 w = zc[7]; *(u32x4*)(VC + ccrow * 512 + 8 * lane) = w; if (cout) { unpack8(w, v); st8f_nt(o_cv, v); } }
#pragma unroll
        for (int q = 0; q < 8; ++q) zc[q] = zn[q];
    }
}

__device__ __forceinline__ void phase_post_b(const Frame& F, ArgsP A, int l) {
    unsigned char* ws = F.ws; const int lane = F.lane, h = lane >> 3, i = lane & 7;
    const bf16* QBR = (const bf16*)(ws + WS_R2); const bf16* KVR = (const bf16*)(ws + WS_R1); const float* KPE = (const float*)(ws + WS_KPE);
    bf16* QB = (bf16*)(ws + WS_QB); bf16* KB = (bf16*)(ws + WS_R3);
    const float inv = rope_inv(lane);
    float g0[8], g1[8], g2[8];
    ld8f(A->in[I_BQN] + l * 192 + 8 * i, g0); ld8f(A->in[I_BQN] + l * 192 + 64 + 8 * i, g1); ld8f(A->in[I_BQN] + l * 192 + 128 + 8 * i, g2);
    constexpr int RU = 4;
    for (int row0 = F.gw; row0 < M; row0 += RU * F.NGW) {
        u32x4 w0[RU], w1[RU], w2[RU];
#pragma unroll
        for (int u = 0; u < RU; ++u) { const int row = row0 + u * F.NGW;
            if (row < M) { const bf16* src = QBR + (size_t)row * 1536 + 192 * h + 8 * i; w0[u] = *(const u32x4*)src; w1[u] = *(const u32x4*)(src + 64); w2[u] = *(const u32x4*)(src + 128); } }
#pragma unroll
        for (int u = 0; u < RU; ++u) { const int row = row0 + u * F.NGW;
            if (row < M) {
                const int pos = row < MP ? (row & (SEQ - 1)) : PAST + ((row - MP) & 15);
                float cs, sn; rope_cs(pos, inv, cs, sn);
                float v0[8], v1[8], v2[8]; unpack8(w0[u], v0); unpack8(w1[u], v1); unpack8(w2[u], v2);
#pragma unroll
                for (int e = 0; e < 8; ++e) { const float part = __shfl_xor(v2[e], 4); const int fi = 8 * (i & 3) + e; const float c = __shfl(cs, fi), s = __shfl(sn, fi);
                    v2[e] = (i < 4) ? v2[e] * c - part * s : v2[e] * c + part * s; }
                float ss = sumsq8(v0) + sumsq8(v1) + sumsq8(v2); ss += __shfl_xor(ss, 1); ss += __shfl_xor(ss, 2); ss += __shfl_xor(ss, 4);
                const float rstd = rsqrtf(ss * (1.f / 192) + EPS);
#pragma unroll
                for (int e = 0; e < 8; ++e) { v0[e] *= rstd * g0[e] * att::Cn<192>::C; v1[e] *= rstd * g1[e] * att::Cn<192>::C; v2[e] *= rstd * g2[e] * att::Cn<192>::C; }
                bf16* dst = QB + (size_t)row * 1536 + 192 * h + 8 * i;
                *(u32x4*)dst = pack8(v0); *(u32x4*)(dst + 64) = pack8(v1); *(u32x4*)(dst + 128) = pack8(v2); } }
    }
    ld8f(A->in[I_BKN] + l * 192 + 8 * i, g0); ld8f(A->in[I_BKN] + l * 192 + 64 + 8 * i, g1); ld8f(A->in[I_BKN] + l * 192 + 128 + 8 * i, g2);
    for (int row0 = F.gw; row0 < M2; row0 += RU * F.NGW) {
        u32x4 w0[RU], w1[RU]; f32x4 p0[RU], p1[RU];
#pragma unroll
        for (int u = 0; u < RU; ++u) { const int row = row0 + u * F.NGW;
            if (row < M2) { const bf16* src = KVR + (size_t)row * 2048 + 256 * h + 8 * i; w0[u] = *(const u32x4*)src; w1[u] = *(const u32x4*)(src + 64);
                const float* kp = KPE + (size_t)row * 64 + 8 * i; p0[u] = *(const f32x4*)kp; p1[u] = *(const f32x4*)(kp + 4); } }
#pragma unroll
        for (int u = 0; u < RU; ++u) { const int row = row0 + u * F.NGW;
            if (row < M2) {
                float v0[8], v1[8], v2[8]; unpack8(w0[u], v0); unpack8(w1[u], v1);
                v2[0] = p0[u].x; v2[1] = p0[u].y; v2[2] = p0[u].z; v2[3] = p0[u].w; v2[4] = p1[u].x; v2[5] = p1[u].y; v2[6] = p1[u].z; v2[7] = p1[u].w;
                float ss = sumsq8(v0) + sumsq8(v1) + sumsq8(v2); ss += __shfl_xor(ss, 1); ss += __shfl_xor(ss, 2); ss += __shfl_xor(ss, 4);
                const float rstd = rsqrtf(ss * (1.f / 192) + EPS);
#pragma unroll
                for (int e = 0; e < 8; ++e) { v0[e] *= rstd * g0[e]; v1[e] *= rstd * g1[e]; v2[e] *= rstd * g2[e]; }
                bf16* dst = KB + (size_t)row * 1536 + 192 * h + 8 * i;
                *(u32x4*)dst = pack8(v0); *(u32x4*)(dst + 64) = pack8(v1); *(u32x4*)(dst + 128) = pack8(v2); } }
    }
}

__device__ __forceinline__ void phase_post_a(const Frame& F, ArgsP A, int l) {
    unsigned char* ws = F.ws; const int lane = F.lane, h = lane >> 4, i = lane & 15;
    const float* OAR = (const float*)(ws + WS_R2); bf16* OA = (bf16*)(ws + WS_OALL);
    const float* lf = A->in[I_ALAM] + l * 256;
    const float s1 = wave_sum(lf[lane] * lf[64 + lane]), s2 = wave_sum(lf[128 + lane] * lf[192 + lane]);
    const float lam_init = 0.8f - 0.6f * expf(-0.3f * (float)l);
    const float lam = expf(s1) - expf(s2) + lam_init, og = 1.f - lam_init;
    float g[8]; ld8f(A->in[I_ASUB] + l * 128 + 8 * i, g);
    constexpr int RU = 4;
    for (int row0 = F.gw; row0 < M; row0 += RU * F.NGW) {
        f32x4 a0[RU], a1[RU], b0[RU], b1[RU];
#pragma unroll
        for (int u = 0; u < RU; ++u) { const int row = row0 + u * F.NGW;
            if (row < M) { const float* src = OAR + (size_t)row * 1024 + 256 * h + 8 * i; a0[u] = *(const f32x4*)src; a1[u] = *(const f32x4*)(src + 4); b0[u] = *(const f32x4*)(src + 128); b1[u] = *(const f32x4*)(src + 132); } }
#pragma unroll
        for (int u = 0; u < RU; ++u) { const int row = row0 + u * F.NGW;
            if (row < M) {
                float d[8];
                d[0] = a0[u].x - lam * b0[u].x; d[1] = a0[u].y - lam * b0[u].y; d[2] = a0[u].z - lam * b0[u].z; d[3] = a0[u].w - lam * b0[u].w;
                d[4] = a1[u].x - lam * b1[u].x; d[5] = a1[u].y - lam * b1[u].y; d[6] = a1[u].z - lam * b1[u].z; d[7] = a1[u].w - lam * b1[u].w;
                float ss = sumsq8(d); ss += __shfl_xor(ss, 1); ss += __shfl_xor(ss, 2); ss += __shfl_xor(ss, 4); ss += __shfl_xor(ss, 8);
                const float rstd = rsqrtf(ss * (1.f / 128) + EPS) * og;
#pragma unroll
                for (int e = 0; e < 8; ++e) d[e] *= rstd * g[e];
                *(u32x4*)(OA + (size_t)row * 2048 + 128 * h + 8 * i) = pack8(d); } }
    }
}

template <int N> __device__ __forceinline__ float absmax_part(const float* g, int lane) {
    float v[(N + 63) / 64];
#pragma unroll
    for (int k = 0; k < (N + 63) / 64; ++k) { const int i = lane + 64 * k; v[k] = g[i < N ? i : N - 1]; }
    float m = 0.f;
#pragma unroll
    for (int k = 0; k < (N + 63) / 64; ++k) m = fmaxf(m, fabsf(v[k]));
    return m;
}
__device__ __forceinline__ float wave_max(float m) {
#pragma unroll
    for (int o = 1; o < 64; o <<= 1) m = fmaxf(m, __shfl_xor(m, o));
    return __uint_as_float(__builtin_amdgcn_readfirstlane(__float_as_uint(m)));
}
__device__ __forceinline__ void phase_attn(const Frame& F, ArgsP A, int l) {
    unsigned char* ws = F.ws; LAS char* lds = (LAS char*)F.lds;
    const bf16* QA = (const bf16*)(ws + WS_QA); const bf16* KA = (const bf16*)(ws + WS_KA); const bf16* VA = (const bf16*)(ws + WS_VA);
    const bf16* QB = (const bf16*)(ws + WS_QB); const bf16* KB = (const bf16*)(ws + WS_R3); const bf16* KVR = (const bf16*)(ws + WS_R1);
    const bf16* QC = (const bf16*)(ws + WS_QC); const bf16* KC = (const bf16*)(ws + WS_KC); const bf16* VC = (const bf16*)(ws + WS_VC);
    float* OAR = (float*)(ws + WS_R2); bf16* OB = (bf16*)(ws + WS_OALL) + 512; bf16* OC = (bf16*)(ws + WS_OALL) + 1536;
    const float p_aq = absmax_part<64>(A->in[I_AQN] + l * 64, F.lane), p_ak = absmax_part<64>(A->in[I_AKN] + l * 64, F.lane);
    const float p_bq = absmax_part<192>(A->in[I_BQN] + l * 192, F.lane), p_bk = absmax_part<192>(A->in[I_BKN] + l * 192, F.lane);
    const float p_cq = absmax_part<128>(A->in[I_CQN] + l * 128, F.lane), p_ck = absmax_part<128>(A->in[I_CKN] + l * 128, F.lane);
    const float p_cb = absmax_part<4 * 257>(A->in[I_CBIAS] + (size_t)l * 4 * 257, F.lane);
    const float negB_A = -1.4426950408889634f * 1.02f * 8.f * wave_max(p_aq) * wave_max(p_ak);
    const float negB_B = -1.4426950408889634f * 1.02f * 13.856406460551018f * wave_max(p_bq) * wave_max(p_bk);
    const float negB_C = -1.4426950408889634f * (1.02f * 11.313708498984761f * wave_max(p_cq) * wave_max(p_ck) + wave_max(p_cb));
#ifndef ATTM
#define ATTM 7
#endif
    if (ATTM & 1) for (int n = F.vcu; n < 1024 + 128; n += F.G) {
        att::UnitP P; P.ldq = 512; P.ldk = 512; P.ldv = 512; P.ldo = 1024; P.qpos0 = 0; P.kpos0 = 0; P.tab = nullptr; P.lo_base = 0; P.lo_step = 0;
        if (n < 1024) { const int v = n & 255, slot = n >> 8, x = v >> 5, j = v & 31, combo = 2 * x + (slot >> 1), b = combo >> 3, vh = combo & 7, i = (slot & 1) ? j : 63 - j;
            const size_t qrow = (size_t)b * SEQ + 256 * i, krow = (size_t)b * SEQ;
            P.Q = QA + qrow * 512 + 64 * vh; P.nq = 256; P.K = KA + krow * 512 + 64 * vh; P.V = VA + krow * 512 + 128 * (vh >> 1); P.O = OAR + qrow * 1024 + 128 * vh;
            P.NT = 4 * i + 4; P.kvalid = P.NT * 64; P.hi_base = 4 * i; P.hi_step = 1; P.fix_lo = 0; P.fix_hi = P.NT - 3;
        } else { const int s = n - 1024, b = s >> 3, vh = s & 7; const size_t qrow = (size_t)MP + 16 * b, krow = (size_t)MP + (size_t)b * SROWS;
            P.Q = QA + qrow * 512 + 64 * vh; P.nq = 16; P.K = KA + krow * 512 + 64 * vh; P.V = VA + krow * 512 + 128 * (vh >> 1); P.O = OAR + qrow * 1024 + 128 * vh;
            P.NT = SROWS / 64; P.kvalid = PAST + DECS; P.hi_base = SROWS / 64; P.hi_step = 0; P.fix_lo = 0; P.fix_hi = (PAST + DECS) / 64; }
        P.negB = negB_A; att::attn_unit<64, true, false, false>(P, lds);
    }
    if (ATTM & 2) for (int n = F.vcu; n < 1024 + 256; n += F.G) {
        att::UnitP P; P.ldq = 1536; P.ldk = 1536; P.ldv = 2048; P.ldo = 2048; P.qpos0 = 0; P.kpos0 = 0; P.tab = nullptr; P.lo_base = 0; P.lo_step = 0;
        if (n < 1024) { const int v = n & 255, slot = n >> 8, x = v >> 5, j = v & 31, combo = 2 * x + (slot >> 1), b = combo >> 3, hh = combo & 7, i = (slot & 1) ? j : 63 - j;
            const size_t qrow = (size_t)b * SEQ + 256 * i, krow = (size_t)b * SEQ;
            P.Q = QB + qrow * 1536 + 192 * hh; P.nq = 256; P.K = KB + krow * 1536 + 192 * hh; P.V = KVR + krow * 2048 + 256 * hh + 128; P.O = OB + qrow * 2048 + 128 * hh;
            P.NT = 4 * i + 4; P.kvalid = P.NT * 64; P.hi_base = 4 * i; P.hi_step = 1; P.fix_lo = 0; P.fix_hi = P.NT - 3;
        } else { const int s = n - 1024 - 128; if (s < 0) continue; const int b = s >> 3, hh = s & 7; const size_t qrow = (size_t)MP + 16 * b, krow = (size_t)MP + (size_t)b * SROWS;
            P.Q = QB + qrow * 1536 + 192 * hh; P.nq = 16; P.K = KB + krow * 1536 + 192 * hh; P.V = KVR + krow * 2048 + 256 * hh + 128; P.O = OB + qrow * 2048 + 128 * hh;
            P.NT = SROWS / 64; P.kvalid = PAST + DECS; P.hi_base = SROWS / 64; P.hi_step = 0; P.fix_lo = 0; P.fix_hi = (PAST + DECS) / 64; }
        P.negB = negB_B; att::attn_unit<192, false, false, false>(P, lds);
    }
    if (ATTM & 4) for (int n = F.vcu; n < 512 + 64; n += F.G) {
        att::UnitP P; P.ldq = 512; P.ldk = 512; P.ldv = 512; P.ldo = 2048;
        if (n < 512) { const int v = n & 255, slot = n >> 8, x = v >> 5, j = v & 31, b = x >> 2, hh = x & 3, i = j + 32 * slot, c0 = 4 * i, T0 = c0 >= 8 ? c0 - 8 : 0;
            const size_t qrow = (size_t)b * SEQ + 256 * i, krow = (size_t)b * SEQ + 64 * T0;
            P.Q = QC + qrow * 512 + 128 * hh; P.nq = 256; P.K = KC + krow * 512 + 128 * hh; P.V = VC + krow * 512 + 128 * hh; P.O = OC + qrow * 2048 + 128 * hh;
            P.NT = c0 + 4 - T0; P.kvalid = P.NT * 64; P.hi_base = c0 - T0; P.hi_step = 1; P.lo_base = c0 - 8 - T0; P.lo_step = 1; P.qpos0 = 256 * i; P.kpos0 = 64 * T0; P.fix_lo = 3; P.fix_hi = P.NT - 3;
            P.tab = A->in[I_CBIAS] + ((size_t)l * 4 + hh) * 257;
        } else { const int s = n - 512, b = s >> 2, hh = s & 3; const size_t qrow = (size_t)MP + 16 * b, krow = (size_t)MP + (size_t)b * CROWS;
            P.Q = QC + qrow * 512 + 128 * hh; P.nq = 16; P.K = KC + krow * 512 + 128 * hh; P.V = VC + krow * 512 + 128 * hh; P.O = OC + qrow * 2048 + 128 * hh;
            P.NT = CROWS / 64; P.kvalid = CPAST + DECS; P.hi_base = CROWS / 64; P.hi_step = 0; P.lo_base = 0; P.lo_step = 0; P.qpos0 = PAST; P.kpos0 = PAST - CPAST; P.fix_lo = 0; P.fix_hi = (CPAST + DECS) / 64;
            P.tab = A->in[I_CBIAS] + ((size_t)l * 4 + hh) * 257; }
        P.negB = negB_C; att::attn_unit<128, false, true, false>(P, lds);
    }
}

constexpr int NPH = 12, NPHASES = NPH * DEPTH + 1;

template <int l>
__device__ __forceinline__ void layer_body(Frame& F, LAS unsigned char* lds0, volatile LAS unsigned* MISC, const int lo, const int hi) {
#ifndef PHM
#define PHM 0xfff
#endif
#define IN(k) (((PHM >> ((k) % NPH)) & 1) && lo <= (k) && (k) < hi)
#define SEAM(k) do { if (IN(k) && IN((k) + 1)) { XcdBarrier b2; b2.bar = (unsigned*)(fresh_args()->ws + WS_CTL) + CW_BAR; b2.x = xb_xcc_id(); b2.st = MISC + 8; xcd_barrier(b2); } } while (0)
    bf16 *H, *Zb, *GT, *U; float* X;
#define FRESH() do { Ap = fresh_args(); F.tid = fresh_tid(); F.lane = F.tid & 63; F.wave = __builtin_amdgcn_readfirstlane(F.tid >> 6); \
    { int bx_ = blockIdx.x, G_ = gridDim.x; asm volatile("" : "+s"(bx_), "+s"(G_)); F.bx = bx_; F.G = G_; F.vcu = (G_ % 8 == 0) ? (bx_ % 8) * (G_ / 8) + bx_ / 8 : bx_; F.gw = F.vcu * 8 + F.wave; F.NGW = G_ * 8; } \
    { unsigned lb_ = 0; asm volatile("" : "+s"(lb_)); F.lds = lds0 + lb_; } \
    F.ws = Ap->ws; F.out = Ap->out; ws = F.ws; H = (bf16*)(ws + WS_R3); Zb = (bf16*)(ws + WS_R1); GT = (bf16*)(ws + WS_GATES); U = (bf16*)(ws + WS_R1); X = F.out + OUT_Y; } while (0)
    ArgsP Ap; unsigned char* ws;
    constexpr size_t WSET = (l & 1) ? WS_WSET1 : 0, WSET_NEXT = (l & 1) ? 0 : WS_WSET1;
        const int pb = NPH * l;
        if (IN(pb + 0)) { FRESH(); phase_pre(F, Ap, l); } SEAM(pb + 0);
        if (IN(pb + 1)) {
            FRESH(); ArgsP A = Ap;
            pg8::Gemm g{H, (const bf16*)(ws + WSET + WS_WIN), M, NIN, DM, DM, DM}; pg8::StaticOrder S; S.init(M, NIN, DM, F.G, F.bx, 4);
            pg8::EpiIn E{Zb, GT, A->in[I_BGATE] + (size_t)l * NGATE, F.lds + EPI_OFF};
            pg8::gemm_phase(F.lds, g, S, E);
            if (l + 1 < DEPTH) { const int nlast = ((M / 256) * (NIN / 256)) % F.G;
                if (nlast != 0 && F.bx >= nlast) pre_weights(F, Ap, l + 1, ws + WSET_NEXT, (F.bx - nlast) * 8 + F.wave, (F.G - nlast) * 8, 0, WCUT1); }
        } SEAM(pb + 1);
        if (IN(pb + 2)) { FRESH(); phase_post_in(F, Ap, l); } SEAM(pb + 2);
        if (IN(pb + 3)) {
            FRESH();
#pragma unroll 1
            for (int gi = 0; gi < 2; ++gi) {
                const bf16* Ain = (const bf16*)(ws + (gi == 0 ? WS_CQ : WS_CKV)); const bf16* Bt = (const bf16*)(ws + WSET + (gi == 0 ? WS_WQB : WS_WKVB));
                const int Mg = gi == 0 ? M : M2, Ng = gi == 0 ? 1536 : 2048, Kg = gi == 0 ? 512 : 256;
                pg8::Gemm g{Ain, Bt, Mg, Ng, Kg, Kg, Kg}; pg8::StaticOrder S; S.init(Mg, Ng, Kg, F.G, gi == 0 ? F.bx : (F.bx + F.G / 2) % F.G);
                pg8::EpiPlain E{(bf16*)(ws + (gi == 0 ? WS_R2 : WS_R1)), Ng, F.lds + EPI_OFF}; pg8::gemm_phase(F.lds, g, S, E);
            }
        } SEAM(pb + 3);
        if (IN(pb + 4)) { FRESH(); phase_post_b(F, Ap, l); } SEAM(pb + 4);
        if (IN(pb + 5)) { FRESH(); phase_attn(F, Ap, l); } SEAM(pb + 5);
        if (IN(pb + 6)) { FRESH(); phase_post_a(F, Ap, l); } SEAM(pb + 6);
        if (IN(pb + 7)) {
            FRESH();
            pg8::Gemm g{(const bf16*)(ws + WS_OALL), (const bf16*)(ws + WSET + WS_WBR), M, DM, DM, DM, DM}; pg8::StaticOrder S; S.init(M, DM, DM, F.G, F.bx, 4);
            pg8::EpiMerge E{GT, H, F.lds + EPI_OFF}; pg8::gemm_phase(F.lds, g, S, E);
            if (l + 1 < DEPTH) { const int nlast = ((M / 256) * (DM / 256)) % F.G;
                if (nlast != 0 && F.bx >= nlast) pre_caches(F, Ap, l + 1, (F.bx - nlast) * 8 + F.wave, (F.G - nlast) * 8); else if (nlast == 0) pre_caches(F, Ap, l + 1, F.gw, F.NGW); }
        } SEAM(pb + 7);
        if (IN(pb + 8)) {
            FRESH();
            { pg8::Gemm g{H, (const bf16*)(ws + WSET + WS_WO), M, DM, DM, DM, DM}; pg8::CombinedOrder S; S.init(MP, DM, DM, NS_O, F.G, F.bx);
              pg8::EpiResidSplit E{X, (float*)(ws + WS_SLAB_O), MP / 256, DM / NS_O, F.lds + EPI_OFF}; pg8::gemm_phase(F.lds, g, S, E); }
        } SEAM(pb + 8);
        if (IN(pb + 9)) { FRESH(); rmsnorm_rows(F, Ap, Ap->in[I_MNORM] + (size_t)l * DM, H, false, (const float*)(ws + WS_SLAB_O), NS_O); } SEAM(pb + 9);
        if (IN(pb + 10)) {
            FRESH();
            pg8::Gemm g{H, (const bf16*)(ws + WSET + WS_WUP), M, DFF, DM, DM, DM}; pg8::StaticOrder S; S.init(M, DFF, DM, F.G, F.bx, 4);
            pg8::EpiUp E{U, F.lds + EPI_OFF}; pg8::gemm_phase(F.lds, g, S, E);
            if (l + 1 < DEPTH) { const int nlast = ((M / 256) * (DFF / 256)) % F.G;
                if (nlast != 0 && F.bx >= nlast) pre_weights(F, Ap, l + 1, ws + WSET_NEXT, (F.bx - nlast) * 8 + F.wave, (F.G - nlast) * 8, WCUT1, WCUT2); }
        } SEAM(pb + 10);
        if (IN(pb + 11)) {
            FRESH();
            { pg8::Gemm g{U, (const bf16*)(ws + WSET + WS_WDN), M, DM, DFF, DFF, DFF}; pg8::CombinedOrder S; S.init(MP, DM, DFF, NS_DN, F.G, F.bx);
              pg8::EpiResidSplit E{X, (float*)(ws + WS_SLAB_DN), MP / 256, DFF / NS_DN, F.lds + EPI_OFF}; pg8::gemm_phase(F.lds, g, S, E); }
            if (l + 1 < DEPTH) { const int n1 = ((M / 256) * (NIN / 256)) % F.G, n2 = ((M / 256) * (DFF / 256)) % F.G;
                pre_weights(F, Ap, l + 1, ws + WSET_NEXT, F.gw, F.NGW, n1 != 0 ? (n2 != 0 ? WCUT2 : WCUT1) : 0, 1 << 30); }
        } SEAM(pb + 11);
    #undef IN
#undef SEAM
#undef FRESH
}

__global__ void __launch_bounds__(512, 2) fwd(Args args) {
    extern __shared__ __attribute__((aligned(16))) unsigned char lds_raw[];
    Frame F;
    F.lds = (LAS unsigned char*)lds_raw;
    F.tid = threadIdx.x; F.lane = F.tid & 63; F.wave = __builtin_amdgcn_readfirstlane(F.tid >> 6);
    F.G = gridDim.x; { const int bx = blockIdx.x; F.vcu = (F.G % 8 == 0) ? (bx % 8) * (F.G / 8) + bx / 8 : bx; }
    F.gw = F.vcu * 8 + F.wave; F.NGW = F.G * 8;
    F.out = args.out; F.ws = args.ws;
    unsigned char* ws = args.ws;
    volatile LAS unsigned* MISC = (volatile LAS unsigned*)(F.lds + MISC_OFF);
    for (int u = F.tid; u < (LDS_BYTES - LDSCTL_OFF) / 4; u += 512) ((LAS unsigned*)(F.lds + LDSCTL_OFF))[u] = 0u;
    __syncthreads();
    XcdBarrier bar; bar.bar = (unsigned*)(ws + WS_CTL) + CW_BAR; bar.x = 0; bar.st = nullptr;
    if (args.use_bar) bar = xcd_barrier_post((unsigned*)(ws + WS_CTL) + CW_BAR, MISC + 8);
    const int lo = args.ph_lo, hi = args.ph_hi;
    layer_body<0>(F, (LAS unsigned char*)lds_raw, MISC, lo, hi);
    layer_body<1>(F, (LAS unsigned char*)lds_raw, MISC, lo, hi);
    layer_body<2>(F, (LAS unsigned char*)lds_raw, MISC, lo, hi);
    layer_body<3>(F, (LAS unsigned char*)lds_raw, MISC, lo, hi);
    if (lo <= NPH * DEPTH && NPH * DEPTH < hi) {
        ArgsP Ap = fresh_args(); F.tid = fresh_tid(); F.lane = F.tid & 63; F.ws = Ap->ws; F.out = Ap->out;
        final_combine(F, (const float*)(F.ws + WS_SLAB_DN), NS_DN);
    }
}

extern "C" void kernel_launch(void* const* d_in, const int* in_sizes, int n_in, void* d_out, int out_size, void* d_ws, size_t ws_size, hipStream_t stream) {
    static int grid = 0;
    if (grid == 0) {
        if (n_in != 31 || (size_t)out_size != OUT_END || ws_size < WS_END) { fprintf(stderr, "kernel_launch: shape mismatch (n_in %d, out %d, ws %zu)\n", n_in, out_size, ws_size); grid = -1; return; }
        int dev = 0, cus = 0;
        if (hipGetDevice(&dev) != hipSuccess || hipDeviceGetAttribute(&cus, hipDeviceAttributeMultiprocessorCount, dev) != hipSuccess) { grid = -1; return; }
        if (hipFuncSetAttribute((const void*)fwd, hipFuncAttributeMaxDynamicSharedMemorySize, LDS_BYTES) != hipSuccess) { fprintf(stderr, "kernel_launch: hipFuncSetAttribute failed\n"); grid = -1; return; }
        int per_cu = 0;
        if (hipOccupancyMaxActiveBlocksPerMultiprocessor(&per_cu, (const void*)fwd, 512, LDS_BYTES) != hipSuccess || per_cu < 1) fprintf(stderr, "kernel_launch: occupancy query reports %d\n", per_cu);
        (void)hipGetLastError();
        grid = cus;
    }
    if (grid < 0) return;
    (void)hipMemsetAsync((char*)d_ws + WS_CTL, 0, CTL_ZERO_BYTES, stream);
    Args a{};
    for (int i = 0; i < 31; ++i) a.in[i] = (const float*)d_in[i];
    a.out = (float*)d_out; a.ws = (unsigned char*)d_ws; a.pad = 0;
#if MK_SPLIT
    for (int p = 0; p < NPHASES; ++p) { a.ph_lo = p; a.ph_hi = p + 1; a.use_bar = 0; hipLaunchKernelGGL(fwd, dim3(grid), dim3(512), LDS_BYTES, stream, a); }
#else
    a.ph_lo = 0; a.ph_hi = NPHASES; a.use_bar = 1; hipLaunchKernelGGL(fwd, dim3(grid), dim3(512), LDS_BYTES, stream, a);
#endif
}
```

```cpp
#include <hip/hip_runtime.h>
#include <cstdio>
#include <cstdint>
#include <cmath>

#ifndef MK_SPLIT
#define MK_SPLIT 0
#endif

#define GAS __attribute__((address_space(1)))
#define LAS __attribute__((address_space(3)))
typedef unsigned short bf16;
typedef short bf16x8 __attribute__((ext_vector_type(8)));
typedef short s16x4 __attribute__((ext_vector_type(4)));
typedef float f32x4 __attribute__((ext_vector_type(4)));
typedef float f32x16 __attribute__((ext_vector_type(16)));
typedef unsigned u32x4 __attribute__((ext_vector_type(4)));
typedef unsigned u32x2 __attribute__((ext_vector_type(2)));

constexpr int DM = 2048, SEQ = 16384, NBATCH = 2, DEPTH = 4, DECB = 16, DECS = 16, PAST = 2048;
constexpr int MP = NBATCH * SEQ, MS = DECB * DECS, M = MP + MS;
constexpr int SROWS = 2176, CROWS = 640, CPAST = 512;
constexpr int M2 = MP + DECB * SROWS;
constexpr int MC = MP + DECB * CROWS;
constexpr int NIN = 10240, NZ = 4096, NGATE = 6144, DFF = 8192, INCOLS = 10048;
constexpr float EPS = 1e-6f;
static_assert(M % 256 == 0 && M2 % 256 == 0, "row counts are whole 256-row panels");

constexpr size_t OUT_Y = 0;
constexpr size_t OUT_AK_P = OUT_Y + (size_t)M * DM;
constexpr size_t OUT_AV_P = OUT_AK_P + (size_t)DEPTH * MP * 512;
constexpr size_t OUT_BC_P = OUT_AV_P + (size_t)DEPTH * MP * 512;
constexpr size_t OUT_BP_P = OUT_BC_P + (size_t)DEPTH * MP * 256;
constexpr size_t OUT_CK_P = OUT_BP_P + (size_t)DEPTH * MP * 64;
constexpr size_t OUT_CV_P = OUT_CK_P + (size_t)DEPTH * NBATCH * 512 * 512;
constexpr size_t OUT_AK_S = OUT_CV_P + (size_t)DEPTH * NBATCH * 512 * 512;
constexpr size_t OUT_AV_S = OUT_AK_S + (size_t)DEPTH * MS * 512;
constexpr size_t OUT_BC_S = OUT_AV_S + (size_t)DEPTH * MS * 512;
constexpr size_t OUT_BP_S = OUT_BC_S + (size_t)DEPTH * MS * 256;
constexpr size_t OUT_CK_S = OUT_BP_S + (size_t)DEPTH * MS * 64;
constexpr size_t OUT_CV_S = OUT_CK_S + (size_t)DEPTH * MS * 512;
constexpr size_t OUT_END = OUT_CV_S + (size_t)DEPTH * MS * 512;
static_assert(OUT_END == 250413056ull, "output size");

constexpr size_t MiB = 1u << 20;
constexpr size_t WS_CTL = 0, CTL_ZERO_BYTES = 1 * MiB;
constexpr size_t WS_WIN = 1 * MiB;
constexpr size_t WS_WQB = 41 * MiB;
constexpr size_t WS_WKVB = 43 * MiB;
constexpr size_t WS_WBR = 44 * MiB;
constexpr size_t WS_WO = 52 * MiB;
constexpr size_t WS_WUP = 60 * MiB;
constexpr size_t WS_WDN = 92 * MiB;
constexpr size_t WS_R3 = 124 * MiB;
constexpr size_t WS_R1 = 322 * MiB;
constexpr size_t WS_GATES = 586 * MiB;
constexpr size_t WS_QA = 973 * MiB;
constexpr size_t WS_KA = 1006 * MiB;
constexpr size_t WS_VA = 1072 * MiB;
constexpr size_t WS_CQ = 1138 * MiB;
constexpr size_t WS_CKV = 1171 * MiB;
constexpr size_t WS_KPE = 1204 * MiB;
constexpr size_t WS_QC = 1221 * MiB;
constexpr size_t WS_KC = 1254 * MiB;
constexpr size_t WS_VC = 1296 * MiB;
constexpr size_t WS_R2 = 1338 * MiB;
constexpr size_t WS_OALL = 1596 * MiB;
constexpr size_t WS_QB = 1727 * MiB;
constexpr size_t WS_END = 1824 * MiB;
static_assert(WS_WIN + (size_t)NIN * DM * 2 <= WS_WQB && WS_WDN + (size_t)DM * DFF * 2 <= WS_R3, "weights");
static_assert(WS_R3 + (size_t)M2 * 1536 * 2 <= WS_R1 && WS_R1 + (size_t)M2 * 2048 * 2 <= WS_GATES && WS_GATES + (size_t)M * NGATE * 2 <= WS_QA, "R3/R1/gates");
static_assert(WS_R1 + (size_t)M * DFF * 2 <= WS_QA, "u overlay");
static_assert(WS_QA + (size_t)M * 512 * 2 <= WS_KA && WS_KA + (size_t)M2 * 512 * 2 <= WS_VA && WS_VA + (size_t)M2 * 512 * 2 <= WS_CQ, "A");
static_assert(WS_CQ + (size_t)M * 512 * 2 <= WS_CKV && WS_CKV + (size_t)M2 * 256 * 2 <= WS_KPE && WS_KPE + (size_t)M2 * 64 * 4 <= WS_QC, "B");
static_assert(WS_QC + (size_t)M * 512 * 2 <= WS_KC && WS_KC + (size_t)MC * 512 * 2 <= WS_VC && WS_VC + (size_t)MC * 512 * 2 <= WS_R2, "C");
static_assert(WS_R2 + (size_t)M * 2048 * 4 <= WS_OALL && WS_OALL + (size_t)M * 2048 * 2 <= WS_QB && WS_QB + (size_t)M * 1536 * 2 <= WS_END, "tail");

constexpr int CW_BAR = 4096;

constexpr int RING_BYTES = 131072;
constexpr int LDSCTL_OFF = RING_BYTES, MISC_OFF = LDSCTL_OFF + 320;
constexpr int LDS_BYTES = 155648;
constexpr int EPI_OFF = RING_BYTES + 8192;
static_assert(EPI_OFF + 8 * 2048 <= LDS_BYTES, "epilogue staging");

#define LDS_WAIT() asm volatile("s_waitcnt lgkmcnt(0)" ::: "memory")
#define VM_WAIT() asm volatile("s_waitcnt vmcnt(0)" ::: "memory")
#define SBAR() __builtin_amdgcn_sched_barrier(0)
__device__ __forceinline__ int fresh_tid() { int t = threadIdx.x; asm volatile("" : "+v"(t)); return t; }
__device__ __forceinline__ unsigned cvtpk(float lo, float hi) { unsigned r; asm volatile("v_cvt_pk_bf16_f32 %0, %1, %2" : "=v"(r) : "v"(lo), "v"(hi)); return r; }
__device__ __forceinline__ float bf_lo(unsigned u) { return __uint_as_float(u << 16); }
__device__ __forceinline__ float bf_hi(unsigned u) { return __uint_as_float(u & 0xffff0000u); }
__device__ __forceinline__ void unpack8(u32x4 w, float (&v)[8]) { v[0] = bf_lo(w.x); v[1] = bf_hi(w.x); v[2] = bf_lo(w.y); v[3] = bf_hi(w.y); v[4] = bf_lo(w.z); v[5] = bf_hi(w.z); v[6] = bf_lo(w.w); v[7] = bf_hi(w.w); }
__device__ __forceinline__ u32x4 pack8(const float (&v)[8]) { u32x4 w; w.x = cvtpk(v[0], v[1]); w.y = cvtpk(v[2], v[3]); w.z = cvtpk(v[4], v[5]); w.w = cvtpk(v[6], v[7]); return w; }
__device__ __forceinline__ void ld8bf(const bf16* p, float (&v)[8]) { unpack8(*(const u32x4*)p, v); }
__device__ __forceinline__ void ld8f(const float* p, float (&v)[8]) { const f32x4 a = *(const f32x4*)p, b = *(const f32x4*)(p + 4); v[0] = a.x; v[1] = a.y; v[2] = a.z; v[3] = a.w; v[4] = b.x; v[5] = b.y; v[6] = b.z; v[7] = b.w; }
__device__ __forceinline__ void st8f(float* p, const float (&v)[8]) { *(f32x4*)p = (f32x4){v[0], v[1], v[2], v[3]}; *(f32x4*)(p + 4) = (f32x4){v[4], v[5], v[6], v[7]}; }
__device__ __forceinline__ void st8f_nt(float* p, const float (&v)[8]) { __builtin_nontemporal_store((f32x4){v[0], v[1], v[2], v[3]}, (f32x4*)p); __builtin_nontemporal_store((f32x4){v[4], v[5], v[6], v[7]}, (f32x4*)(p + 4)); }
__device__ __forceinline__ float wave_sum(float v) {
#pragma unroll
    for (int o = 1; o < 64; o <<= 1) v += __shfl_xor(v, o);
    return v;
}
__device__ __forceinline__ float sumsq8(const float (&v)[8]) { float s = 0.f;
#pragma unroll
    for (int e = 0; e < 8; ++e) s += v[e] * v[e];
    return s; }

#define XB_TMO      128
#define XB_XCNT(j)  (256  + 64 * (j))
#define XB_XSUB(j)  (1280 + 64 * (j))
#define XB_XGEN(j)  (2304 + 64 * (j))
#define XB_TOP      3328
#define XB_TOPGEN   3392
#define XCD_BAR_WORDS 3456
#define XB_SPIN_CAP (1u << 18)
__device__ __forceinline__ unsigned xb_ld(unsigned* p)              { return __hip_atomic_load(p, __ATOMIC_RELAXED, __HIP_MEMORY_SCOPE_AGENT); }
__device__ __forceinline__ unsigned xb_add(unsigned* p, unsigned v) { return __hip_atomic_fetch_add(p, v, __ATOMIC_RELAXED, __HIP_MEMORY_SCOPE_AGENT); }
__device__ __forceinline__ unsigned xb_xcc_id() { return (unsigned)__builtin_amdgcn_s_getreg((3 << 11) | 20) & 0xFu; }
#define XB_SPIN(cond, bar) do { unsigned _sp = 0; while (cond) { __builtin_amdgcn_s_sleep(1); \
    if ((++_sp & 255u) == 0u) { if (xb_ld(&(bar)[XB_TMO])) break; if (_sp > XB_SPIN_CAP) { atomicAdd(&(bar)[XB_TMO], 1u); break; } } } } while (0)
struct XcdBarrier { unsigned* bar; unsigned x; volatile LAS unsigned* st; };
__device__ __forceinline__ XcdBarrier xcd_barrier_post(unsigned* bar, volatile LAS unsigned* st) {
    XcdBarrier b; b.bar = bar; b.x = xb_xcc_id(); b.st = st;
    if (threadIdx.x == 0) (void)xb_add(&bar[XB_XCNT(b.x)], 1u);
    return b;
}
__device__ __forceinline__ void xcd_barrier_complete(unsigned* bar, unsigned x, unsigned& nloc, unsigned& nx) {
    const unsigned G = gridDim.x * gridDim.y * gridDim.z;
    unsigned sum, cnt, mine, sp = 0u;
    for (;;) {
        sum = 0u; cnt = 0u; mine = 0u;
#pragma unroll
        for (unsigned j = 0; j < 16; ++j) { const unsigned c = xb_ld(&bar[XB_XCNT(j)]); sum += c; cnt += (c > 0u) ? 1u : 0u; mine = (j == x) ? c : mine; }
        if (sum == G) break;
        __builtin_amdgcn_s_sleep(1);
        if ((++sp & 255u) == 0u) { if (xb_ld(&bar[XB_TMO])) break; if (sp > XB_SPIN_CAP) { atomicAdd(&bar[XB_TMO], 1u); break; } }
    }
    nloc = mine > 0u ? mine : 1u; nx = cnt > 0u ? cnt : 1u;
}
__device__ __forceinline__ void xcd_barrier(const XcdBarrier& b) {
    asm volatile("s_waitcnt vmcnt(0)" ::: "memory");
    __syncthreads();
    if (threadIdx.x == 0) {
        unsigned* bar = b.bar;
        __builtin_amdgcn_s_waitcnt(0);
        unsigned nloc = b.st[0], nx = b.st[1];
        if (nloc == 0u) { xcd_barrier_complete(bar, b.x, nloc, nx); b.st[0] = nloc; b.st[1] = nx; }
        const unsigned old = xb_add(&bar[XB_XSUB(b.x)], 1u);
        const unsigned gen = old / nloc;
        if (old + 1u == (gen + 1u) * nloc) {
            __builtin_amdgcn_fence(__ATOMIC_RELEASE, "agent");
            asm volatile("s_waitcnt vmcnt(0)" ::: "memory");
            const unsigned og = xb_add(&bar[XB_TOP], 1u);
            const unsigned tg = og / nx;
            if (og + 1u == (tg + 1u) * nx) xb_add(&bar[XB_TOPGEN], 1u);
            else XB_SPIN(xb_ld(&bar[XB_TOPGEN]) == tg, bar);
            __builtin_amdgcn_fence(__ATOMIC_ACQUIRE, "agent");
            xb_add(&bar[XB_XGEN(b.x)], 1u);
            asm volatile("s_waitcnt vmcnt(0)" ::: "memory");
        } else {
            XB_SPIN(xb_ld(&bar[XB_XGEN(b.x)]) == gen, bar);
            __builtin_amdgcn_fence(__ATOMIC_ACQUIRE, "agent");
            asm volatile("s_waitcnt vmcnt(0)" ::: "memory");
        }
    }
    __syncthreads();
}

namespace pg8 {
constexpr int BM = 256, BK = 64, HALF = 128, HTB = HALF * BK * 2, NXCD = 8, WGM = 8;
__host__ __device__ __forceinline__ int lds_byte(int r, int c) { return r * 128 + ((((c >> 3) ^ ((r >> 1) & 7))) << 4) + (c & 7) * 2; }
__host__ __device__ __forceinline__ void stage_rc(int b, int& R, int& C) { R = b >> 7; const int slot = (b & 127) >> 4; C = (slot ^ ((R >> 1) & 7)) * 8; }
__host__ __device__ __forceinline__ int perm32(int rho) { const int n = rho >> 4, i = rho & 15; return 8 * (i >> 2) + 4 * n + (i & 3); }
struct Unit { int pm, pn, koff, nt; };
struct Gemm { const bf16* A; const bf16* Bt; int M, N, K, lda, ldb; };
struct StaticOrder {
    int nM, nN, nwg, G, c, nt, wgm;
    __device__ void init(int M_, int N_, int K_, int G_, int c_, int wgm_ = WGM) { nM = M_ / BM; nN = N_ / BM; nwg = nM * nN; G = G_; c = c_; nt = K_ / BK; wgm = wgm_; }
    __device__ bool next(int i, Unit& u) const {
        const long L = (long)i * G + c; if (L >= nwg) return false;
        int wgid = (int)L; { const int q = nwg / NXCD, r = nwg % NXCD, xcd = wgid % NXCD, off = wgid / NXCD; wgid = (xcd < r ? xcd * (q + 1) : r * (q + 1) + (xcd - r) * q) + off; }
        const int nig = wgm * nN, gid = wgid / nig, fm = gid * wgm, gsz = (nM - fm) < wgm ? (nM - fm) : wgm;
        u.pm = fm + ((wgid % nig) % gsz); u.pn = (wgid % nig) / gsz; u.koff = 0; u.nt = nt; return true;
    }
};
struct CombinedOrder {
    StaticOrder S0; int pmS, nN, np, KS;
    __device__ void init(int Mmain, int N_, int K_, int NS_, int G_, int c_) { S0.init(Mmain, N_, K_, G_, c_, 4); pmS = Mmain / BM; nN = N_ / BM; np = nN * NS_; KS = K_ / NS_; }
    __device__ bool next(int i, Unit& u) const { const long L = (long)i * S0.G + S0.c; if (L < S0.nwg) return S0.next(i, u);
        const int p = (int)(L - S0.nwg); if (p >= np) return false; u.pm = pmS; u.pn = p % nN; u.koff = (p / nN) * KS; u.nt = KS / BK; return true; }
};
template <class Epi, class Order>
__device__ __forceinline__ void gemm_phase(LAS unsigned char* lds, const Gemm g, const Order& S, const Epi& E) {
    const int tid = fresh_tid(), wid = __builtin_amdgcn_readfirstlane(tid >> 6), lane = tid & 63, wr = wid >> 2, wc = wid & 3, fr = lane & 15, fq = lane >> 4;
    unsigned voffA[2], voffB[2];
#pragma unroll
    for (int i = 0; i < 2; ++i) { int R, C; stage_rc(tid * 16 + i * 8192, R, C); const int Rb = 64 * (R >> 5) + perm32(R & 31);
        voffA[i] = (unsigned)(R * g.lda + C) * 2u; voffB[i] = (unsigned)(Rb * g.ldb + C) * 2u; }
    const size_t kstep = (size_t)(BK * 2);
    const size_t hstepA = (size_t)HALF * g.lda * 2, hstepB = (size_t)32 * g.ldb * 2;
    const size_t tstepA = 2 * hstepA, tstepB = (size_t)BM * g.ldb * 2;
    const unsigned ldsw = (unsigned)wid * 1024u;
    const int aoff = lds_byte(wr * 64 + fr, fq * 8), boff = lds_byte(wc * 32 + fr, fq * 8), aoff1 = aoff ^ 64, boff1 = boff ^ 64;
#define PG8_SA(b, h) (((b) * 2 + (h)) * HTB)
#define PG8_SB(b, h) ((4 + (b) * 2 + (h)) * HTB)
#define PG8_STAGE(bufoff, gbase, voff) do { _Pragma("unroll") for (int _i = 0; _i < 2; ++_i) \
        __builtin_amdgcn_global_load_lds((const unsigned*)((const char*)(gbase) + (voff)[_i]), (LAS unsigned*)(lds + (bufoff) + ldsw + _i * 8192), 16, 0, 0); } while (0)
#define PG8_LDA(dst, b, h) do { _Pragma("unroll") for (int m = 0; m < 4; ++m) _Pragma("unroll") for (int k = 0; k < 2; ++k) dst[m][k] = *(const LAS bf16x8*)(lds + PG8_SA(b, h) + (k ? aoff1 : aoff) + m * 2048); } while (0)
#define PG8_LDB(dst, b, h) do { _Pragma("unroll") for (int n = 0; n < 2; ++n) _Pragma("unroll") for (int k = 0; k < 2; ++k) dst[n][k] = *(const LAS bf16x8*)(lds + PG8_SB(b, h) + (k ? boff1 : boff) + n * 2048); } while (0)
#define PG8_MMA(ai, bj, At, Bt) do { __builtin_amdgcn_s_setprio(1); _Pragma("unroll") for (int m = 0; m < 4; ++m) _Pragma("unroll") for (int n = 0; n < 2; ++n) _Pragma("unroll") for (int k = 0; k < 2; ++k) \
        acc[ai][bj][m][n] = __builtin_amdgcn_mfma_f32_16x16x32_bf16(Bt[n][k], At[m][k], acc[ai][bj][m][n], 0, 0, 0); __builtin_amdgcn_s_setprio(0); } while (0)
#define PG8_WAIT_V(n) asm volatile("s_waitcnt vmcnt(" #n ")" ::: "memory")
#define PG8_WAIT_L(n) asm volatile("s_waitcnt lgkmcnt(" #n ")" ::: "memory")
#define PG8_BAR __builtin_amdgcn_s_barrier()
#define PG8_SCHED __builtin_amdgcn_sched_barrier(0)
    Unit cur, nxt; int ui = 0;
    if (!S.next(0, cur)) return;
    f32x4 acc[2][2][4][2];
#pragma unroll
    for (int a = 0; a < 2; ++a)
#pragma unroll
        for (int b = 0; b < 2; ++b)
#pragma unroll
            for (int m = 0; m < 4; ++m)
#pragma unroll
                for (int n = 0; n < 2; ++n) acc[a][b][m][n] = (f32x4){0.f, 0.f, 0.f, 0.f};
    bf16x8 At[4][2], B0[2][2], B1[2][2];
    const char* cA = (const char*)g.A + (size_t)cur.pm * tstepA + (size_t)cur.koff * 2; const char* cB = (const char*)g.Bt + (size_t)cur.pn * tstepB + (size_t)cur.koff * 2;
    PG8_STAGE(PG8_SB(0, 0), cB, voffB); PG8_STAGE(PG8_SB(0, 1), cB + hstepB, voffB); PG8_STAGE(PG8_SA(0, 0), cA, voffA); PG8_STAGE(PG8_SA(0, 1), cA + hstepA, voffA);
    if (wr == 1) PG8_BAR;
    PG8_WAIT_V(2); PG8_BAR;
    PG8_STAGE(PG8_SB(1, 0), cB + kstep, voffB); PG8_STAGE(PG8_SA(1, 0), cA + kstep, voffA); PG8_STAGE(PG8_SB(1, 1), cB + hstepB + kstep, voffB);
    PG8_WAIT_V(6); PG8_BAR;
    for (;;) {
        const bool has_next = S.next(ui + 1, nxt);
        const char* nA = has_next ? (const char*)g.A + (size_t)nxt.pm * tstepA + (size_t)nxt.koff * 2 : cA; const char* nB = has_next ? (const char*)g.Bt + (size_t)nxt.pn * tstepB + (size_t)nxt.koff * 2 : cB;
        const int nt = cur.nt;
        for (int t = 0; t < nt; t += 2) {
            if constexpr (Epi::HOOK) { if (t == 8 || t == 24) E.mid(acc, cur, wr, wc, fr, fq, t); }
            const bool last = (t == nt - 2);
            const char* a1 = cA + (size_t)(t + 1) * kstep;
            const char* a2 = last ? nA : cA + (size_t)(t + 2) * kstep; const char* b2 = last ? nB : cB + (size_t)(t + 2) * kstep;
            const char* a3 = a2 + kstep; const char* b3 = b2 + kstep;
            PG8_LDB(B0, 0, 0); PG8_LDB(B1, 0, 1); PG8_SCHED; PG8_LDA(At, 0, 0); PG8_STAGE(PG8_SA(1, 1), a1 + hstepA, voffA);
            PG8_WAIT_V(8); PG8_WAIT_L(0); PG8_BAR; PG8_MMA(0, 0, At, B0); PG8_MMA(0, 1, At, B1); PG8_BAR; PG8_SCHED;
            PG8_LDA(At, 0, 1); PG8_STAGE(PG8_SB(0, 0), b2, voffB); PG8_STAGE(PG8_SB(0, 1), b2 + hstepB, voffB); PG8_STAGE(PG8_SA(0, 0), a2, voffA);
            PG8_WAIT_V(8); PG8_WAIT_L(0); PG8_BAR; PG8_MMA(1, 0, At, B0); PG8_MMA(1, 1, At, B1); PG8_BAR; PG8_SCHED;
            PG8_LDB(B0, 1, 0); PG8_LDB(B1, 1, 1); PG8_SCHED; PG8_LDA(At, 1, 0); PG8_STAGE(PG8_SA(0, 1), a2 + hstepA, voffA);
            PG8_WAIT_V(8); PG8_WAIT_L(0); PG8_BAR; PG8_MMA(0, 0, At, B0); PG8_MMA(0, 1, At, B1); PG8_BAR; PG8_SCHED;
            PG8_LDA(At, 1, 1); PG8_STAGE(PG8_SB(1, 0), b3, voffB); PG8_STAGE(PG8_SB(1, 1), b3 + hstepB, voffB); PG8_STAGE(PG8_SA(1, 0), a3, voffA);
            PG8_WAIT_V(8); PG8_WAIT_L(0); PG8_BAR; PG8_MMA(1, 0, At, B0); PG8_MMA(1, 1, At, B1); PG8_BAR; PG8_SCHED;
        }
        if (wr == 0) PG8_BAR;
        E(acc, cur, wr, wc, fr, fq);
        if (!has_next) break;
#pragma unroll
        for (int a = 0; a < 2; ++a)
#pragma unroll
            for (int b = 0; b < 2; ++b)
#pragma unroll
                for (int m = 0; m < 4; ++m)
#pragma unroll
                    for (int n = 0; n < 2; ++n) acc[a][b][m][n] = (f32x4){0.f, 0.f, 0.f, 0.f};
        cur = nxt; cA = nA; cB = nB; ++ui;
        if (wr == 1) PG8_BAR;
    }
    PG8_WAIT_V(0);
    PG8_BAR;
#undef PG8_SA
#undef PG8_SB
#undef PG8_STAGE
#undef PG8_LDA
#undef PG8_LDB
#undef PG8_MMA
#undef PG8_WAIT_V
#undef PG8_WAIT_L
#undef PG8_BAR
#undef PG8_SCHED
}

#define EPI_LOOP_BEGIN const int row0 = u.pm * BM + wr * 64 + fr, col0 = u.pn * BM + wc * 64 + 8 * fq; \
    _Pragma("unroll") for (int ai = 0; ai < 2; ++ai) _Pragma("unroll") for (int m = 0; m < 4; ++m) { const size_t row = (size_t)(row0 + ai * HALF + m * 16); \
    _Pragma("unroll") for (int bj = 0; bj < 2; ++bj) { const int col = col0 + bj * 32; f32x4 v0 = acc[ai][bj][m][0], v1 = acc[ai][bj][m][1];
#define EPI_LOOP_END } }
__device__ __forceinline__ u32x4 pk8(f32x4 v0, f32x4 v1) { u32x4 w; w.x = cvtpk(v0[0], v0[1]); w.y = cvtpk(v0[2], v0[3]); w.z = cvtpk(v1[0], v1[1]); w.w = cvtpk(v1[2], v1[3]); return w; }
__device__ __forceinline__ float sigm(float v) { return __builtin_amdgcn_rcpf(1.f + __builtin_amdgcn_exp2f(-1.4426950408889634f * v)); }

template <bool NT> __device__ __forceinline__ void st_lines(LAS unsigned char* scr, u32x4 w0, u32x4 w1, bf16* tile, size_t ldc, int fr, int fq) {
    const int lane = fq * 16 + fr, rr = lane >> 3, c = lane & 7;
    *(LAS u32x4*)(scr + fr * 128 + ((fq ^ (fr & 7)) << 4)) = w0;
    *(LAS u32x4*)(scr + fr * 128 + (((4 + fq) ^ (fr & 7)) << 4)) = w1;
    const u32x4 a = *(const LAS u32x4*)(scr + rr * 128 + ((c ^ rr) << 4)), b = *(const LAS u32x4*)(scr + (8 + rr) * 128 + ((c ^ rr) << 4));
    bf16* d = tile + (size_t)rr * ldc + c * 8;
    if constexpr (NT) { __builtin_nontemporal_store(a, (u32x4*)d); __builtin_nontemporal_store(b, (u32x4*)(d + 8 * ldc)); }
    else { *(u32x4*)d = a; *(u32x4*)(d + 8 * ldc) = b; }
}
__device__ __forceinline__ void sl_xpose(LAS unsigned char* scr, u32x4 w0, u32x4 w1, int fr, int fq, u32x4& a, u32x4& b) {
    const int lane = fq * 16 + fr, rr = lane >> 3, c = lane & 7;
    *(LAS u32x4*)(scr + fr * 128 + ((fq ^ (fr & 7)) << 4)) = w0;
    *(LAS u32x4*)(scr + fr * 128 + (((4 + fq) ^ (fr & 7)) << 4)) = w1;
    a = *(const LAS u32x4*)(scr + rr * 128 + ((c ^ rr) << 4)); b = *(const LAS u32x4*)(scr + (8 + rr) * 128 + ((c ^ rr) << 4));
}
template <bool NT> __device__ __forceinline__ void sl_store(u32x4 a, u32x4 b, bf16* tile, size_t ldc, int fr, int fq) {
    const int lane = fq * 16 + fr, rr = lane >> 3, c = lane & 7;
    bf16* d = tile + (size_t)rr * ldc + c * 8;
    if constexpr (NT) { __builtin_nontemporal_store(a, (u32x4*)d); __builtin_nontemporal_store(b, (u32x4*)(d + 8 * ldc)); }
    else { *(u32x4*)d = a; *(u32x4*)(d + 8 * ldc) = b; }
}
struct EpiIn {
    static constexpr bool HOOK = false;
    bf16* Z; bf16* G; const float* bg; LAS unsigned char* scr;
    __device__ __forceinline__ void operator()(const f32x4 (&acc)[2][2][4][2], const Unit& u, int wr, int wc, int fr, int fq) const {
        const bool isg = u.pn * BM >= NZ;
        const int colw = u.pn * BM + wc * 64 - (isg ? NZ : 0);
        bf16* base = (isg ? G : Z) + (size_t)(u.pm * BM + wr * 64) * (isg ? NGATE : NZ) + colw; const size_t ldc = isg ? NGATE : NZ;
        LAS unsigned char* sw = scr + (wr * 4 + wc) * 2048;
        f32x4 b00, b01, b10, b11;
        if (isg) { const float* bp = bg + colw + 8 * fq; b00 = *(const f32x4*)bp; b01 = *(const f32x4*)(bp + 4); b10 = *(const f32x4*)(bp + 32); b11 = *(const f32x4*)(bp + 36); }
#pragma unroll
        for (int ai = 0; ai < 2; ++ai) { u32x4 ra[4], rb[4];
#pragma unroll
            for (int m = 0; m < 4; ++m) {
                f32x4 v0 = acc[ai][0][m][0], v1 = acc[ai][0][m][1], v2 = acc[ai][1][m][0], v3 = acc[ai][1][m][1];
                if (isg) { v0 += b00; v1 += b01; v2 += b10; v3 += b11;
#pragma unroll
                    for (int e = 0; e < 4; ++e) { v0[e] = sigm(v0[e]); v1[e] = sigm(v1[e]); v2[e] = sigm(v2[e]); v3[e] = sigm(v3[e]); } }
                sl_xpose(sw, pk8(v0, v1), pk8(v2, v3), fr, fq, ra[m], rb[m]); }
#pragma unroll
            for (int m = 0; m < 4; ++m) sl_store<true>(ra[m], rb[m], base + (size_t)(ai * HALF + m * 16) * ldc, ldc, fr, fq); }
    }
};
struct EpiPlain {
    static constexpr bool HOOK = false;
    bf16* O; int ldc; LAS unsigned char* scr;
    __device__ __forceinline__ void operator()(const f32x4 (&acc)[2][2][4][2], const Unit& u, int wr, int wc, int fr, int fq) const {
        bf16* base = O + (size_t)(u.pm * BM + wr * 64) * ldc + u.pn * BM + wc * 64; LAS unsigned char* sw = scr + (wr * 4 + wc) * 2048;
#pragma unroll
        for (int ai = 0; ai < 2; ++ai) { u32x4 ra[4], rb[4];
#pragma unroll
            for (int m = 0; m < 4; ++m) sl_xpose(sw, pk8(acc[ai][0][m][0], acc[ai][0][m][1]), pk8(acc[ai][1][m][0], acc[ai][1][m][1]), fr, fq, ra[m], rb[m]);
#pragma unroll
            for (int m = 0; m < 4; ++m) sl_store<false>(ra[m], rb[m], base + (size_t)(ai * HALF + m * 16) * ldc, (size_t)ldc, fr, fq); }
    }
};
struct EpiMerge {
    static constexpr bool HOOK = true;
    const bf16* G; bf16* Ob; LAS unsigned char* scr;
    __device__ __forceinline__ void mid(f32x4 (&acc)[2][2][4][2], const Unit& u, int wr, int wc, int fr, int fq, int t) const {
        const __amdgpu_buffer_rsrc_t rs = __builtin_amdgcn_make_buffer_rsrc((void*)G, 0, (int)((size_t)M * NGATE * 2), 0x00020000);
        const int gx = (t == 8) ? 0 : DM;
        const int voff = ((u.pm * BM + wr * 64 + fr) * NGATE + u.pn * BM + wc * 64 + 8 * fq + gx) * 2;
#pragma unroll
        for (int ai = 0; ai < 2; ++ai) {
            u32x4 wa[4][2], wb[4][2];
#pragma unroll
            for (int m = 0; m < 4; ++m)
#pragma unroll
                for (int bj = 0; bj < 2; ++bj) { const int so = ((ai * HALF + m * 16) * NGATE + bj * 32) * 2;
                    wa[m][bj] = __builtin_amdgcn_raw_buffer_load_b128(rs, voff, so, 0); wb[m][bj] = __builtin_amdgcn_raw_buffer_load_b128(rs, voff, so + DM * 2, 0); }
#pragma unroll
            for (int m = 0; m < 4; ++m)
#pragma unroll
                for (int bj = 0; bj < 2; ++bj) {
                    float a[8], b[8]; unpack8(wa[m][bj], a); unpack8(wb[m][bj], b);
#pragma unroll
                    for (int e = 0; e < 8; ++e) a[e] = a[e] * __builtin_amdgcn_rcpf(fmaxf(b[e], 1e-30f));
                    f32x4& v0 = acc[ai][bj][m][0]; f32x4& v1 = acc[ai][bj][m][1];
                    v0[0] *= a[0]; v0[1] *= a[1]; v0[2] *= a[2]; v0[3] *= a[3]; v1[0] *= a[4]; v1[1] *= a[5]; v1[2] *= a[6]; v1[3] *= a[7]; }
            SBAR(); }
    }
    __device__ __forceinline__ void operator()(const f32x4 (&acc)[2][2][4][2], const Unit& u, int wr, int wc, int fr, int fq) const {
        bf16* base = Ob + (size_t)(u.pm * BM + wr * 64) * DM + u.pn * BM + wc * 64; LAS unsigned char* sw = scr + (wr * 4 + wc) * 2048;
        const bf16* gb = G + (size_t)(u.pm * BM + wr * 64 + fr) * NGATE + 2 * DM + u.pn * BM + wc * 64 + 8 * fq;
        u32x4 gq[2][4][2];
#pragma unroll
        for (int ai = 0; ai < 2; ++ai)
#pragma unroll
            for (int m = 0; m < 4; ++m) { const bf16* gp = gb + (size_t)(ai * HALF + m * 16) * NGATE; gq[ai][m][0] = *(const u32x4*)gp; gq[ai][m][1] = *(const u32x4*)(gp + 32); }
#pragma unroll
        for (int ai = 0; ai < 2; ++ai) { u32x4 ra[4], rb[4];
#pragma unroll
            for (int m = 0; m < 4; ++m) {
                float g0[8], g1[8]; unpack8(gq[ai][m][0], g0); unpack8(gq[ai][m][1], g1);
                f32x4 v0 = acc[ai][0][m][0], v1 = acc[ai][0][m][1], v2 = acc[ai][1][m][0], v3 = acc[ai][1][m][1];
                v0[0] *= g0[0]; v0[1] *= g0[1]; v0[2] *= g0[2]; v0[3] *= g0[3]; v1[0] *= g0[4]; v1[1] *= g0[5]; v1[2] *= g0[6]; v1[3] *= g0[7];
                v2[0] *= g1[0]; v2[1] *= g1[1]; v2[2] *= g1[2]; v2[3] *= g1[3]; v3[0] *= g1[4]; v3[1] *= g1[5]; v3[2] *= g1[6]; v3[3] *= g1[7];
                sl_xpose(sw, pk8(v0, v1), pk8(v2, v3), fr, fq, ra[m], rb[m]); }
#pragma unroll
            for (int m = 0; m < 4; ++m) sl_store<false>(ra[m], rb[m], base + (size_t)(ai * HALF + m * 16) * DM, (size_t)DM, fr, fq); }
    }
};
struct EpiResidSplit {
    static constexpr bool HOOK = false;
    float* X; float* P; int pmS, KS; LAS unsigned char* scr;
    __device__ __forceinline__ void operator()(const f32x4 (&acc)[2][2][4][2], const Unit& u, int wr, int wc, int fr, int fq) const {
        const bool piece = u.pm >= pmS;
        float* base = (piece ? P + (size_t)(u.koff / KS) * (MS * DM) - (size_t)u.pm * BM * DM : X) + (size_t)(u.pm * BM + wr * 64) * DM + u.pn * BM + wc * 64;
        LAS unsigned char* sw = scr + (wr * 4 + wc) * 2048;
        const int lane = fq * 16 + fr, rr = lane >> 3, c = lane & 7;
        float* drow = base + (size_t)rr * DM + c * 4;
#define RS_OFF(st) ((size_t)((((st) >> 3) & 1) * HALF + (((st) >> 1) & 3) * 16) * DM + ((st) & 1) * 32)
        f32x4 xa[2][4], xb[2][4];
        if (!piece) {
#pragma unroll
            for (int q = 0; q < 4; ++q) { const float* d = drow + RS_OFF(q); xa[0][q] = *(const f32x4*)d; xb[0][q] = *(const f32x4*)(d + 8 * DM); } }
#pragma unroll
        for (int bt = 0; bt < 4; ++bt) {
            if (!piece && bt < 3) {
#pragma unroll
                for (int q = 0; q < 4; ++q) { const float* d = drow + RS_OFF(4 * (bt + 1) + q); xa[(bt + 1) & 1][q] = *(const f32x4*)d; xb[(bt + 1) & 1][q] = *(const f32x4*)(d + 8 * DM); } }
#pragma unroll
            for (int q = 0; q < 4; ++q) { const int st = 4 * bt + q, ai = (st >> 3) & 1, m = (st >> 1) & 3, bj = st & 1;
                *(LAS f32x4*)(sw + fr * 128 + (((2 * fq) ^ (fr & 7)) << 4)) = acc[ai][bj][m][0];
                *(LAS f32x4*)(sw + fr * 128 + (((2 * fq + 1) ^ (fr & 7)) << 4)) = acc[ai][bj][m][1];
                f32x4 a = *(const LAS f32x4*)(sw + rr * 128 + ((c ^ rr) << 4)), b = *(const LAS f32x4*)(sw + (8 + rr) * 128 + ((c ^ rr) << 4));
                float* d = drow + RS_OFF(st);
                if (!piece) { a += xa[bt & 1][q]; b += xb[bt & 1][q]; }
                *(f32x4*)d = a; *(f32x4*)(d + 8 * DM) = b; }
        }
#undef RS_OFF
    }
};
struct EpiUp {
    static constexpr bool HOOK = false;
    bf16* U; LAS unsigned char* scr;
    __device__ __forceinline__ void operator()(const f32x4 (&acc)[2][2][4][2], const Unit& u, int wr, int wc, int fr, int fq) const {
        bf16* base = U + (size_t)(u.pm * BM + wr * 64) * DFF + u.pn * BM + wc * 64; LAS unsigned char* sw = scr + (wr * 4 + wc) * 2048;
#pragma unroll
        for (int ai = 0; ai < 2; ++ai) { u32x4 ra[4], rb[4];
#pragma unroll
            for (int m = 0; m < 4; ++m) {
                f32x4 v0 = acc[ai][0][m][0], v1 = acc[ai][0][m][1], v2 = acc[ai][1][m][0], v3 = acc[ai][1][m][1];
#pragma unroll
                for (int e = 0; e < 4; ++e) { const float a = fmaxf(v0[e], 0.f), b = fmaxf(v1[e], 0.f), c = fmaxf(v2[e], 0.f), d = fmaxf(v3[e], 0.f); v0[e] = a * a; v1[e] = b * b; v2[e] = c * c; v3[e] = d * d; }
                sl_xpose(sw, pk8(v0, v1), pk8(v2, v3), fr, fq, ra[m], rb[m]); }
#pragma unroll
            for (int m = 0; m < 4; ++m) sl_store<true>(ra[m], rb[m], base + (size_t)(ai * HALF + m * 16) * DFF, (size_t)DFF, fr, fq); }
    }
};
}

namespace att {
__device__ __forceinline__ int crow(int r, int hi) { return (r & 3) + 8 * (r >> 2) + 4 * hi; }
__device__ __forceinline__ int v_st(int k, int c) { const int kk = (k & ~0xC) | ((k & 4) << 1) | ((k & 8) >> 1); return ((kk >> 3) * 4 + (c >> 5)) * 512 + ((kk & 7) * 32 + (c & 31)) * 2; }
__device__ __forceinline__ int v_rd_base(int lane) { return ((lane & 3) << 3) | (((lane >> 2) & 3) << 6) | (((lane >> 4) & 1) << 5) | (((lane >> 5) & 1) << 8); }
constexpr int v_rd_off(int d0, int ks, int half) { return d0 * 512 + ks * 4096 + half * 2048; }
template <int OFF> __device__ __forceinline__ s16x4 tr_read(unsigned vb) {
    s16x4 r; asm volatile("ds_read_b64_tr_b16 %0, %1 offset:%2" : "=&v"(r) : "v"(vb), "i"(OFF) : "memory"); return r;
}
template <int DQK> struct Cn {
    static constexpr float SCALE = DQK == 64 ? 0.125f : (DQK == 128 ? 0.08838834764831845f : 0.07216878364870323f);
    static constexpr float C = SCALE * 1.4426950408889634f;
    static constexpr float THRR = 8.f / SCALE;
};
template <int DQK> __device__ __forceinline__ int kswz(int row) { return (DQK == 128 ? (row & 15) : ((row >> 1) & 7)) << 4; }
template <int DQK>
__device__ __forceinline__ void qkt_h(f32x16& p, const f32x16& cinit, const LAS char* Ks, int rowbase, const bf16x8* qr, int r32, int hi) {
    constexpr int KRB = DQK * 2;
    p = cinit;
    const int sw = kswz<DQK>(r32);
#pragma unroll
    for (int d0 = 0; d0 < DQK / 16; ++d0) { const int cb = (d0 * 2 + hi) * 16;
        const bf16x8 b = *(const LAS bf16x8*)(Ks + (rowbase + r32) * KRB + (cb ^ sw));
        p = __builtin_amdgcn_mfma_f32_32x32x16_bf16(b, qr[d0], p, 0, 0, 0); }
}
template <int DQK>
__device__ __forceinline__ void smx_h(f32x16& p, float negB, float& l_acc, bf16x8& paA, bf16x8& paB) {
#pragma unroll
    for (int r = 0; r < 16; ++r) p[r] = __builtin_amdgcn_exp2f(p[r]);
    float s0 = (p[0] + p[1]) + (p[2] + p[3]), s1 = (p[4] + p[5]) + (p[6] + p[7]), s2 = (p[8] + p[9]) + (p[10] + p[11]), s3 = (p[12] + p[13]) + (p[14] + p[15]);
    l_acc += (s0 + s1) + (s2 + s3);
#define PK4(P, BASE, OUT) do { unsigned a0 = cvtpk(P[BASE + 0], P[BASE + 1]), a1 = cvtpk(P[BASE + 2], P[BASE + 3]);   \
    unsigned b0 = cvtpk(P[BASE + 4], P[BASE + 5]), b1 = cvtpk(P[BASE + 6], P[BASE + 7]);                              \
    auto r0 = __builtin_amdgcn_permlane32_swap(a0, b0, false, false); auto r1 = __builtin_amdgcn_permlane32_swap(a1, b1, false, false); \
    u32x4 w = {r0[0], r1[0], r0[1], r1[1]}; OUT = __builtin_bit_cast(bf16x8, w); } while (0)
    PK4(p, 0, paA); PK4(p, 8, paB);
#undef PK4
}
template <int D0, int KS0> __device__ __forceinline__ void pv_half_one(f32x16& od, unsigned vb, bf16x8 paA, bf16x8 paB) {
    s16x4 l0 = tr_read<v_rd_off(D0, KS0, 0)>(vb), h0 = tr_read<v_rd_off(D0, KS0, 1)>(vb), l1 = tr_read<v_rd_off(D0, KS0 + 1, 0)>(vb), h1 = tr_read<v_rd_off(D0, KS0 + 1, 1)>(vb);
    asm volatile("s_waitcnt lgkmcnt(0)" : "+v"(l0), "+v"(h0), "+v"(l1), "+v"(h1) :: "memory");
#define PK(L, H) (bf16x8){L[0], L[1], L[2], L[3], H[0], H[1], H[2], H[3]}
    od = __builtin_amdgcn_mfma_f32_32x32x16_bf16(paA, PK(l0, h0), od, 0, 0, 0);
    od = __builtin_amdgcn_mfma_f32_32x32x16_bf16(paB, PK(l1, h1), od, 0, 0, 0);
#undef PK
}
template <int KS0> __device__ __forceinline__ void pv_half(f32x16* o, unsigned vb, bf16x8 paA, bf16x8 paB) {
#define TR4(D0) s16x4 l0_##D0 = tr_read<v_rd_off(D0, KS0, 0)>(vb), h0_##D0 = tr_read<v_rd_off(D0, KS0, 1)>(vb), l1_##D0 = tr_read<v_rd_off(D0, KS0 + 1, 0)>(vb), h1_##D0 = tr_read<v_rd_off(D0, KS0 + 1, 1)>(vb)
    TR4(0); TR4(1); TR4(2); TR4(3);
#undef TR4
    asm volatile("s_waitcnt lgkmcnt(0)" : "+v"(l0_0), "+v"(h0_0), "+v"(l1_0), "+v"(h1_0), "+v"(l0_1), "+v"(h0_1), "+v"(l1_1), "+v"(h1_1),
                                          "+v"(l0_2), "+v"(h0_2), "+v"(l1_2), "+v"(h1_2), "+v"(l0_3), "+v"(h0_3), "+v"(l1_3), "+v"(h1_3) :: "memory");
#define PK(L, H) (bf16x8){L[0], L[1], L[2], L[3], H[0], H[1], H[2], H[3]}
#define MM(D0) o[D0] = __builtin_amdgcn_mfma_f32_32x32x16_bf16(paA, PK(l0_##D0, h0_##D0), o[D0], 0, 0, 0); o[D0] = __builtin_amdgcn_mfma_f32_32x32x16_bf16(paB, PK(l1_##D0, h1_##D0), o[D0], 0, 0, 0)
    MM(0); MM(1); MM(2); MM(3);
#undef MM
#undef PK
}
struct VFrag { s16x4 l0[4], h0[4], l1[4], h1[4]; };
template <int KS0> __device__ __forceinline__ void pv_issue(VFrag& f, unsigned vb) {
    f.l0[0] = tr_read<v_rd_off(0, KS0, 0)>(vb); f.h0[0] = tr_read<v_rd_off(0, KS0, 1)>(vb); f.l1[0] = tr_read<v_rd_off(0, KS0 + 1, 0)>(vb); f.h1[0] = tr_read<v_rd_off(0, KS0 + 1, 1)>(vb);
    f.l0[1] = tr_read<v_rd_off(1, KS0, 0)>(vb); f.h0[1] = tr_read<v_rd_off(1, KS0, 1)>(vb); f.l1[1] = tr_read<v_rd_off(1, KS0 + 1, 0)>(vb); f.h1[1] = tr_read<v_rd_off(1, KS0 + 1, 1)>(vb);
    f.l0[2] = tr_read<v_rd_off(2, KS0, 0)>(vb); f.h0[2] = tr_read<v_rd_off(2, KS0, 1)>(vb); f.l1[2] = tr_read<v_rd_off(2, KS0 + 1, 0)>(vb); f.h1[2] = tr_read<v_rd_off(2, KS0 + 1, 1)>(vb);
    f.l0[3] = tr_read<v_rd_off(3, KS0, 0)>(vb); f.h0[3] = tr_read<v_rd_off(3, KS0, 1)>(vb); f.l1[3] = tr_read<v_rd_off(3, KS0 + 1, 0)>(vb); f.h1[3] = tr_read<v_rd_off(3, KS0 + 1, 1)>(vb);
}
__device__ __forceinline__ void pv_wait(VFrag& f) {
    asm volatile("s_waitcnt lgkmcnt(0)" : "+v"(f.l0[0]), "+v"(f.h0[0]), "+v"(f.l1[0]), "+v"(f.h1[0]), "+v"(f.l0[1]), "+v"(f.h0[1]), "+v"(f.l1[1]), "+v"(f.h1[1]),
                                          "+v"(f.l0[2]), "+v"(f.h0[2]), "+v"(f.l1[2]), "+v"(f.h1[2]), "+v"(f.l0[3]), "+v"(f.h0[3]), "+v"(f.l1[3]), "+v"(f.h1[3]) :: "memory");
}
__device__ __forceinline__ void pv_mma(f32x16* o, const VFrag& f, bf16x8 paA, bf16x8 paB) {
#define PK(L, H) (bf16x8){L[0], L[1], L[2], L[3], H[0], H[1], H[2], H[3]}
#pragma unroll
    for (int d = 0; d < 4; ++d) { o[d] = __builtin_amdgcn_mfma_f32_32x32x16_bf16(paA, PK(f.l0[d], f.h0[d]), o[d], 0, 0, 0); o[d] = __builtin_amdgcn_mfma_f32_32x32x16_bf16(paB, PK(f.l1[d], f.h1[d]), o[d], 0, 0, 0); }
#undef PK
}
struct UnitP {
    const bf16* Q; int ldq; int nq;
    const bf16* K; int ldk; const bf16* V; int ldv;
    void* O; int ldo;
    int NT;
    int kvalid;
    int lo_base, lo_step, hi_base, hi_step;
    int qpos0, kpos0; const float* tab;
    float negB;
    int fix_lo, fix_hi;
};
constexpr int LDS_ATT_V = 0, LDS_ATT_K = 49152, LDS_ATT_WS = RING_BYTES + 1024, LDS_ATT_TAB = LDS_ATT_WS + 2048, LDS_ATT_END = LDS_ATT_TAB + 1088;
static_assert(LDS_ATT_K + 3 * 24576 <= RING_BYTES && LDS_ATT_WS >= MISC_OFF + 128 && LDS_ATT_END <= EPI_OFF, "attention LDS");

template <int DQK, bool F32OUT, bool BIAS, bool PIPE2>
__device__ __forceinline__ void attn_unit(const UnitP& P, LAS char* lds) {
    constexpr int NQ = DQK / 16, KRB = DQK * 2, KCH = DQK / 8, KP = DQK / 64;
    constexpr int SHM_V = 16384, SHM_K = 64 * DQK * 2;
    constexpr float NEGINF = -__builtin_huge_valf();
    const int tid = fresh_tid(), wid = __builtin_amdgcn_readfirstlane(tid >> 6), lane = tid & 63, r32 = lane & 31, hi = lane >> 5;
    LAS char* V_lds = lds + LDS_ATT_V; LAS char* K_lds = lds + LDS_ATT_K;
    LAS float* ws = (LAS float*)(lds + LDS_ATT_WS) + wid * 64; LAS float* li_l = ws; LAS float* al_l = ws + 32;
    LAS float* tblS = (LAS float*)(lds + LDS_ATT_TAB);
    const int NT = P.NT, kvalid = P.kvalid;
    int lo_w = P.lo_base + P.lo_step * (wid >> 1); lo_w = lo_w < 0 ? 0 : lo_w;
    const int hi_w = P.hi_base + P.hi_step * (wid >> 1);
    float l_reg = 0.f; const float negB = P.negB; f32x16 o[4] = {}; bf16x8 qr[NQ];
    { int qrow = wid * 32 + r32; qrow = qrow < P.nq ? qrow : P.nq - 1;
      const bf16* Qw = P.Q + (size_t)qrow * P.ldq + hi * 8;
#pragma unroll
      for (int d0 = 0; d0 < NQ; ++d0) qr[d0] = *(const bf16x8*)(Qw + d0 * 16); }
    unsigned voffV[2], voffK[KP];
#pragma unroll
    for (int i = 0; i < 2; ++i) { const int b_ = (tid + 512 * i) * 16, st = b_ >> 9, kk = (st >> 2) * 8 + ((b_ & 511) >> 6), c = (st & 3) * 32 + ((b_ & 63) >> 1), k = (kk & ~0xC) | ((kk & 4) << 1) | ((kk & 8) >> 1);
        voffV[i] = (unsigned)(k * P.ldv + c) * 2u; }
#pragma unroll
    for (int p = 0; p < KP; ++p) { const int G = tid + 512 * p, row = G / KCH, slot = G % KCH, g = slot ^ (kswz<DQK>(row) >> 4); voffK[p] = (unsigned)(row * P.ldk + g * 8) * 2u; }
    const unsigned vb0 = (unsigned)(uintptr_t)V_lds + (unsigned)v_rd_base(lane);
    const bf16* Kh = P.K; const bf16* Vh = P.V; const int ldk = P.ldk, ldv = P.ldv;
#define DMA(b, k0) do { const char* vsrc_ = (const char*)(Vh + (size_t)(k0) * ldv); const char* ksrc_ = (const char*)(Kh + (size_t)(k0) * ldk); \
    _Pragma("unroll") for (int i = 0; i < 2; ++i) __builtin_amdgcn_global_load_lds((const unsigned*)(vsrc_ + voffV[i]), (LAS unsigned*)(V_lds + (b) * SHM_V + wid * 1024 + i * 8192), 16, 0, 0); \
    _Pragma("unroll") for (int p = 0; p < KP; ++p) __builtin_amdgcn_global_load_lds((const unsigned*)(ksrc_ + voffK[p]), (LAS unsigned*)(K_lds + (b) * SHM_K + wid * 1024 + p * 8192), 16, 0, 0); } while (0)
#define FIXUP(p0, p1, jt) do { \
    if ((jt) < P.fix_lo || (jt) >= P.fix_hi) { int kv_ = kvalid, lo_ = lo_w, hi_ = hi_w; asm volatile("; masked-tile path" : "+s"(kv_), "+s"(lo_), "+s"(hi_) :: "memory");     \
      if ((jt) < lo_ || (jt) > hi_) { _Pragma("unroll") for (int r = 0; r < 16; ++r) { p0[r] = NEGINF; p1[r] = NEGINF; } } \
      else if (((jt) + 1) * 64 > kv_) { _Pragma("unroll") for (int r = 0; r < 16; ++r) { const int key = (jt) * 64 + crow(r, hi); if (key >= kv_) p0[r] = NEGINF; if (key + 32 >= kv_) p1[r] = NEGINF; } } } \
    if constexpr (BIAS) { if ((jt) >= lo_w && (jt) <= hi_w) { const int kb_ = P.kpos0 + (jt) * 64, qw_ = P.qpos0 + wid * 32; \
        if (qw_ - (kb_ + 63) >= 128) { const float c_ = tblS[256]; _Pragma("unroll") for (int r = 0; r < 16; ++r) { p0[r] += c_; p1[r] += c_; } } \
        else { const int dq_ = qw_ + r32 - kb_; _Pragma("unroll") for (int r = 0; r < 16; ++r) { int d0_ = dq_ - crow(r, hi), d1_ = d0_ - 32; \
            d0_ = d0_ < -128 ? -128 : (d0_ > 128 ? 128 : d0_); d1_ = d1_ < -128 ? -128 : (d1_ > 128 ? 128 : d1_); p0[r] += tblS[d0_ + 128]; p1[r] += tblS[d1_ + 128]; } } } } \
    } while (0)
    f32x16 pA0, pA1; bf16x8 pa0, pa1, pa2, pa3;
    DMA(0, 0); if (1 < NT) DMA(1, 64);
    if constexpr (BIAS) { if (tid < 257) tblS[tid] = P.tab[tid] * 1.4426950408889634f; }
    if (1 < NT) { if constexpr (KP == 1) asm volatile("s_waitcnt vmcnt(3)" ::: "memory"); else if constexpr (KP == 2) asm volatile("s_waitcnt vmcnt(4)" ::: "memory"); else asm volatile("s_waitcnt vmcnt(5)" ::: "memory"); }
    else asm volatile("s_waitcnt vmcnt(0)" ::: "memory");
    asm volatile("s_waitcnt lgkmcnt(0)\n\ts_barrier" ::: "memory");
    if constexpr (!PIPE2) {
#define FIXUP_H(p, jt, kofs) do { \
    if ((jt) < P.fix_lo || (jt) >= P.fix_hi) { int kv_ = kvalid, lo_ = lo_w, hi_ = hi_w; asm volatile("; masked-tile path" : "+s"(kv_), "+s"(lo_), "+s"(hi_) :: "memory"); \
      if ((jt) < lo_ || (jt) > hi_) { _Pragma("unroll") for (int r = 0; r < 16; ++r) p[r] = NEGINF; } \
      else if (((jt) + 1) * 64 > kv_) { _Pragma("unroll") for (int r = 0; r < 16; ++r) { if ((jt) * 64 + (kofs) + crow(r, hi) >= kv_) p[r] = NEGINF; } } } \
    if constexpr (BIAS) { if ((jt) >= lo_w && (jt) <= hi_w) { const int kb_ = P.kpos0 + (jt) * 64 + (kofs), qw_ = P.qpos0 + wid * 32; \
        if (qw_ - (kb_ + 31) >= 128) { const float c_ = tblS[256]; _Pragma("unroll") for (int r = 0; r < 16; ++r) p[r] += c_; } \
        else { const int dq_ = qw_ + r32 - kb_; _Pragma("unroll") for (int r = 0; r < 16; ++r) { int d0_ = dq_ - crow(r, hi); d0_ = d0_ < -128 ? -128 : (d0_ > 128 ? 128 : d0_); p[r] += tblS[d0_ + 128]; } } } } \
    } while (0)
        static_assert(!PIPE2, "q is pre-scaled: only the half-tile loop is current");
        f32x16 cinit;
#pragma unroll
        for (int r = 0; r < 16; ++r) cinit[r] = negB;
        const bool wave_on = wid * 32 < P.nq;
        int bsel = 0;
        for (int j = 0; j < NT; ++j) {
            const int bn1 = bsel == 2 ? 0 : bsel + 1, bn2 = bn1 == 2 ? 0 : bn1 + 1;
            if (j + 2 < NT) DMA(bn2, (j + 2) * 64);
            if (wave_on && j >= lo_w && j <= hi_w) {
            SBAR(); qkt_h<DQK>(pA0, cinit, K_lds + bsel * SHM_K, 0, qr, r32, hi);
            FIXUP_H(pA0, j, 0);
            SBAR(); qkt_h<DQK>(pA1, cinit, K_lds + bsel * SHM_K, 32, qr, r32, hi); smx_h<DQK>(pA0, negB, l_reg, pa0, pa1);
            FIXUP_H(pA1, j, 32);
            if constexpr (true) {
                VFrag f0, f2; SBAR(); pv_issue<0>(f0, vb0 + bsel * SHM_V); pv_wait(f0); pv_issue<2>(f2, vb0 + bsel * SHM_V);
                pv_mma(o, f0, pa0, pa1); smx_h<DQK>(pA1, negB, l_reg, pa2, pa3);
                SBAR(); pv_wait(f2); pv_mma(o, f2, pa2, pa3); SBAR();
            } else {
            SBAR(); pv_half<0>(o, vb0 + bsel * SHM_V, pa0, pa1); smx_h<DQK>(pA1, negB, l_reg, pa2, pa3);
            SBAR(); pv_half<2>(o, vb0 + bsel * SHM_V, pa2, pa3); SBAR();
            }
            }
            if (j + 2 < NT) { if constexpr (KP == 1) asm volatile("s_waitcnt vmcnt(3) lgkmcnt(0)\n\ts_barrier" ::: "memory"); else if constexpr (KP == 2) asm volatile("s_waitcnt vmcnt(4) lgkmcnt(0)\n\ts_barrier" ::: "memory"); else asm volatile("s_waitcnt vmcnt(5) lgkmcnt(0)\n\ts_barrier" ::: "memory"); }
            else asm volatile("s_waitcnt vmcnt(0) lgkmcnt(0)\n\ts_barrier" ::: "memory");
            bsel = bn1;
        }
#undef FIXUP_H
    }
    { auto rr = __builtin_amdgcn_permlane32_swap(__float_as_uint(l_reg), __float_as_uint(l_reg), false, false); l_reg = __uint_as_float(rr[0]) + __uint_as_float(rr[1]); }
    if (hi == 0) li_l[r32] = l_reg; asm volatile("s_waitcnt lgkmcnt(0)" ::: "memory");
    float rli[16];
#pragma unroll
    for (int r = 0; r < 16; ++r) rli[r] = __builtin_amdgcn_rcpf(li_l[crow(r, hi)]);
    const int nq = P.nq, ldo = P.ldo;
#pragma unroll
    for (int r = 0; r < 16; ++r) { const int orow = wid * 32 + crow(r, hi);
        if (orow < nq) {
            if constexpr (F32OUT) { float* Ow = (float*)P.O + (size_t)orow * ldo + r32;
#pragma unroll
                for (int d0 = 0; d0 < 4; ++d0) Ow[d0 * 32] = o[d0][r] * rli[r]; }
            else { bf16* Ow = (bf16*)P.O + (size_t)orow * ldo + r32;
#pragma unroll
                for (int d0 = 0; d0 < 4; ++d0) Ow[d0 * 32] = (bf16)(cvtpk(o[d0][r] * rli[r], 0.f) & 0xffffu); }
        } }
    __syncthreads();
#undef DMA
#undef FIXUP
}
}

template <class T> __device__ __forceinline__ T* launder(T* p) { asm volatile("" : "+s"(p)); return p; }
struct Frame {
    LAS unsigned char* lds;
    int tid, lane, wave, vcu, G, bx;
    int gw, NGW;
    float* out; unsigned char* ws;
};
struct Args { const float* in[31]; float* out; unsigned char* ws; int ph_lo, ph_hi; int use_bar, pad; };
typedef const __attribute__((address_space(4))) Args* ArgsP;
__device__ __forceinline__ ArgsP fresh_args() { ArgsP p = (ArgsP)__builtin_amdgcn_kernarg_segment_ptr(); asm volatile("" : "+s"(p)); return p; }
enum { I_XP = 0, I_XS, I_CAK, I_CAV, I_CBC, I_CBP, I_CCK, I_CCV, I_ANORM, I_WIN, I_BGATE, I_AQN, I_AKN, I_ALAM, I_ASUB, I_BQAN, I_BKVN, I_WQB, I_WKVB, I_BQN, I_BKN, I_CQN, I_CKN, I_CBIAS,
       I_WBRA, I_WBRB, I_WBRC, I_WO, I_MNORM, I_WUP, I_WDN };

__device__ __forceinline__ void transpose_item(const float* W, int K, int N, bf16* WT, int ldw, int gap_at, int gap, LAS float* scr, int item, int lane) {
    const int nblk = N / 32, kb = item / nblk, nb = item % nblk, k0 = 64 * kb, n0 = 32 * nb;
    float t[32];
#pragma unroll
    for (int i = 0; i < 32; ++i) t[i] = W[(size_t)(k0 + 2 * i + (lane >> 5)) * N + n0 + (lane & 31)];
#pragma unroll
    for (int i = 0; i < 32; ++i) scr[(2 * i + (lane >> 5)) * 33 + (lane & 31)] = t[i];
    LDS_WAIT(); asm volatile("" ::: "memory");
    const int c = lane & 7; const int roff = (n0 >= gap_at) ? gap : 0;
#pragma unroll
    for (int j = 0; j < 4; ++j) { const int n = (lane >> 3) + 8 * j; const LAS float* s = scr + (8 * c) * 33 + n;
        u32x4 o; o.x = cvtpk(s[0 * 33], s[1 * 33]); o.y = cvtpk(s[2 * 33], s[3 * 33]); o.z = cvtpk(s[4 * 33], s[5 * 33]); o.w = cvtpk(s[6 * 33], s[7 * 33]);
        *(u32x4*)(WT + (size_t)(roff + n0 + n) * ldw + k0 + 8 * c) = o; }
    LDS_WAIT(); asm volatile("" ::: "memory");
}

__device__ __forceinline__ void rmsnorm_rows(const Frame& F, ArgsP A, const float* g, bf16* H, bool first, const float* slab, int ns) {
    float* X = F.out + OUT_Y;
    if (!first) {
        LAS float* part = (LAS float*)(F.lds + EPI_OFF);
        for (int rs = F.vcu; rs < MS; rs += F.G) {
            const size_t off = (size_t)rs * DM + 256 * F.wave + 4 * F.lane;
            f32x4 v = *(const f32x4*)(X + (size_t)MP * DM + off);
            const float* sp = slab + off;
            for (int k = 0; k < ns; k += 8) { f32x4 t[8];
#pragma unroll
                for (int q = 0; q < 8; ++q) t[q] = *(const f32x4*)(sp + (size_t)(k + q) * MS * DM);
#pragma unroll
                for (int q = 0; q < 8; ++q) v += t[q]; }
            const float ps = wave_sum((v.x * v.x + v.y * v.y) + (v.z * v.z + v.w * v.w));
            __syncthreads();
            if (F.lane == 0) part[F.wave] = ps;
            __syncthreads();
            float tot = 0.f;
#pragma unroll
            for (int w = 0; w < 8; ++w) tot += part[w];
            const float rstd = rsqrtf(tot * (1.f / DM) + EPS);
            const f32x4 gg = *(const f32x4*)(g + 256 * F.wave + 4 * F.lane);
            u32x2 w; w.x = cvtpk(v.x * rstd * gg.x, v.y * rstd * gg.y); w.y = cvtpk(v.z * rstd * gg.z, v.w * rstd * gg.w);
            *(u32x2*)(H + (size_t)MP * DM + off) = w;
            *(f32x4*)(X + (size_t)MP * DM + off) = v;
        }
    }
    constexpr int RU = 4;
    const int Rn = first ? M : MP;
    f32x4 gg[8];
#pragma unroll
    for (int j = 0; j < 8; ++j) gg[j] = *(const f32x4*)(g + 4 * F.lane + 256 * j);
    for (int row0 = F.gw; row0 < Rn; row0 += RU * F.NGW) {
        f32x4 v[RU][8];
#pragma unroll
        for (int u = 0; u < RU; ++u) { const int row = row0 + u * F.NGW;
            if (row < Rn) { const float* xr = first ? (row < MP ? A->in[I_XP] + (size_t)row * DM : A->in[I_XS] + (size_t)(row - MP) * DM) : X + (size_t)row * DM;
#pragma unroll
                for (int j = 0; j < 8; ++j) v[u][j] = *(const f32x4*)(xr + 4 * F.lane + 256 * j); } }
#pragma unroll
        for (int u = 0; u < RU; ++u) { const int row = row0 + u * F.NGW;
            if (row < Rn) {
                float ss = 0.f;
#pragma unroll
                for (int j = 0; j < 8; ++j) ss += (v[u][j].x * v[u][j].x + v[u][j].y * v[u][j].y) + (v[u][j].z * v[u][j].z + v[u][j].w * v[u][j].w);
                const float rstd = rsqrtf(wave_sum(ss) * (1.f / DM) + EPS);
#pragma unroll
                for (int j = 0; j < 8; ++j) {
                    u32x2 w; w.x = cvtpk(v[u][j].x * rstd * gg[j].x, v[u][j].y * rstd * gg[j].y); w.y = cvtpk(v[u][j].z * rstd * gg[j].z, v[u][j].w * rstd * gg[j].w);
                    *(u32x2*)(H + (size_t)row * DM + 4 * F.lane + 256 * j) = w;
                    if (first) *(f32x4*)(X + (size_t)row * DM + 4 * F.lane + 256 * j) = v[u][j]; } } }
    }
}
__device__ __forceinline__ void final_combine(const Frame& F, const float* slab, int ns) {
    float* X = F.out + OUT_Y;
    for (int rs = F.vcu; rs < MS; rs += F.G) {
        const size_t off = (size_t)rs * DM + 256 * F.wave + 4 * F.lane;
        f32x4 v = *(const f32x4*)(X + (size_t)MP * DM + off);
        const float* sp = slab + off;
        for (int k = 0; k < ns; k += 8) { f32x4 t[8];
#pragma unroll
            for (int q = 0; q < 8; ++q) t[q] = *(const f32x4*)(sp + (size_t)(k + q) * MS * DM);
#pragma unroll
            for (int q = 0; q < 8; ++q) v += t[q]; }
        *(f32x4*)(X + (size_t)MP * DM + off) = v;
    }
}
__device__ __forceinline__ void pre_weights(const Frame& F, ArgsP A, int l, unsigned char* wsw, int gw, int NGW, int it_lo = 0, int it_hi = 1 << 30) {
    LAS float* scr = (LAS float*)(F.lds + F.wave * 16384);
    constexpr int I_IN = (DM / 64) * (INCOLS / 32), I_QB = (512 / 64) * (1536 / 32), I_KVB = (256 / 64) * (2048 / 32), I_BA = (512 / 64) * (DM / 32), I_BB = (1024 / 64) * (DM / 32),
                  I_O = (DM / 64) * (DM / 32), I_UP = (DM / 64) * (DFF / 32), I_DN = (DFF / 64) * (DM / 32);
    constexpr int NITEMS = I_IN + I_QB + I_KVB + 2 * I_BA + I_BB + I_O + I_UP + I_DN;
    const int it_end = it_hi < NITEMS ? it_hi : NITEMS;
    for (int it = it_lo + gw; it < it_end; it += NGW) {
        int r = it;
        if (r < I_IN) { transpose_item(A->in[I_WIN] + (size_t)l * DM * INCOLS, DM, INCOLS, (bf16*)(wsw + WS_WIN), DM, 2368, 192, scr, r, F.lane); continue; } r -= I_IN;
        if (r < I_QB) { transpose_item(A->in[I_WQB] + (size_t)l * 512 * 1536, 512, 1536, (bf16*)(wsw + WS_WQB), 512, 1 << 30, 0, scr, r, F.lane); continue; } r -= I_QB;
        if (r < I_KVB) { transpose_item(A->in[I_WKVB] + (size_t)l * 256 * 2048, 256, 2048, (bf16*)(wsw + WS_WKVB), 256, 1 << 30, 0, scr, r, F.lane); continue; } r -= I_KVB;
        if (r < I_BA) { transpose_item(A->in[I_WBRA] + (size_t)l * 512 * DM, 512, DM, (bf16*)(wsw + WS_WBR), DM, 1 << 30, 0, scr, r, F.lane); continue; } r -= I_BA;
        if (r < I_BB) { transpose_item(A->in[I_WBRB] + (size_t)l * 1024 * DM, 1024, DM, (bf16*)(wsw + WS_WBR) + 512, DM, 1 << 30, 0, scr, r, F.lane); continue; } r -= I_BB;
        if (r < I_BA) { transpose_item(A->in[I_WBRC] + (size_t)l * 512 * DM, 512, DM, (bf16*)(wsw + WS_WBR) + 1536, DM, 1 << 30, 0, scr, r, F.lane); continue; } r -= I_BA;
        if (r < I_O) { transpose_item(A->in[I_WO] + (size_t)l * DM * DM, DM, DM, (bf16*)(wsw + WS_WO), DM, 1 << 30, 0, scr, r, F.lane); continue; } r -= I_O;
        if (r < I_UP) { transpose_item(A->in[I_WUP] + (size_t)l * DM * DFF, DM, DFF, (bf16*)(wsw + WS_WUP), DM, 1 << 30, 0, scr, r, F.lane); continue; } r -= I_UP;
        transpose_item(A->in[I_WDN] + (size_t)l * DFF * DM, DFF, DM, (bf16*)(wsw + WS_WDN), DFF, 1 << 30, 0, scr, r, F.lane);
    }
    const int gt = gw * 64 + F.lane, NGT = NGW * 64;
    if (it_lo == 0) {
        bf16* wz = (bf16*)(wsw + WS_WIN) + (size_t)2368 * DM;
        for (int i = gt; i < 192 * DM / 8; i += NGT) *(u32x4*)(wz + (size_t)i * 8) = (u32x4){0u, 0u, 0u, 0u};
    }
}
__device__ __forceinline__ void pre_caches(const Frame& F, ArgsP A, int l, int gw, int NGW) {
    unsigned char* ws = F.ws; const int gt = gw * 64 + F.lane, NGT = NGW * 64;
    {
        bf16* KA = (bf16*)(ws + WS_KA); bf16* VA = (bf16*)(ws + WS_VA); bf16* CKV = (bf16*)(ws + WS_CKV); float* KPE = (float*)(ws + WS_KPE); bf16* KC = (bf16*)(ws + WS_KC); bf16* VC = (bf16*)(ws + WS_VC);
        const float* cak = A->in[I_CAK] + (size_t)l * DECB * PAST * 512; const float* cav = A->in[I_CAV] + (size_t)l * DECB * PAST * 512;
        const float* cbc = A->in[I_CBC] + (size_t)l * DECB * PAST * 256; const float* cbp = A->in[I_CBP] + (size_t)l * DECB * PAST * 64;
        const float* cck = A->in[I_CCK] + (size_t)l * DECB * CPAST * 512; const float* ccv = A->in[I_CCV] + (size_t)l * DECB * CPAST * 512;
        for (int i0 = gt; i0 < DECB * PAST * 512 / 8; i0 += 4 * NGT) { f32x4 ka[4][2], va[4][2];
#pragma unroll
            for (int u = 0; u < 4; ++u) { const int i = i0 + u * NGT; if (i < DECB * PAST * 512 / 8) { const float* pk = cak + (size_t)i * 8; const float* pv = cav + (size_t)i * 8;
                ka[u][0] = *(const f32x4*)pk; ka[u][1] = *(const f32x4*)(pk + 4); va[u][0] = *(const f32x4*)pv; va[u][1] = *(const f32x4*)(pv + 4); } }
#pragma unroll
            for (int u = 0; u < 4; ++u) { const int i = i0 + u * NGT; if (i < DECB * PAST * 512 / 8) { const int c = (i & 63) * 8, rr = i >> 6, b = rr >> 11, p = rr & 2047; const size_t d = ((size_t)MP + b * SROWS + p) * 512 + c;
                *(u32x4*)(KA + d) = pg8::pk8(ka[u][0], ka[u][1]); *(u32x4*)(VA + d) = pg8::pk8(va[u][0], va[u][1]); } } }
        for (int i0 = gt; i0 < DECB * PAST * 256 / 8; i0 += 4 * NGT) { f32x4 ka[4][2];
#pragma unroll
            for (int u = 0; u < 4; ++u) { const int i = i0 + u * NGT; if (i < DECB * PAST * 256 / 8) { const float* pk = cbc + (size_t)i * 8; ka[u][0] = *(const f32x4*)pk; ka[u][1] = *(const f32x4*)(pk + 4); } }
#pragma unroll
            for (int u = 0; u < 4; ++u) { const int i = i0 + u * NGT; if (i < DECB * PAST * 256 / 8) { const int c = (i & 31) * 8, rr = i >> 5, b = rr >> 11, p = rr & 2047; const size_t d = ((size_t)MP + b * SROWS + p) * 256 + c;
                *(u32x4*)(CKV + d) = pg8::pk8(ka[u][0], ka[u][1]); } } }
        for (int i = gt; i < DECB * PAST * 64 / 8; i += NGT) { const int c = (i & 7) * 8, rr = i >> 3, b = rr >> 11, p = rr & 2047; const size_t d = ((size_t)MP + b * SROWS + p) * 64 + c;
            float v[8]; ld8f(cbp + (size_t)i * 8, v); st8f(KPE + d, v); }
        for (int i0 = gt; i0 < DECB * CPAST * 512 / 8; i0 += 4 * NGT) { f32x4 ka[4][2], va[4][2];
#pragma unroll
            for (int u = 0; u < 4; ++u) { const int i = i0 + u * NGT; if (i < DECB * CPAST * 512 / 8) { const float* pk = cck + (size_t)i * 8; const float* pv = ccv + (size_t)i * 8;
                ka[u][0] = *(const f32x4*)pk; ka[u][1] = *(const f32x4*)(pk + 4); va[u][0] = *(const f32x4*)pv; va[u][1] = *(const f32x4*)(pv + 4); } }
#pragma unroll
            for (int u = 0; u < 4; ++u) { const int i = i0 + u * NGT; if (i < DECB * CPAST * 512 / 8) { const int c = (i & 63) * 8, rr = i >> 6, b = rr >> 9, p = rr & 511; const size_t d = ((size_t)MP + b * CROWS + p) * 512 + c;
                *(u32x4*)(KC + d) = pg8::pk8(ka[u][0], ka[u][1]); *(u32x4*)(VC + d) = pg8::pk8(va[u][0], va[u][1]); } } }
        const u32x4 z4 = (u32x4){0u, 0u, 0u, 0u};
        for (int i = gt; i < DECB * 112 * 64; i += NGT) { const int c = (i & 63) * 8, rr = i >> 6, b = rr / 112, p = rr % 112;
            const size_t d = ((size_t)MP + b * SROWS + PAST + DECS + p) * 512 + c; *(u32x4*)(KA + d) = z4; *(u32x4*)(VA + d) = z4;
            const size_t dc = ((size_t)MP + b * CROWS + CPAST + DECS + p) * 512 + c; *(u32x4*)(KC + dc) = z4; *(u32x4*)(VC + dc) = z4; }
        for (int i = gt; i < DECB * 112 * 32; i += NGT) { const int c = (i & 31) * 8, rr = i >> 5, b = rr / 112, p = rr % 112;
            const size_t d = ((size_t)MP + b * SROWS + PAST + DECS + p) * 256 + c; *(u32x4*)(CKV + d) = z4; }
        for (int i = gt; i < DECB * 112 * 16; i += NGT) { const int c = (i & 15) * 4, rr = i >> 4, b = rr / 112, p = rr % 112;
            const size_t d = ((size_t)MP + b * SROWS + PAST + DECS + p) * 64 + c; *(f32x4*)(KPE + d) = (f32x4){0.f, 0.f, 0.f, 0.f}; }
    }
}
constexpr size_t WS_SLAB_O = WS_R2, WS_SLAB_DN = WS_R2 + 64 * MiB;
constexpr int NS_O = 16, NS_DN = 32;
static_assert(NS_O % 8 == 0 && NS_DN % 8 == 0 && (size_t)NS_O * MS * DM * 4 <= 64 * MiB && (size_t)NS_DN * MS * DM * 4 <= 64 * MiB && WS_SLAB_DN + 64 * MiB <= WS_OALL, "slabs");
constexpr int WCUT1 = 13000, WCUT2 = 26500;
constexpr size_t WS_WSET1 = 1823 * MiB;
static_assert(WS_WDN + WS_WSET1 + (size_t)DM * DFF * 2 <= 2032 * MiB && WS_WIN + WS_WSET1 >= WS_END, "second weight set");
__device__ __forceinline__ void phase_pre(const Frame& F, ArgsP A, int l) {
    if (l == 0) { pre_weights(F, A, 0, F.ws, F.gw, F.NGW); pre_caches(F, A, 0, F.gw, F.NGW); }
    rmsnorm_rows(F, A, A->in[I_ANORM] + (size_t)l * DM, (bf16*)(F.ws + WS_R3), l == 0, (const float*)(F.ws + WS_SLAB_DN), NS_DN);
}

__device__ __forceinline__ float rope_inv(int lane) { return __builtin_amdgcn_exp2f(-(float)(lane & 31) * (18.931568569324174f / 32.f)); }
__device__ __forceinline__ void rope_cs(int pos, float inv, float& cs, float& sn) {
    const float a = (float)pos * inv; const float k = rintf(a * 0.15915494309189535f);
    float r = fmaf(-k, 6.28125f, a); r = fmaf(-k, 1.9353071795864769e-3f, r);
    const float rev = r * 0.15915494309189535f;
    cs = __builtin_amdgcn_cosf(rev); sn = __builtin_amdgcn_sinf(rev);
}

__device__ __forceinline__ void phase_post_in(const Frame& F, ArgsP A, int l) {
    unsigned char* ws = F.ws; const int lane = F.lane;
    const bf16* Z = (const bf16*)(ws + WS_R1);
    bf16* QA = (bf16*)(ws + WS_QA); bf16* KA = (bf16*)(ws + WS_KA); bf16* VA = (bf16*)(ws + WS_VA); bf16* CQ = (bf16*)(ws + WS_CQ); bf16* CKV = (bf16*)(ws + WS_CKV); float* KPE = (float*)(ws + WS_KPE);
    bf16* QC = (bf16*)(ws + WS_QC); bf16* KC = (bf16*)(ws + WS_KC); bf16* VC = (bf16*)(ws + WS_VC);
    const float inv = rope_inv(lane);
    float gq[8], gk[8], gqa[8], gkv[8], gcq[8], gck[8];
    ld8f(A->in[I_AQN] + l * 64 + 8 * (lane & 7), gq); ld8f(A->in[I_AKN] + l * 64 + 8 * (lane & 7), gk);
    ld8f(A->in[I_BQAN] + l * 512 + 8 * lane, gqa); ld8f(A->in[I_BKVN] + l * 256 + 8 * (lane & 31), gkv);
    ld8f(A->in[I_CQN] + l * 128 + 8 * (lane & 15), gcq); ld8f(A->in[I_CKN] + l * 128 + 8 * (lane & 15), gck);
    u32x4 zc[8], zn[8];
    if (F.gw < M) {
#pragma unroll
        for (int q = 0; q < 8; ++q) zc[q] = *(const u32x4*)(Z + (size_t)F.gw * NZ + 8 * lane + 512 * q); }
    for (int row = F.gw; row < M; row += F.NGW) {
        { const int nrow = row + F.NGW;
          if (nrow < M) {
#pragma unroll
              for (int q = 0; q < 8; ++q) zn[q] = *(const u32x4*)(Z + (size_t)nrow * NZ + 8 * lane + 512 * q); } }
        const bool samp = row >= MP; int b, t, pos;
        if (!samp) { b = row >> 14; t = row & (SEQ - 1); pos = t; } else { const int r = row - MP; b = r >> 4; t = r & 15; pos = PAST + t; }
        const size_t kvrow = samp ? (size_t)MP + b * SROWS + PAST + t : (size_t)row;
        const size_t ccrow = samp ? (size_t)MP + b * CROWS + CPAST + t : (size_t)row;
        float* o_ak = F.out + (samp ? OUT_AK_S + ((size_t)l * MS + (row - MP)) * 512 : OUT_AK_P + ((size_t)l * MP + row) * 512) + 8 * lane;
        float* o_av = F.out + (samp ? OUT_AV_S + ((size_t)l * MS + (row - MP)) * 512 : OUT_AV_P + ((size_t)l * MP + row) * 512) + 8 * lane;
        float* o_bc = F.out + (samp ? OUT_BC_S + ((size_t)l * MS + (row - MP)) * 256 : OUT_BC_P + ((size_t)l * MP + row) * 256) + 8 * (lane & 31);
        float* o_bp = F.out + (samp ? OUT_BP_S + ((size_t)l * MS + (row - MP)) * 64 : OUT_BP_P + ((size_t)l * MP + row) * 64) + 8 * (lane & 7);
        const bool cout = samp || t >= SEQ - 512;
        float* o_ck = F.out + (samp ? OUT_CK_S + ((size_t)l * MS + (row - MP)) * 512 : OUT_CK_P + (((size_t)l * NBATCH + b) * 512 + (t - (SEQ - 512))) * 512) + 8 * lane;
        float* o_cv = F.out + (samp ? OUT_CV_S + ((size_t)l * MS + (row - MP)) * 512 : OUT_CV_P + (((size_t)l * NBATCH + b) * 512 + (t - (SEQ - 512))) * 512) + 8 * lane;
        float cs, sn; rope_cs(pos, inv, cs, sn);
        float v[8], y[8];
#pragma unroll
        for (int seg = 0; seg < 2; ++seg) {
            unpack8(zc[seg], v);
            float ss = sumsq8(v); ss += __shfl_xor(ss, 1); ss += __shfl_xor(ss, 2); ss += __shfl_xor(ss, 4);
            const float rstd = rsqrtf(ss * (1.f / 64) + EPS);
#pragma unroll
            for (int e = 0; e < 8; ++e) y[e] = v[e] * rstd * (seg == 0 ? gq[e] : gk[e]);
#pragma unroll
            for (int e = 0; e < 8; ++e) { const float part = __shfl_xor(y[e], 1), c = __shfl(cs, 4 * e), s = __shfl(sn, 4 * e);
                if ((lane & 7) == 0) y[e] = y[e] * c - part * s; else if ((lane & 7) == 1) y[e] = y[e] * c + part * s; }
            if (seg == 0) { float yq[8];
#pragma unroll
                for (int e = 0; e < 8; ++e) yq[e] = y[e] * att::Cn<64>::C;
                *(u32x4*)(QA + (size_t)row * 512 + 8 * lane) = pack8(yq); }
            else { *(u32x4*)(KA + kvrow * 512 + 8 * lane) = pack8(y); st8f_nt(o_ak, y); }
        }
        { const u32x4 w = zc[2]; *(u32x4*)(VA + kvrow * 512 + 8 * lane) = w; unpack8(w, v); st8f_nt(o_av, v); }
        { unpack8(zc[3], v); const float rstd = rsqrtf(wave_sum(sumsq8(v)) * (1.f / 512) + EPS);
#pragma unroll
          for (int e = 0; e < 8; ++e) y[e] = v[e] * rstd * gqa[e];
          *(u32x4*)(CQ + (size_t)row * 512 + 8 * lane) = pack8(y); }
        { unpack8(zc[4], v);
          float ss = sumsq8(v); ss += __shfl_xor(ss, 1); ss += __shfl_xor(ss, 2); ss += __shfl_xor(ss, 4); ss += __shfl_xor(ss, 8); ss += __shfl_xor(ss, 16);
          const float rstd = rsqrtf(ss * (1.f / 256) + EPS);
          const int i = lane & 7;
#pragma unroll
          for (int e = 0; e < 8; ++e) { const float part = __shfl_xor(v[e], 4); const int fi = 8 * (i & 3) + e; const float c = __shfl(cs, fi), s = __shfl(sn, fi);
              y[e] = (lane < 32) ? v[e] * rstd * gkv[e] : ((i < 4) ? v[e] * c - part * s : v[e] * c + part * s); }
          if (lane < 32) { *(u32x4*)(CKV + kvrow * 256 + 8 * lane) = pack8(y); st8f_nt(o_bc, y); }
          else if (lane < 40) { st8f(KPE + kvrow * 64 + 8 * i, y); st8f_nt(o_bp, y); } }
#pragma unroll
        for (int seg = 0; seg < 2; ++seg) {
            unpack8(zc[5 + seg], v);
            float ss = sumsq8(v); ss += __shfl_xor(ss, 1); ss += __shfl_xor(ss, 2); ss += __shfl_xor(ss, 4); ss += __shfl_xor(ss, 8);
            const float rstd = rsqrtf(ss * (1.f / 128) + EPS);
#pragma unroll
            for (int e = 0; e < 8; ++e) y[e] = v[e] * rstd * (seg == 0 ? gcq[e] * att::Cn<128>::C : gck[e]);
            if (seg == 0) *(u32x4*)(QC + (size_t)row * 512 + 8 * lane) = pack8(y);
            else { *(u32x4*)(KC + ccrow * 512 + 8 * lane) = pack8(y); if (cout) st8f_nt(o_ck, y); }
        }
        { const u32x4 w = zc[7]; *(u32x4*)(VC + ccrow * 512 + 8 * lane) = w; if (cout) { unpack8(w, v); st8f_nt(o_cv, v); } }
#pragma unroll
        for (int q = 0; q < 8; ++q) zc[q] = zn[q];
    }
}

__device__ __forceinline__ void phase_post_b(const Frame& F, ArgsP A, int l) {
    unsigned char* ws = F.ws; const int lane = F.lane, h = lane >> 3, i = lane & 7;
    const bf16* QBR = (const bf16*)(ws + WS_R2); const bf16* KVR = (const bf16*)(ws + WS_R1); const float* KPE = (const float*)(ws + WS_KPE);
    bf16* QB = (bf16*)(ws + WS_QB); bf16* KB = (bf16*)(ws + WS_R3);
    const float inv = rope_inv(lane);
    float g0[8], g1[8], g2[8];
    ld8f(A->in[I_BQN] + l * 192 + 8 * i, g0); ld8f(A->in[I_BQN] + l * 192 + 64 + 8 * i, g1); ld8f(A->in[I_BQN] + l * 192 + 128 + 8 * i, g2);
    constexpr int RU = 4;
    for (int row0 = F.gw; row0 < M; row0 += RU * F.NGW) {
        u32x4 w0[RU], w1[RU], w2[RU];
#pragma unroll
        for (int u = 0; u < RU; ++u) { const int row = row0 + u * F.NGW;
            if (row < M) { const bf16* src = QBR + (size_t)row * 1536 + 192 * h + 8 * i; w0[u] = *(const u32x4*)src; w1[u] = *(const u32x4*)(src + 64); w2[u] = *(const u32x4*)(src + 128); } }
#pragma unroll
        for (int u = 0; u < RU; ++u) { const int row = row0 + u * F.NGW;
            if (row < M) {
                const int pos = row < MP ? (row & (SEQ - 1)) : PAST + ((row - MP) & 15);
                float cs, sn; rope_cs(pos, inv, cs, sn);
                float v0[8], v1[8], v2[8]; unpack8(w0[u], v0); unpack8(w1[u], v1); unpack8(w2[u], v2);
#pragma unroll
                for (int e = 0; e < 8; ++e) { const float part = __shfl_xor(v2[e], 4); const int fi = 8 * (i & 3) + e; const float c = __shfl(cs, fi), s = __shfl(sn, fi);
                    v2[e] = (i < 4) ? v2[e] * c - part * s : v2[e] * c + part * s; }
                float ss = sumsq8(v0) + sumsq8(v1) + sumsq8(v2); ss += __shfl_xor(ss, 1); ss += __shfl_xor(ss, 2); ss += __shfl_xor(ss, 4);
                const float rstd = rsqrtf(ss * (1.f / 192) + EPS);
#pragma unroll
                for (int e = 0; e < 8; ++e) { v0[e] *= rstd * g0[e] * att::Cn<192>::C; v1[e] *= rstd * g1[e] * att::Cn<192>::C; v2[e] *= rstd * g2[e] * att::Cn<192>::C; }
                bf16* dst = QB + (size_t)row * 1536 + 192 * h + 8 * i;
                *(u32x4*)dst = pack8(v0); *(u32x4*)(dst + 64) = pack8(v1); *(u32x4*)(dst + 128) = pack8(v2); } }
    }
    ld8f(A->in[I_BKN] + l * 192 + 8 * i, g0); ld8f(A->in[I_BKN] + l * 192 + 64 + 8 * i, g1); ld8f(A->in[I_BKN] + l * 192 + 128 + 8 * i, g2);
    for (int row0 = F.gw; row0 < M2; row0 += RU * F.NGW) {
        u32x4 w0[RU], w1[RU]; f32x4 p0[RU], p1[RU];
#pragma unroll
        for (int u = 0; u < RU; ++u) { const int row = row0 + u * F.NGW;
            if (row < M2) { const bf16* src = KVR + (size_t)row * 2048 + 256 * h + 8 * i; w0[u] = *(const u32x4*)src; w1[u] = *(const u32x4*)(src + 64);
                const float* kp = KPE + (size_t)row * 64 + 8 * i; p0[u] = *(const f32x4*)kp; p1[u] = *(const f32x4*)(kp + 4); } }
#pragma unroll
        for (int u = 0; u < RU; ++u) { const int row = row0 + u * F.NGW;
            if (row < M2) {
                float v0[8], v1[8], v2[8]; unpack8(w0[u], v0); unpack8(w1[u], v1);
                v2[0] = p0[u].x; v2[1] = p0[u].y; v2[2] = p0[u].z; v2[3] = p0[u].w; v2[4] = p1[u].x; v2[5] = p1[u].y; v2[6] = p1[u].z; v2[7] = p1[u].w;
                float ss = sumsq8(v0) + sumsq8(v1) + sumsq8(v2); ss += __shfl_xor(ss, 1); ss += __shfl_xor(ss, 2); ss += __shfl_xor(ss, 4);
                const float rstd = rsqrtf(ss * (1.f / 192) + EPS);
#pragma unroll
                for (int e = 0; e < 8; ++e) { v0[e] *= rstd * g0[e]; v1[e] *= rstd * g1[e]; v2[e] *= rstd * g2[e]; }
                bf16* dst = KB + (size_t)row * 1536 + 192 * h + 8 * i;
                *(u32x4*)dst = pack8(v0); *(u32x4*)(dst + 64) = pack8(v1); *(u32x4*)(dst + 128) = pack8(v2); } }
    }
}

__device__ __forceinline__ void phase_post_a(const Frame& F, ArgsP A, int l) {
    unsigned char* ws = F.ws; const int lane = F.lane, h = lane >> 4, i = lane & 15;
    const float* OAR = (const float*)(ws + WS_R2); bf16* OA = (bf16*)(ws + WS_OALL);
    const float* lf = A->in[I_ALAM] + l * 256;
    const float s1 = wave_sum(lf[lane] * lf[64 + lane]), s2 = wave_sum(lf[128 + lane] * lf[192 + lane]);
    const float lam_init = 0.8f - 0.6f * expf(-0.3f * (float)l);
    const float lam = expf(s1) - expf(s2) + lam_init, og = 1.f - lam_init;
    float g[8]; ld8f(A->in[I_ASUB] + l * 128 + 8 * i, g);
    constexpr int RU = 4;
    for (int row0 = F.gw; row0 < M; row0 += RU * F.NGW) {
        f32x4 a0[RU], a1[RU], b0[RU], b1[RU];
#pragma unroll
        for (int u = 0; u < RU; ++u) { const int row = row0 + u * F.NGW;
            if (row < M) { const float* src = OAR + (size_t)row * 1024 + 256 * h + 8 * i; a0[u] = *(const f32x4*)src; a1[u] = *(const f32x4*)(src + 4); b0[u] = *(const f32x4*)(src + 128); b1[u] = *(const f32x4*)(src + 132); } }
#pragma unroll
        for (int u = 0; u < RU; ++u) { const int row = row0 + u * F.NGW;
            if (row < M) {
                float d[8];
                d[0] = a0[u].x - lam * b0[u].x; d[1] = a0[u].y - lam * b0[u].y; d[2] = a0[u].z - lam * b0[u].z; d[3] = a0[u].w - lam * b0[u].w;
                d[4] = a1[u].x - lam * b1[u].x; d[5] = a1[u].y - lam * b1[u].y; d[6] = a1[u].z - lam * b1[u].z; d[7] = a1[u].w - lam * b1[u].w;
                float ss = sumsq8(d); ss += __shfl_xor(ss, 1); ss += __shfl_xor(ss, 2); ss += __shfl_xor(ss, 4); ss += __shfl_xor(ss, 8);
                const float rstd = rsqrtf(ss * (1.f / 128) + EPS) * og;
#pragma unroll
                for (int e = 0; e < 8; ++e) d[e] *= rstd * g[e];
                *(u32x4*)(OA + (size_t)row * 2048 + 128 * h + 8 * i) = pack8(d); } }
    }
}

template <int N> __device__ __forceinline__ float absmax_part(const float* g, int lane) {
    float v[(N + 63) / 64];
#pragma unroll
    for (int k = 0; k < (N + 63) / 64; ++k) { const int i = lane + 64 * k; v[k] = g[i < N ? i : N - 1]; }
    float m = 0.f;
#pragma unroll
    for (int k = 0; k < (N + 63) / 64; ++k) m = fmaxf(m, fabsf(v[k]));
    return m;
}
__device__ __forceinline__ float wave_max(float m) {
#pragma unroll
    for (int o = 1; o < 64; o <<= 1) m = fmaxf(m, __shfl_xor(m, o));
    return __uint_as_float(__builtin_amdgcn_readfirstlane(__float_as_uint(m)));
}
__device__ __forceinline__ void phase_attn(const Frame& F, ArgsP A, int l) {
    unsigned char* ws = F.ws; LAS char* lds = (LAS char*)F.lds;
    const bf16* QA = (const bf16*)(ws + WS_QA); const bf16* KA = (const bf16*)(ws + WS_KA); const bf16* VA = (const bf16*)(ws + WS_VA);
    const bf16* QB = (const bf16*)(ws + WS_QB); const bf16* KB = (const bf16*)(ws + WS_R3); const bf16* KVR = (const bf16*)(ws + WS_R1);
    const bf16* QC = (const bf16*)(ws + WS_QC); const bf16* KC = (const bf16*)(ws + WS_KC); const bf16* VC = (const bf16*)(ws + WS_VC);
    float* OAR = (float*)(ws + WS_R2); bf16* OB = (bf16*)(ws + WS_OALL) + 512; bf16* OC = (bf16*)(ws + WS_OALL) + 1536;
    const float p_aq = absmax_part<64>(A->in[I_AQN] + l * 64, F.lane), p_ak = absmax_part<64>(A->in[I_AKN] + l * 64, F.lane);
    const float p_bq = absmax_part<192>(A->in[I_BQN] + l * 192, F.lane), p_bk = absmax_part<192>(A->in[I_BKN] + l * 192, F.lane);
    const float p_cq = absmax_part<128>(A->in[I_CQN] + l * 128, F.lane), p_ck = absmax_part<128>(A->in[I_CKN] + l * 128, F.lane);
    const float p_cb = absmax_part<4 * 257>(A->in[I_CBIAS] + (size_t)l * 4 * 257, F.lane);
    const float negB_A = -1.4426950408889634f * 1.02f * 8.f * wave_max(p_aq) * wave_max(p_ak);
    const float negB_B = -1.4426950408889634f * 1.02f * 13.856406460551018f * wave_max(p_bq) * wave_max(p_bk);
    const float negB_C = -1.4426950408889634f * (1.02f * 11.313708498984761f * wave_max(p_cq) * wave_max(p_ck) + wave_max(p_cb));
#ifndef ATTM
#define ATTM 7
#endif
    if (ATTM & 1) for (int n = F.vcu; n < 1024 + 128; n += F.G) {
        att::UnitP P; P.ldq = 512; P.ldk = 512; P.ldv = 512; P.ldo = 1024; P.qpos0 = 0; P.kpos0 = 0; P.tab = nullptr; P.lo_base = 0; P.lo_step = 0;
        if (n < 1024) { const int v = n & 255, slot = n >> 8, x = v >> 5, j = v & 31, combo = 2 * x + (slot >> 1), b = combo >> 3, vh = combo & 7, i = (slot & 1) ? j : 63 - j;
            const size_t qrow = (size_t)b * SEQ + 256 * i, krow = (size_t)b * SEQ;
            P.Q = QA + qrow * 512 + 64 * vh; P.nq = 256; P.K = KA + krow * 512 + 64 * vh; P.V = VA + krow * 512 + 128 * (vh >> 1); P.O = OAR + qrow * 1024 + 128 * vh;
            P.NT = 4 * i + 4; P.kvalid = P.NT * 64; P.hi_base = 4 * i; P.hi_step = 1; P.fix_lo = 0; P.fix_hi = P.NT - 3;
        } else { const int s = n - 1024, b = s >> 3, vh = s & 7; const size_t qrow = (size_t)MP + 16 * b, krow = (size_t)MP + (size_t)b * SROWS;
            P.Q = QA + qrow * 512 + 64 * vh; P.nq = 16; P.K = KA + krow * 512 + 64 * vh; P.V = VA + krow * 512 + 128 * (vh >> 1); P.O = OAR + qrow * 1024 + 128 * vh;
            P.NT = SROWS / 64; P.kvalid = PAST + DECS; P.hi_base = SROWS / 64; P.hi_step = 0; P.fix_lo = 0; P.fix_hi = (PAST + DECS) / 64; }
        P.negB = negB_A; att::attn_unit<64, true, false, false>(P, lds);
    }
    if (ATTM & 2) for (int n = F.vcu; n < 1024 + 256; n += F.G) {
        att::UnitP P; P.ldq = 1536; P.ldk = 1536; P.ldv = 2048; P.ldo = 2048; P.qpos0 = 0; P.kpos0 = 0; P.tab = nullptr; P.lo_base = 0; P.lo_step = 0;
        if (n < 1024) { const int v = n & 255, slot = n >> 8, x = v >> 5, j = v & 31, combo = 2 * x + (slot >> 1), b = combo >> 3, hh = combo & 7, i = (slot & 1) ? j : 63 - j;
            const size_t qrow = (size_t)b * SEQ + 256 * i, krow = (size_t)b * SEQ;
            P.Q = QB + qrow * 1536 + 192 * hh; P.nq = 256; P.K = KB + krow * 1536 + 192 * hh; P.V = KVR + krow * 2048 + 256 * hh + 128; P.O = OB + qrow * 2048 + 128 * hh;
            P.NT = 4 * i + 4; P.kvalid = P.NT * 64; P.hi_base = 4 * i; P.hi_step = 1; P.fix_lo = 0; P.fix_hi = P.NT - 3;
        } else { const int s = n - 1024 - 128; if (s < 0) continue; const int b = s >> 3, hh = s & 7; const size_t qrow = (size_t)MP + 16 * b, krow = (size_t)MP + (size_t)b * SROWS;
            P.Q = QB + qrow * 1536 + 192 * hh; P.nq = 16; P.K = KB + krow * 1536 + 192 * hh; P.V = KVR + krow * 2048 + 256 * hh + 128; P.O = OB + qrow * 2048 + 128 * hh;
            P.NT = SROWS / 64; P.kvalid = PAST + DECS; P.hi_base = SROWS / 64; P.hi_step = 0; P.fix_lo = 0; P.fix_hi = (PAST + DECS) / 64; }
        P.negB = negB_B; att::attn_unit<192, false, false, false>(P, lds);
    }
    if (ATTM & 4) for (int n = F.vcu; n < 512 + 64; n += F.G) {
        att::UnitP P; P.ldq = 512; P.ldk = 512; P.ldv = 512; P.ldo = 2048;
        if (n < 512) { const int v = n & 255, slot = n >> 8, x = v >> 5, j = v & 31, b = x >> 2, hh = x & 3, i = j + 32 * slot, c0 = 4 * i, T0 = c0 >= 8 ? c0 - 8 : 0;
            const size_t qrow = (size_t)b * SEQ + 256 * i, krow = (size_t)b * SEQ + 64 * T0;
            P.Q = QC + qrow * 512 + 128 * hh; P.nq = 256; P.K = KC + krow * 512 + 128 * hh; P.V = VC + krow * 512 + 128 * hh; P.O = OC + qrow * 2048 + 128 * hh;
            P.NT = c0 + 4 - T0; P.kvalid = P.NT * 64; P.hi_base = c0 - T0; P.hi_step = 1; P.lo_base = c0 - 8 - T0; P.lo_step = 1; P.qpos0 = 256 * i; P.kpos0 = 64 * T0; P.fix_lo = 3; P.fix_hi = P.NT - 3;
            P.tab = A->in[I_CBIAS] + ((size_t)l * 4 + hh) * 257;
        } else { const int s = n - 512, b = s >> 2, hh = s & 3; const size_t qrow = (size_t)MP + 16 * b, krow = (size_t)MP + (size_t)b * CROWS;
            P.Q = QC + qrow * 512 + 128 * hh; P.nq = 16; P.K = KC + krow * 512 + 128 * hh; P.V = VC + krow * 512 + 128 * hh; P.O = OC + qrow * 2048 + 128 * hh;
            P.NT = CROWS / 64; P.kvalid = CPAST + DECS; P.hi_base = CROWS / 64; P.hi_step = 0; P.lo_base = 0; P.lo_step = 0; P.qpos0 = PAST; P.kpos0 = PAST - CPAST; P.fix_lo = 0; P.fix_hi = (CPAST + DECS) / 64;
            P.tab = A->in[I_CBIAS] + ((size_t)l * 4 + hh) * 257; }
        P.negB = negB_C; att::attn_unit<128, false, true, false>(P, lds);
    }
}

constexpr int NPH = 12, NPHASES = NPH * DEPTH + 1;

template <int l>
__device__ __forceinline__ void layer_body(Frame& F, LAS unsigned char* lds0, volatile LAS unsigned* MISC, const int lo, const int hi) {
#ifndef PHM
#define PHM 0xfff
#endif
#define IN(k) (((PHM >> ((k) % NPH)) & 1) && lo <= (k) && (k) < hi)
#define SEAM(k) do { if (IN(k) && IN((k) + 1)) { XcdBarrier b2; b2.bar = (unsigned*)(fresh_args()->ws + WS_CTL) + CW_BAR; b2.x = xb_xcc_id(); b2.st = MISC + 8; xcd_barrier(b2); } } while (0)
    bf16 *H, *Zb, *GT, *U; float* X;
#define FRESH() do { Ap = fresh_args(); F.tid = fresh_tid(); F.lane = F.tid & 63; F.wave = __builtin_amdgcn_readfirstlane(F.tid >> 6); \
    { int bx_ = blockIdx.x, G_ = gridDim.x; asm volatile("" : "+s"(bx_), "+s"(G_)); F.bx = bx_; F.G = G_; F.vcu = (G_ % 8 == 0) ? (bx_ % 8) * (G_ / 8) + bx_ / 8 : bx_; F.gw = F.vcu * 8 + F.wave; F.NGW = G_ * 8; } \
    { unsigned lb_ = 0; asm volatile("" : "+s"(lb_)); F.lds = lds0 + lb_; } \
    F.ws = Ap->ws; F.out = Ap->out; ws = F.ws; H = (bf16*)(ws + WS_R3); Zb = (bf16*)(ws + WS_R1); GT = (bf16*)(ws + WS_GATES); U = (bf16*)(ws + WS_R1); X = F.out + OUT_Y; } while (0)
    ArgsP Ap; unsigned char* ws;
    constexpr size_t WSET = (l & 1) ? WS_WSET1 : 0, WSET_NEXT = (l & 1) ? 0 : WS_WSET1;
        const int pb = NPH * l;
        if (IN(pb + 0)) { FRESH(); phase_pre(F, Ap, l); } SEAM(pb + 0);
        if (IN(pb + 1)) {
            FRESH(); ArgsP A = Ap;
            pg8::Gemm g{H, (const bf16*)(ws + WSET + WS_WIN), M, NIN, DM, DM, DM}; pg8::StaticOrder S; S.init(M, NIN, DM, F.G, F.bx, 4);
            pg8::EpiIn E{Zb, GT, A->in[I_BGATE] + (size_t)l * NGATE, F.lds + EPI_OFF};
            pg8::gemm_phase(F.lds, g, S, E);
            if (l + 1 < DEPTH) { const int nlast = ((M / 256) * (NIN / 256)) % F.G;
                if (nlast != 0 && F.bx >= nlast) pre_weights(F, Ap, l + 1, ws + WSET_NEXT, (F.bx - nlast) * 8 + F.wave, (F.G - nlast) * 8, 0, WCUT1); }
        } SEAM(pb + 1);
        if (IN(pb + 2)) { FRESH(); phase_post_in(F, Ap, l); } SEAM(pb + 2);
        if (IN(pb + 3)) {
            FRESH();
#pragma unroll 1
            for (int gi = 0; gi < 2; ++gi) {
                const bf16* Ain = (const bf16*)(ws + (gi == 0 ? WS_CQ : WS_CKV)); const bf16* Bt = (const bf16*)(ws + WSET + (gi == 0 ? WS_WQB : WS_WKVB));
                const int Mg = gi == 0 ? M : M2, Ng = gi == 0 ? 1536 : 2048, Kg = gi == 0 ? 512 : 256;
                pg8::Gemm g{Ain, Bt, Mg, Ng, Kg, Kg, Kg}; pg8::StaticOrder S; S.init(Mg, Ng, Kg, F.G, gi == 0 ? F.bx : (F.bx + F.G / 2) % F.G);
                pg8::EpiPlain E{(bf16*)(ws + (gi == 0 ? WS_R2 : WS_R1)), Ng, F.lds + EPI_OFF}; pg8::gemm_phase(F.lds, g, S, E);
            }
        } SEAM(pb + 3);
        if (IN(pb + 4)) { FRESH(); phase_post_b(F, Ap, l); } SEAM(pb + 4);
        if (IN(pb + 5)) { FRESH(); phase_attn(F, Ap, l); } SEAM(pb + 5);
        if (IN(pb + 6)) { FRESH(); phase_post_a(F, Ap, l); } SEAM(pb + 6);
        if (IN(pb + 7)) {
            FRESH();
            pg8::Gemm g{(const bf16*)(ws + WS_OALL), (const bf16*)(ws + WSET + WS_WBR), M, DM, DM, DM, DM}; pg8::StaticOrder S; S.init(M, DM, DM, F.G, F.bx, 4);
            pg8::EpiMerge E{GT, H, F.lds + EPI_OFF}; pg8::gemm_phase(F.lds, g, S, E);
            if (l + 1 < DEPTH) { const int nlast = ((M / 256) * (DM / 256)) % F.G;
                if (nlast != 0 && F.bx >= nlast) pre_caches(F, Ap, l + 1, (F.bx - nlast) * 8 + F.wave, (F.G - nlast) * 8); else if (nlast == 0) pre_caches(F, Ap, l + 1, F.gw, F.NGW); }
        } SEAM(pb + 7);
        if (IN(pb + 8)) {
            FRESH();
            { pg8::Gemm g{H, (const bf16*)(ws + WSET + WS_WO), M, DM, DM, DM, DM}; pg8::CombinedOrder S; S.init(MP, DM, DM, NS_O, F.G, F.bx);
              pg8::EpiResidSplit E{X, (float*)(ws + WS_SLAB_O), MP / 256, DM / NS_O, F.lds + EPI_OFF}; pg8::gemm_phase(F.lds, g, S, E); }
        } SEAM(pb + 8);
        if (IN(pb + 9)) { FRESH(); rmsnorm_rows(F, Ap, Ap->in[I_MNORM] + (size_t)l * DM, H, false, (const float*)(ws + WS_SLAB_O), NS_O); } SEAM(pb + 9);
        if (IN(pb + 10)) {
            FRESH();
            pg8::Gemm g{H, (const bf16*)(ws + WSET + WS_WUP), M, DFF, DM, DM, DM}; pg8::StaticOrder S; S.init(M, DFF, DM, F.G, F.bx, 4);
            pg8::EpiUp E{U, F.lds + EPI_OFF}; pg8::gemm_phase(F.lds, g, S, E);
            if (l + 1 < DEPTH) { const int nlast = ((M / 256) * (DFF / 256)) % F.G;
                if (nlast != 0 && F.bx >= nlast) pre_weights(F, Ap, l + 1, ws + WSET_NEXT, (F.bx - nlast) * 8 + F.wave, (F.G - nlast) * 8, WCUT1, WCUT2); }
        } SEAM(pb + 10);
        if (IN(pb + 11)) {
            FRESH();
            { pg8::Gemm g{U, (const bf16*)(ws + WSET + WS_WDN), M, DM, DFF, DFF, DFF}; pg8::CombinedOrder S; S.init(MP, DM, DFF, NS_DN, F.G, F.bx);
              pg8::EpiResidSplit E{X, (float*)(ws + WS_SLAB_DN), MP / 256, DFF / NS_DN, F.lds + EPI_OFF}; pg8::gemm_phase(F.lds, g, S, E); }
            if (l + 1 < DEPTH) { const int n1 = ((M / 256) * (NIN / 256)) % F.G, n2 = ((M / 256) * (DFF / 256)) % F.G;
                pre_weights(F, Ap, l + 1, ws + WSET_NEXT, F.gw, F.NGW, n1 != 0 ? (n2 != 0 ? WCUT2 : WCUT1) : 0, 1 << 30); }
        } SEAM(pb + 11);
    #undef IN
#undef SEAM
#undef FRESH
}

__global__ void __launch_bounds__(512, 2) fwd(Args args) {
    extern __shared__ __attribute__((aligned(16))) unsigned char lds_raw[];
    Frame F;
    F.lds = (LAS unsigned char*)lds_raw;
    F.tid = threadIdx.x; F.lane = F.tid & 63; F.wave = __builtin_amdgcn_readfirstlane(F.tid >> 6);
    F.G = gridDim.x; { const int bx = blockIdx.x; F.vcu = (F.G % 8 == 0) ? (bx % 8) * (F.G / 8) + bx / 8 : bx; }
    F.gw = F.vcu * 8 + F.wave; F.NGW = F.G * 8;
    F.out = args.out; F.ws = args.ws;
    unsigned char* ws = args.ws;
    volatile LAS unsigned* MISC = (volatile LAS unsigned*)(F.lds + MISC_OFF);
    for (int u = F.tid; u < (LDS_BYTES - LDSCTL_OFF) / 4; u += 512) ((LAS unsigned*)(F.lds + LDSCTL_OFF))[u] = 0u;
    __syncthreads();
    XcdBarrier bar; bar.bar = (unsigned*)(ws + WS_CTL) + CW_BAR; bar.x = 0; bar.st = nullptr;
    if (args.use_bar) bar = xcd_barrier_post((unsigned*)(ws + WS_CTL) + CW_BAR, MISC + 8);
    const int lo = args.ph_lo, hi = args.ph_hi;
    layer_body<0>(F, (LAS unsigned char*)lds_raw, MISC, lo, hi);
    layer_body<1>(F, (LAS unsigned char*)lds_raw, MISC, lo, hi);
    layer_body<2>(F, (LAS unsigned char*)lds_raw, MISC, lo, hi);
    layer_body<3>(F, (LAS unsigned char*)lds_raw, MISC, lo, hi);
    if (lo <= NPH * DEPTH && NPH * DEPTH < hi) {
        ArgsP Ap = fresh_args(); F.tid = fresh_tid(); F.lane = F.tid & 63; F.ws = Ap->ws; F.out = Ap->out;
        final_combine(F, (const float*)(F.ws + WS_SLAB_DN), NS_DN);
    }
}

extern "C" void kernel_launch(void* const* d_in, const int* in_sizes, int n_in, void* d_out, int out_size, void* d_ws, size_t ws_size, hipStream_t stream) {
    static int grid = 0;
    if (grid == 0) {
        if (n_in != 31 || (size_t)out_size != OUT_END || ws_size < WS_END) { fprintf(stderr, "kernel_launch: shape mismatch (n_in %d, out %d, ws %zu)\n", n_in, out_size, ws_size); grid = -1; return; }
        int dev = 0, cus = 0;
        if (hipGetDevice(&dev) != hipSuccess || hipDeviceGetAttribute(&cus, hipDeviceAttributeMultiprocessorCount, dev) != hipSuccess) { grid = -1; return; }
        if (hipFuncSetAttribute((const void*)fwd, hipFuncAttributeMaxDynamicSharedMemorySize, LDS_BYTES) != hipSuccess) { fprintf(stderr, "kernel_launch: hipFuncSetAttribute failed\n"); grid = -1; return; }
        int per_cu = 0;
        if (hipOccupancyMaxActiveBlocksPerMultiprocessor(&per_cu, (const void*)fwd, 512, LDS_BYTES) != hipSuccess || per_cu < 1) fprintf(stderr, "kernel_launch: occupancy query reports %d\n", per_cu);
        (void)hipGetLastError();
        grid = cus;
    }
    if (grid < 0) return;
    (void)hipMemsetAsync((char*)d_ws + WS_CTL, 0, CTL_ZERO_BYTES, stream);
    Args a{};
    for (int i = 0; i < 31; ++i) a.in[i] = (const float*)d_in[i];
    a.out = (float*)d_out; a.ws = (unsigned char*)d_ws; a.pad = 0;
#if MK_SPLIT
    for (int p = 0; p < NPHASES; ++p) { a.ph_lo = p; a.ph_hi = p + 1; a.use_bar = 0; hipLaunchKernelGGL(fwd, dim3(grid), dim3(512), LDS_BYTES, stream, a); }
#else
    a.ph_lo = 0; a.ph_hi = NPHASES; a.use_bar = 1; hipLaunchKernelGGL(fwd, dim3(grid), dim3(512), LDS_BYTES, stream, a);
#endif
}
```

```cpp
#include <hip/hip_runtime.h>
#include <cstdio>
#include <cstdint>
#include <cmath>

#ifndef MK_SPLIT
#define MK_SPLIT 0
#endif

#define GAS __attribute__((address_space(1)))
#define LAS __attribute__((address_space(3)))
typedef unsigned short bf16;
typedef short bf16x8 __attribute__((ext_vector_type(8)));
typedef short s16x4 __attribute__((ext_vector_type(4)));
typedef float f32x4 __attribute__((ext_vector_type(4)));
typedef float f32x16 __attribute__((ext_vector_type(16)));
typedef unsigned u32x4 __attribute__((ext_vector_type(4)));
typedef unsigned u32x2 __attribute__((ext_vector_type(2)));

constexpr int DM = 2048, SEQ = 16384, NBATCH = 2, DEPTH = 4, DECB = 16, DECS = 16, PAST = 2048;
constexpr int MP = NBATCH * SEQ, MS = DECB * DECS, M = MP + MS;
constexpr int SROWS = 2176, CROWS = 640, CPAST = 512;
constexpr int M2 = MP + DECB * SROWS;
constexpr int MC = MP + DECB * CROWS;
constexpr int NIN = 10240, NZ = 4096, NGATE = 6144, DFF = 8192, INCOLS = 10048;
constexpr float EPS = 1e-6f;
static_assert(M % 256 == 0 && M2 % 256 == 0, "row counts are whole 256-row panels");

constexpr size_t OUT_Y = 0;
constexpr size_t OUT_AK_P = OUT_Y + (size_t)M * DM;
constexpr size_t OUT_AV_P = OUT_AK_P + (size_t)DEPTH * MP * 512;
constexpr size_t OUT_BC_P = OUT_AV_P + (size_t)DEPTH * MP * 512;
constexpr size_t OUT_BP_P = OUT_BC_P + (size_t)DEPTH * MP * 256;
constexpr size_t OUT_CK_P = OUT_BP_P + (size_t)DEPTH * MP * 64;
constexpr size_t OUT_CV_P = OUT_CK_P + (size_t)DEPTH * NBATCH * 512 * 512;
constexpr size_t OUT_AK_S = OUT_CV_P + (size_t)DEPTH * NBATCH * 512 * 512;
constexpr size_t OUT_AV_S = OUT_AK_S + (size_t)DEPTH * MS * 512;
constexpr size_t OUT_BC_S = OUT_AV_S + (size_t)DEPTH * MS * 512;
constexpr size_t OUT_BP_S = OUT_BC_S + (size_t)DEPTH * MS * 256;
constexpr size_t OUT_CK_S = OUT_BP_S + (size_t)DEPTH * MS * 64;
constexpr size_t OUT_CV_S = OUT_CK_S + (size_t)DEPTH * MS * 512;
constexpr size_t OUT_END = OUT_CV_S + (size_t)DEPTH * MS * 512;
static_assert(OUT_END == 250413056ull, "output size");

constexpr size_t MiB = 1u << 20;
constexpr size_t WS_CTL = 0, CTL_ZERO_BYTES = 1 * MiB;
constexpr size_t WS_WIN = 1 * MiB;
constexpr size_t WS_WQB = 41 * MiB;
constexpr size_t WS_WKVB = 43 * MiB;
constexpr size_t WS_WBR = 44 * MiB;
constexpr size_t WS_WO = 52 * MiB;
constexpr size_t WS_WUP = 60 * MiB;
constexpr size_t WS_WDN = 92 * MiB;
constexpr size_t WS_R3 = 124 * MiB;
constexpr size_t WS_R1 = 322 * MiB;
constexpr size_t WS_GATES = 586 * MiB;
constexpr size_t WS_QA = 973 * MiB;
constexpr size_t WS_KA = 1006 * MiB;
constexpr size_t WS_VA = 1072 * MiB;
constexpr size_t WS_CQ = 1138 * MiB;
constexpr size_t WS_CKV = 1171 * MiB;
constexpr size_t WS_KPE = 1204 * MiB;
constexpr size_t WS_QC = 1221 * MiB;
constexpr size_t WS_KC = 1254 * MiB;
constexpr size_t WS_VC = 1296 * MiB;
constexpr size_t WS_R2 = 1338 * MiB;
constexpr size_t WS_OALL = 1596 * MiB;
constexpr size_t WS_QB = 1727 * MiB;
constexpr size_t WS_END = 1824 * MiB;
static_assert(WS_WIN + (size_t)NIN * DM * 2 <= WS_WQB && WS_WDN + (size_t)DM * DFF * 2 <= WS_R3, "weights");
static_assert(WS_R3 + (size_t)M2 * 1536 * 2 <= WS_R1 && WS_R1 + (size_t)M2 * 2048 * 2 <= WS_GATES && WS_GATES + (size_t)M * NGATE * 2 <= WS_QA, "R3/R1/gates");
static_assert(WS_R1 + (size_t)M * DFF * 2 <= WS_QA, "u overlay");
static_assert(WS_QA + (size_t)M * 512 * 2 <= WS_KA && WS_KA + (size_t)M2 * 512 * 2 <= WS_VA && WS_VA + (size_t)M2 * 512 * 2 <= WS_CQ, "A");
static_assert(WS_CQ + (size_t)M * 512 * 2 <= WS_CKV && WS_CKV + (size_t)M2 * 256 * 2 <= WS_KPE && WS_KPE + (size_t)M2 * 64 * 4 <= WS_QC, "B");
static_assert(WS_QC + (size_t)M * 512 * 2 <= WS_KC && WS_KC + (size_t)MC * 512 * 2 <= WS_VC && WS_VC + (size_t)MC * 512 * 2 <= WS_R2, "C");
static_assert(WS_R2 + (size_t)M * 2048 * 4 <= WS_OALL && WS_OALL + (size_t)M * 2048 * 2 <= WS_QB && WS_QB + (size_t)M * 1536 * 2 <= WS_END, "tail");

constexpr int CW_BAR = 4096;

constexpr int RING_BYTES = 131072;
constexpr int LDSCTL_OFF = RING_BYTES, MISC_OFF = LDSCTL_OFF + 320;
constexpr int LDS_BYTES = 155648;
constexpr int EPI_OFF = RING_BYTES + 8192;
static_assert(EPI_OFF + 8 * 2048 <= LDS_BYTES, "epilogue staging");

#define LDS_WAIT() asm volatile("s_waitcnt lgkmcnt(0)" ::: "memory")
#define VM_WAIT() asm volatile("s_waitcnt vmcnt(0)" ::: "memory")
#define SBAR() __builtin_amdgcn_sched_barrier(0)
__device__ __forceinline__ int fresh_tid() { int t = threadIdx.x; asm volatile("" : "+v"(t)); return t; }
__device__ __forceinline__ unsigned cvtpk(float lo, float hi) { unsigned r; asm volatile("v_cvt_pk_bf16_f32 %0, %1, %2" : "=v"(r) : "v"(lo), "v"(hi)); return r; }
__device__ __forceinline__ float bf_lo(unsigned u) { return __uint_as_float(u << 16); }
__device__ __forceinline__ float bf_hi(unsigned u) { return __uint_as_float(u & 0xffff0000u); }
__device__ __forceinline__ void unpack8(u32x4 w, float (&v)[8]) { v[0] = bf_lo(w.x); v[1] = bf_hi(w.x); v[2] = bf_lo(w.y); v[3] = bf_hi(w.y); v[4] = bf_lo(w.z); v[5] = bf_hi(w.z); v[6] = bf_lo(w.w); v[7] = bf_hi(w.w); }
__device__ __forceinline__ u32x4 pack8(const float (&v)[8]) { u32x4 w; w.x = cvtpk(v[0], v[1]); w.y = cvtpk(v[2], v[3]); w.z = cvtpk(v[4], v[5]); w.w = cvtpk(v[6], v[7]); return w; }
__device__ __forceinline__ void ld8bf(const bf16* p, float (&v)[8]) { unpack8(*(const u32x4*)p, v); }
__device__ __forceinline__ void ld8f(const float* p, float (&v)[8]) { const f32x4 a = *(const f32x4*)p, b = *(const f32x4*)(p + 4); v[0] = a.x; v[1] = a.y; v[2] = a.z; v[3] = a.w; v[4] = b.x; v[5] = b.y; v[6] = b.z; v[7] = b.w; }
__device__ __forceinline__ void st8f(float* p, const float (&v)[8]) { *(f32x4*)p = (f32x4){v[0], v[1], v[2], v[3]}; *(f32x4*)(p + 4) = (f32x4){v[4], v[5], v[6], v[7]}; }
__device__ __forceinline__ void st8f_nt(float* p, const float (&v)[8]) { __builtin_nontemporal_store((f32x4){v[0], v[1], v[2], v[3]}, (f32x4*)p); __builtin_nontemporal_store((f32x4){v[4], v[5], v[6], v[7]}, (f32x4*)(p + 4)); }
__device__ __forceinline__ float wave_sum(float v) {
#pragma unroll
    for (int o = 1; o < 64; o <<= 1) v += __shfl_xor(v, o);
    return v;
}
__device__ __forceinline__ float sumsq8(const float (&v)[8]) { float s = 0.f;
#pragma unroll
    for (int e = 0; e < 8; ++e) s += v[e] * v[e];
    return s; }

#define XB_TMO      128
#define XB_XCNT(j)  (256  + 64 * (j))
#define XB_XSUB(j)  (1280 + 64 * (j))
#define XB_XGEN(j)  (2304 + 64 * (j))
#define XB_TOP      3328
#define XB_TOPGEN   3392
#define XCD_BAR_WORDS 3456
#define XB_SPIN_CAP (1u << 18)
__device__ __forceinline__ unsigned xb_ld(unsigned* p)              { return __hip_atomic_load(p, __ATOMIC_RELAXED, __HIP_MEMORY_SCOPE_AGENT); }
__device__ __forceinline__ unsigned xb_add(unsigned* p, unsigned v) { return __hip_atomic_fetch_add(p, v, __ATOMIC_RELAXED, __HIP_MEMORY_SCOPE_AGENT); }
__device__ __forceinline__ unsigned xb_xcc_id() { return (unsigned)__builtin_amdgcn_s_getreg((3 << 11) | 20) & 0xFu; }
#define XB_SPIN(cond, bar) do { unsigned _sp = 0; while (cond) { __builtin_amdgcn_s_sleep(1); \
    if ((++_sp & 255u) == 0u) { if (xb_ld(&(bar)[XB_TMO])) break; if (_sp > XB_SPIN_CAP) { atomicAdd(&(bar)[XB_TMO], 1u); break; } } } } while (0)
struct XcdBarrier { unsigned* bar; unsigned x; volatile LAS unsigned* st; };
__device__ __forceinline__ XcdBarrier xcd_barrier_post(unsigned* bar, volatile LAS unsigned* st) {
    XcdBarrier b; b.bar = bar; b.x = xb_xcc_id(); b.st = st;
    if (threadIdx.x == 0) (void)xb_add(&bar[XB_XCNT(b.x)], 1u);
    return b;
}
__device__ __forceinline__ void xcd_barrier_complete(unsigned* bar, unsigned x, unsigned& nloc, unsigned& nx) {
    const unsigned G = gridDim.x * gridDim.y * gridDim.z;
    unsigned sum, cnt, mine, sp = 0u;
    for (;;) {
        sum = 0u; cnt = 0u; mine = 0u;
#pragma unroll
        for (unsigned j = 0; j < 16; ++j) { const unsigned c = xb_ld(&bar[XB_XCNT(j)]); sum += c; cnt += (c > 0u) ? 1u : 0u; mine = (j == x) ? c : mine; }
        if (sum == G) break;
        __builtin_amdgcn_s_sleep(1);
        if ((++sp & 255u) == 0u) { if (xb_ld(&bar[XB_TMO])) break; if (sp > XB_SPIN_CAP) { atomicAdd(&bar[XB_TMO], 1u); break; } }
    }
    nloc = mine > 0u ? mine : 1u; nx = cnt > 0u ? cnt : 1u;
}
__device__ __forceinline__ void xcd_barrier(const XcdBarrier& b) {
    asm volatile("s_waitcnt vmcnt(0)" ::: "memory");
    __syncthreads();
    if (threadIdx.x == 0) {
        unsigned* bar = b.bar;
        __builtin_amdgcn_s_waitcnt(0);
        unsigned nloc = b.st[0], nx = b.st[1];
        if (nloc == 0u) { xcd_barrier_complete(bar, b.x, nloc, nx); b.st[0] = nloc; b.st[1] = nx; }
        const unsigned old = xb_add(&bar[XB_XSUB(b.x)], 1u);
        const unsigned gen = old / nloc;
        if (old + 1u == (gen + 1u) * nloc) {
            __builtin_amdgcn_fence(__ATOMIC_RELEASE, "agent");
            asm volatile("s_waitcnt vmcnt(0)" ::: "memory");
            const unsigned og = xb_add(&bar[XB_TOP], 1u);
            const unsigned tg = og / nx;
            if (og + 1u == (tg + 1u) * nx) xb_add(&bar[XB_TOPGEN], 1u);
            else XB_SPIN(xb_ld(&bar[XB_TOPGEN]) == tg, bar);
            __builtin_amdgcn_fence(__ATOMIC_ACQUIRE, "agent");
            xb_add(&bar[XB_XGEN(b.x)], 1u);
            asm volatile("s_waitcnt vmcnt(0)" ::: "memory");
        } else {
            XB_SPIN(xb_ld(&bar[XB_XGEN(b.x)]) == gen, bar);
            __builtin_amdgcn_fence(__ATOMIC_ACQUIRE, "agent");
            asm volatile("s_waitcnt vmcnt(0)" ::: "memory");
        }
    }
    __syncthreads();
}

namespace pg8 {
constexpr int BM = 256, BK = 64, HALF = 128, HTB = HALF * BK * 2, NXCD = 8, WGM = 8;
__host__ __device__ __forceinline__ int lds_byte(int r, int c) { return r * 128 + ((((c >> 3) ^ ((r >> 1) & 7))) << 4) + (c & 7) * 2; }
__host__ __device__ __forceinline__ void stage_rc(int b, int& R, int& C) { R = b >> 7; const int slot = (b & 127) >> 4; C = (slot ^ ((R >> 1) & 7)) * 8; }
__host__ __device__ __forceinline__ int perm32(int rho) { const int n = rho >> 4, i = rho & 15; return 8 * (i >> 2) + 4 * n + (i & 3); }
struct Unit { int pm, pn, koff, nt; };
struct Gemm { const bf16* A; const bf16* Bt; int M, N, K, lda, ldb; };
struct StaticOrder {
    int nM, nN, nwg, G, c, nt, wgm;
    __device__ void init(int M_, int N_, int K_, int G_, int c_, int wgm_ = WGM) { nM = M_ / BM; nN = N_ / BM; nwg = nM * nN; G = G_; c = c_; nt = K_ / BK; wgm = wgm_; }
    __device__ bool next(int i, Unit& u) const {
        const long L = (long)i * G + c; if (L >= nwg) return false;
        int wgid = (int)L; { const int q = nwg / NXCD, r = nwg % NXCD, xcd = wgid % NXCD, off = wgid / NXCD; wgid = (xcd < r ? xcd * (q + 1) : r * (q + 1) + (xcd - r) * q) + off; }
        const int nig = wgm * nN, gid = wgid / nig, fm = gid * wgm, gsz = (nM - fm) < wgm ? (nM - fm) : wgm;
        u.pm = fm + ((wgid % nig) % gsz); u.pn = (wgid % nig) / gsz; u.koff = 0; u.nt = nt; return true;
    }
};
struct CombinedOrder {
    StaticOrder S0; int pmS, nN, np, KS;
    __device__ void init(int Mmain, int N_, int K_, int NS_, int G_, int c_) { S0.init(Mmain, N_, K_, G_, c_, 4); pmS = Mmain / BM; nN = N_ / BM; np = nN * NS_; KS = K_ / NS_; }
    __device__ bool next(int i, Unit& u) const { const long L = (long)i * S0.G + S0.c; if (L < S0.nwg) return S0.next(i, u);
        const int p = (int)(L - S0.nwg); if (p >= np) return false; u.pm = pmS; u.pn = p % nN; u.koff = (p / nN) * KS; u.nt = KS / BK; return true; }
};
template <class Epi, class Order>
__device__ __forceinline__ void gemm_phase(LAS unsigned char* lds, const Gemm g, const Order& S, const Epi& E) {
    const int tid = fresh_tid(), wid = __builtin_amdgcn_readfirstlane(tid >> 6), lane = tid & 63, wr = wid >> 2, wc = wid & 3, fr = lane & 15, fq = lane >> 4;
    unsigned voffA[2], voffB[2];
#pragma unroll
    for (int i = 0; i < 2; ++i) { int R, C; stage_rc(tid * 16 + i * 8192, R, C); const int Rb = 64 * (R >> 5) + perm32(R & 31);
        voffA[i] = (unsigned)(R * g.lda + C) * 2u; voffB[i] = (unsigned)(Rb * g.ldb + C) * 2u; }
    const size_t kstep = (size_t)(BK * 2);
    const size_t hstepA = (size_t)HALF * g.lda * 2, hstepB = (size_t)32 * g.ldb * 2;
    const size_t tstepA = 2 * hstepA, tstepB = (size_t)BM * g.ldb * 2;
    const unsigned ldsw = (unsigned)wid * 1024u;
    const int aoff = lds_byte(wr * 64 + fr, fq * 8), boff = lds_byte(wc * 32 + fr, fq * 8), aoff1 = aoff ^ 64, boff1 = boff ^ 64;
#define PG8_SA(b, h) (((b) * 2 + (h)) * HTB)
#define PG8_SB(b, h) ((4 + (b) * 2 + (h)) * HTB)
#define PG8_STAGE(bufoff, gbase, voff) do { _Pragma("unroll") for (int _i = 0; _i < 2; ++_i) \
        __builtin_amdgcn_global_load_lds((const unsigned*)((const char*)(gbase) + (voff)[_i]), (LAS unsigned*)(lds + (bufoff) + ldsw + _i * 8192), 16, 0, 0); } while (0)
#define PG8_LDA(dst, b, h) do { _Pragma("unroll") for (int m = 0; m < 4; ++m) _Pragma("unroll") for (int k = 0; k < 2; ++k) dst[m][k] = *(const LAS bf16x8*)(lds + PG8_SA(b, h) + (k ? aoff1 : aoff) + m * 2048); } while (0)
#define PG8_LDB(dst, b, h) do { _Pragma("unroll") for (int n = 0; n < 2; ++n) _Pragma("unroll") for (int k = 0; k < 2; ++k) dst[n][k] = *(const LAS bf16x8*)(lds + PG8_SB(b, h) + (k ? boff1 : boff) + n * 2048); } while (0)
#define PG8_MMA(ai, bj, At, Bt) do { __builtin_amdgcn_s_setprio(1); _Pragma("unroll") for (int m = 0; m < 4; ++m) _Pragma("unroll") for (int n = 0; n < 2; ++n) _Pragma("unroll") for (int k = 0; k < 2; ++k) \
        acc[ai][bj][m][n] = __builtin_amdgcn_mfma_f32_16x16x32_bf16(Bt[n][k], At[m][k], acc[ai][bj][m][n], 0, 0, 0); __builtin_amdgcn_s_setprio(0); } while (0)
#define PG8_WAIT_V(n) asm volatile("s_waitcnt vmcnt(" #n ")" ::: "memory")
#define PG8_WAIT_L(n) asm volatile("s_waitcnt lgkmcnt(" #n ")" ::: "memory")
#define PG8_BAR __builtin_amdgcn_s_barrier()
#define PG8_SCHED __builtin_amdgcn_sched_barrier(0)
    Unit cur, nxt; int ui = 0;
    if (!S.next(0, cur)) return;
    f32x4 acc[2][2][4][2];
#pragma unroll
    for (int a = 0; a < 2; ++a)
#pragma unroll
        for (int b = 0; b < 2; ++b)
#pragma unroll
            for (int m = 0; m < 4; ++m)
#pragma unroll
                for (int n = 0; n < 2; ++n) acc[a][b][m][n] = (f32x4){0.f, 0.f, 0.f, 0.f};
    bf16x8 At[4][2], B0[2][2], B1[2][2];
    const char* cA = (const char*)g.A + (size_t)cur.pm * tstepA + (size_t)cur.koff * 2; const char* cB = (const char*)g.Bt + (size_t)cur.pn * tstepB + (size_t)cur.koff * 2;
    PG8_STAGE(PG8_SB(0, 0), cB, voffB); PG8_STAGE(PG8_SB(0, 1), cB + hstepB, voffB); PG8_STAGE(PG8_SA(0, 0), cA, voffA); PG8_STAGE(PG8_SA(0, 1), cA + hstepA, voffA);
    if (wr == 1) PG8_BAR;
    PG8_WAIT_V(2); PG8_BAR;
    PG8_STAGE(PG8_SB(1, 0), cB + kstep, voffB); PG8_STAGE(PG8_SA(1, 0), cA + kstep, voffA); PG8_STAGE(PG8_SB(1, 1), cB + hstepB + kstep, voffB);
    PG8_WAIT_V(6); PG8_BAR;
    for (;;) {
        const bool has_next = S.next(ui + 1, nxt);
        const char* nA = has_next ? (const char*)g.A + (size_t)nxt.pm * tstepA + (size_t)nxt.koff * 2 : cA; const char* nB = has_next ? (const char*)g.Bt + (size_t)nxt.pn * tstepB + (size_t)nxt.koff * 2 : cB;
        const int nt = cur.nt;
        for (int t = 0; t < nt; t += 2) {
            if constexpr (Epi::HOOK) { if (t == 8 || t == 24) E.mid(acc, cur, wr, wc, fr, fq, t); }
            const bool last = (t == nt - 2);
            const char* a1 = cA + (size_t)(t + 1) * kstep;
            const char* a2 = last ? nA : cA + (size_t)(t + 2) * kstep; const char* b2 = last ? nB : cB + (size_t)(t + 2) * kstep;
            const char* a3 = a2 + kstep; const char* b3 = b2 + kstep;
            PG8_LDB(B0, 0, 0); PG8_LDB(B1, 0, 1); PG8_SCHED; PG8_LDA(At, 0, 0); PG8_STAGE(PG8_SA(1, 1), a1 + hstepA, voffA);
            PG8_WAIT_V(8); PG8_WAIT_L(0); PG8_BAR; PG8_MMA(0, 0, At, B0); PG8_MMA(0, 1, At, B1); PG8_BAR; PG8_SCHED;
            PG8_LDA(At, 0, 1); PG8_STAGE(PG8_SB(0, 0), b2, voffB); PG8_STAGE(PG8_SB(0, 1), b2 + hstepB, voffB); PG8_STAGE(PG8_SA(0, 0), a2, voffA);
            PG8_WAIT_V(8); PG8_WAIT_L(0); PG8_BAR; PG8_MMA(1, 0, At, B0); PG8_MMA(1, 1, At, B1); PG8_BAR; PG8_SCHED;
            PG8_LDB(B0, 1, 0); PG8_LDB(B1, 1, 1); PG8_SCHED; PG8_LDA(At, 1, 0); PG8_STAGE(PG8_SA(0, 1), a2 + hstepA, voffA);
            PG8_WAIT_V(8); PG8_WAIT_L(0); PG8_BAR; PG8_MMA(0, 0, At, B0); PG8_MMA(0, 1, At, B1); PG8_BAR; PG8_SCHED;
            PG8_LDA(At, 1, 1); PG8_STAGE(PG8_SB(1, 0), b3, voffB); PG8_STAGE(PG8_SB(1, 1), b3 + hstepB, voffB); PG8_STAGE(PG8_SA(1, 0), a3, voffA);
            PG8_WAIT_V(8); PG8_WAIT_L(0); PG8_BAR; PG8_MMA(1, 0, At, B0); PG8_MMA(1, 1, At, B1); PG8_BAR; PG8_SCHED;
        }
        if (wr == 0) PG8_BAR;
        E(acc, cur, wr, wc, fr, fq);
        if (!has_next) break;
#pragma unroll
        for (int a = 0; a < 2; ++a)
#pragma unroll
            for (int b = 0; b < 2; ++b)
#pragma unroll
                for (int m = 0; m < 4; ++m)
#pragma unroll
                    for (int n = 0; n < 2; ++n) acc[a][b][m][n] = (f32x4){0.f, 0.f, 0.f, 0.f};
        cur = nxt; cA = nA; cB = nB; ++ui;
        if (wr == 1) PG8_BAR;
    }
    PG8_WAIT_V(0);
    PG8_BAR;
#undef PG8_SA
#undef PG8_SB
#undef PG8_STAGE
#undef PG8_LDA
#undef PG8_LDB
#undef PG8_MMA
#undef PG8_WAIT_V
#undef PG8_WAIT_L
#undef PG8_BAR
#undef PG8_SCHED
}

#define EPI_LOOP_BEGIN const int row0 = u.pm * BM + wr * 64 + fr, col0 = u.pn * BM + wc * 64 + 8 * fq; \
    _Pragma("unroll") for (int ai = 0; ai < 2; ++ai) _Pragma("unroll") for (int m = 0; m < 4; ++m) { const size_t row = (size_t)(row0 + ai * HALF + m * 16); \
    _Pragma("unroll") for (int bj = 0; bj < 2; ++bj) { const int col = col0 + bj * 32; f32x4 v0 = acc[ai][bj][m][0], v1 = acc[ai][bj][m][1];
#define EPI_LOOP_END } }
__device__ __forceinline__ u32x4 pk8(f32x4 v0, f32x4 v1) { u32x4 w; w.x = cvtpk(v0[0], v0[1]); w.y = cvtpk(v0[2], v0[3]); w.z = cvtpk(v1[0], v1[1]); w.w = cvtpk(v1[2], v1[3]); return w; }
__device__ __forceinline__ float sigm(float v) { return __builtin_amdgcn_rcpf(1.f + __builtin_amdgcn_exp2f(-1.4426950408889634f * v)); }

template <bool NT> __device__ __forceinline__ void st_lines(LAS unsigned char* scr, u32x4 w0, u32x4 w1, bf16* tile, size_t ldc, int fr, int fq) {
    const int lane = fq * 16 + fr, rr = lane >> 3, c = lane & 7;
    *(LAS u32x4*)(scr + fr * 128 + ((fq ^ (fr & 7)) << 4)) = w0;
    *(LAS u32x4*)(scr + fr * 128 + (((4 + fq) ^ (fr & 7)) << 4)) = w1;
    const u32x4 a = *(const LAS u32x4*)(scr + rr * 128 + ((c ^ rr) << 4)), b = *(const LAS u32x4*)(scr + (8 + rr) * 128 + ((c ^ rr) << 4));
    bf16* d = tile + (size_t)rr * ldc + c * 8;
    if constexpr (NT) { __builtin_nontemporal_store(a, (u32x4*)d); __builtin_nontemporal_store(b, (u32x4*)(d + 8 * ldc)); }
    else { *(u32x4*)d = a; *(u32x4*)(d + 8 * ldc) = b; }
}
__device__ __forceinline__ void sl_xpose(LAS unsigned char* scr, u32x4 w0, u32x4 w1, int fr, int fq, u32x4& a, u32x4& b) {
    const int lane = fq * 16 + fr, rr = lane >> 3, c = lane & 7;
    *(LAS u32x4*)(scr + fr * 128 + ((fq ^ (fr & 7)) << 4)) = w0;
    *(LAS u32x4*)(scr + fr * 128 + (((4 + fq) ^ (fr & 7)) << 4)) = w1;
    a = *(const LAS u32x4*)(scr + rr * 128 + ((c ^ rr) << 4)); b = *(const LAS u32x4*)(scr + (8 + rr) * 128 + ((c ^ rr) << 4));
}
template <bool NT> __device__ __forceinline__ void sl_store(u32x4 a, u32x4 b, bf16* tile, size_t ldc, int fr, int fq) {
    const int lane = fq * 16 + fr, rr = lane >> 3, c = lane & 7;
    bf16* d = tile + (size_t)rr * ldc + c * 8;
    if constexpr (NT) { __builtin_nontemporal_store(a, (u32x4*)d); __builtin_nontemporal_store(b, (u32x4*)(d + 8 * ldc)); }
    else { *(u32x4*)d = a; *(u32x4*)(d + 8 * ldc) = b; }
}
struct EpiIn {
    static constexpr bool HOOK = false;
    bf16* Z; bf16* G; const float* bg; LAS unsigned char* scr;
    __device__ __forceinline__ void operator()(const f32x4 (&acc)[2][2][4][2], const Unit& u, int wr, int wc, int fr, int fq) const {
        const bool isg = u.pn * BM >= NZ;
        const int colw = u.pn * BM + wc * 64 - (isg ? NZ : 0);
        bf16* base = (isg ? G : Z) + (size_t)(u.pm * BM + wr * 64) * (isg ? NGATE : NZ) + colw; const size_t ldc = isg ? NGATE : NZ;
        LAS unsigned char* sw = scr + (wr * 4 + wc) * 2048;
        f32x4 b00, b01, b10, b11;
        if (isg) { const float* bp = bg + colw + 8 * fq; b00 = *(const f32x4*)bp; b01 = *(const f32x4*)(bp + 4); b10 = *(const f32x4*)(bp + 32); b11 = *(const f32x4*)(bp + 36); }
#pragma unroll
        for (int ai = 0; ai < 2; ++ai) { u32x4 ra[4], rb[4];
#pragma unroll
            for (int m = 0; m < 4; ++m) {
                f32x4 v0 = acc[ai][0][m][0], v1 = acc[ai][0][m][1], v2 = acc[ai][1][m][0], v3 = acc[ai][1][m][1];
                if (isg) { v0 += b00; v1 += b01; v2 += b10; v3 += b11;
#pragma unroll
                    for (int e = 0; e < 4; ++e) { v0[e] = sigm(v0[e]); v1[e] = sigm(v1[e]); v2[e] = sigm(v2[e]); v3[e] = sigm(v3[e]); } }
                sl_xpose(sw, pk8(v0, v1), pk8(v2, v3), fr, fq, ra[m], rb[m]); }
#pragma unroll
            for (int m = 0; m < 4; ++m) sl_store<true>(ra[m], rb[m], base + (size_t)(ai * HALF + m * 16) * ldc, ldc, fr, fq); }
    }
};
struct EpiPlain {
    static constexpr bool HOOK = false;
    bf16* O; int ldc; LAS unsigned char* scr;
    __device__ __forceinline__ void operator()(const f32x4 (&acc)[2][2][4][2], const Unit& u, int wr, int wc, int fr, int fq) const {
        bf16* base = O + (size_t)(u.pm * BM + wr * 64) * ldc + u.pn * BM + wc * 64; LAS unsigned char* sw = scr + (wr * 4 + wc) * 2048;
#pragma unroll
        for (int ai = 0; ai < 2; ++ai) { u32x4 ra[4], rb[4];
#pragma unroll
            for (int m = 0; m < 4; ++m) sl_xpose(sw, pk8(acc[ai][0][m][0], acc[ai][0][m][1]), pk8(acc[ai][1][m][0], acc[ai][1][m][1]), fr, fq, ra[m], rb[m]);
#pragma unroll
            for (int m = 0; m < 4; ++m) sl_store<false>(ra[m], rb[m], base + (size_t)(ai * HALF + m * 16) * ldc, (size_t)ldc, fr, fq); }
    }
};
struct EpiMerge {
    static constexpr bool HOOK = true;
    const bf16* G; bf16* Ob; LAS unsigned char* scr;
    __device__ __forceinline__ void mid(f32x4 (&acc)[2][2][4][2], const Unit& u, int wr, int wc, int fr, int fq, int t) const {
        const __amdgpu_buffer_rsrc_t rs = __builtin_amdgcn_make_buffer_rsrc((void*)G, 0, (int)((size_t)M * NGATE * 2), 0x00020000);
        const int gx = (t == 8) ? 0 : DM;
        const int voff = ((u.pm * BM + wr * 64 + fr) * NGATE + u.pn * BM + wc * 64 + 8 * fq + gx) * 2;
#pragma unroll
        for (int ai = 0; ai < 2; ++ai) {
            u32x4 wa[4][2], wb[4][2];
#pragma unroll
            for (int m = 0; m < 4; ++m)
#pragma unroll
                for (int bj = 0; bj < 2; ++bj) { const int so = ((ai * HALF + m * 16) * NGATE + bj * 32) * 2;
                    wa[m][bj] = __builtin_amdgcn_raw_buffer_load_b128(rs, voff, so, 0); wb[m][bj] = __builtin_amdgcn_raw_buffer_load_b128(rs, voff, so + DM * 2, 0); }
#pragma unroll
            for (int m = 0; m < 4; ++m)
#pragma unroll
                for (int bj = 0; bj < 2; ++bj) {
                    float a[8], b[8]; unpack8(wa[m][bj], a); unpack8(wb[m][bj], b);
#pragma unroll
                    for (int e = 0; e < 8; ++e) a[e] = a[e] * __builtin_amdgcn_rcpf(fmaxf(b[e], 1e-30f));
                    f32x4& v0 = acc[ai][bj][m][0]; f32x4& v1 = acc[ai][bj][m][1];
                    v0[0] *= a[0]; v0[1] *= a[1]; v0[2] *= a[2]; v0[3] *= a[3]; v1[0] *= a[4]; v1[1] *= a[5]; v1[2] *= a[6]; v1[3] *= a[7]; }
            SBAR(); }
    }
    __device__ __forceinline__ void operator()(const f32x4 (&acc)[2][2][4][2], const Unit& u, int wr, int wc, int fr, int fq) const {
        bf16* base = Ob + (size_t)(u.pm * BM + wr * 64) * DM + u.pn * BM + wc * 64; LAS unsigned char* sw = scr + (wr * 4 + wc) * 2048;
        const bf16* gb = G + (size_t)(u.pm * BM + wr * 64 + fr) * NGATE + 2 * DM + u.pn * BM + wc * 64 + 8 * fq;
        u32x4 gq[2][4][2];
#pragma unroll
        for (int ai = 0; ai < 2; ++ai)
#pragma unroll
            for (int m = 0; m < 4; ++m) { const bf16* gp = gb + (size_t)(ai * HALF + m * 16) * NGATE; gq[ai][m][0] = *(const u32x4*)gp; gq[ai][m][1] = *(const u32x4*)(gp + 32); }
#pragma unroll
        for (int ai = 0; ai < 2; ++ai) { u32x4 ra[4], rb[4];
#pragma unroll
            for (int m = 0; m < 4; ++m) {
                float g0[8], g1[8]; unpack8(gq[ai][m][0], g0); unpack8(gq[ai][m][1], g1);
                f32x4 v0 = acc[ai][0][m][0], v1 = acc[ai][0][m][1], v2 = acc[ai][1][m][0], v3 = acc[ai][1][m][1];
                v0[0] *= g0[0]; v0[1] *= g0[1]; v0[2] *= g0[2]; v0[3] *= g0[3]; v1[0] *= g0[4]; v1[1] *= g0[5]; v1[2] *= g0[6]; v1[3] *= g0[7];
                v2[0] *= g1[0]; v2[1] *= g1[1]; v2[2] *= g1[2]; v2[3] *= g1[3]; v3[0] *= g1[4]; v3[1] *= g1[5]; v3[2] *= g1[6]; v3[3] *= g1[7];
                sl_xpose(sw, pk8(v0, v1), pk8(v2, v3), fr, fq, ra[m], rb[m]); }
#pragma unroll
            for (int m = 0; m < 4; ++m) sl_store<false>(ra[m], rb[m], base + (size_t)(ai * HALF + m * 16) * DM, (size_t)DM, fr, fq); }
    }
};
struct EpiResidSplit {
    static constexpr bool HOOK = false;
    float* X; float* P; int pmS, KS; LAS unsigned char* scr;
    __device__ __forceinline__ void operator()(const f32x4 (&acc)[2][2][4][2], const Unit& u, int wr, int wc, int fr, int fq) const {
        const bool piece = u.pm >= pmS;
        float* base = (piece ? P + (size_t)(u.koff / KS) * (MS * DM) - (size_t)u.pm * BM * DM : X) + (size_t)(u.pm * BM + wr * 64) * DM + u.pn * BM + wc * 64;
        LAS unsigned char* sw = scr + (wr * 4 + wc) * 2048;
        const int lane = fq * 16 + fr, rr = lane >> 3, c = lane & 7;
        float* drow = base + (size_t)rr * DM + c * 4;
#define RS_OFF(st) ((size_t)((((st) >> 3) & 1) * HALF + (((st) >> 1) & 3) * 16) * DM + ((st) & 1) * 32)
        f32x4 xa[2][4], xb[2][4];
        if (!piece) {
#pragma unroll
            for (int q = 0; q < 4; ++q) { const float* d = drow + RS_OFF(q); xa[0][q] = *(const f32x4*)d; xb[0][q] = *(const f32x4*)(d + 8 * DM); } }
#pragma unroll
        for (int bt = 0; bt < 4; ++bt) {
            if (!piece && bt < 3) {
#pragma unroll
                for (int q = 0; q < 4; ++q) { const float* d = drow + RS_OFF(4 * (bt + 1) + q); xa[(bt + 1) & 1][q] = *(const f32x4*)d; xb[(bt + 1) & 1][q] = *(const f32x4*)(d + 8 * DM); } }
            f32x4 ta[4], tb[4];
#pragma unroll
            for (int q = 0; q < 4; ++q) { const int st = 4 * bt + q, ai = (st >> 3) & 1, m = (st >> 1) & 3, bj = st & 1;
                *(LAS f32x4*)(sw + fr * 128 + (((2 * fq) ^ (fr & 7)) << 4)) = acc[ai][bj][m][0];
                *(LAS f32x4*)(sw + fr * 128 + (((2 * fq + 1) ^ (fr & 7)) << 4)) = acc[ai][bj][m][1];
                ta[q] = *(const LAS f32x4*)(sw + rr * 128 + ((c ^ rr) << 4)); tb[q] = *(const LAS f32x4*)(sw + (8 + rr) * 128 + ((c ^ rr) << 4)); }
#pragma unroll
            for (int q = 0; q < 4; ++q) { const int st = 4 * bt + q;
                f32x4 a = ta[q], b = tb[q];
                float* d = drow + RS_OFF(st);
                if (!piece) { a += xa[bt & 1][q]; b += xb[bt & 1][q]; }
                *(f32x4*)d = a; *(f32x4*)(d + 8 * DM) = b; }
        }
#undef RS_OFF
    }
};
struct EpiUp {
    static constexpr bool HOOK = false;
    bf16* U; LAS unsigned char* scr;
    __device__ __forceinline__ void operator()(const f32x4 (&acc)[2][2][4][2], const Unit& u, int wr, int wc, int fr, int fq) const {
        bf16* base = U + (size_t)(u.pm * BM + wr * 64) * DFF + u.pn * BM + wc * 64; LAS unsigned char* sw = scr + (wr * 4 + wc) * 2048;
#pragma unroll
        for (int ai = 0; ai < 2; ++ai) { u32x4 ra[4], rb[4];
#pragma unroll
            for (int m = 0; m < 4; ++m) {
                f32x4 v0 = acc[ai][0][m][0], v1 = acc[ai][0][m][1], v2 = acc[ai][1][m][0], v3 = acc[ai][1][m][1];
#pragma unroll
                for (int e = 0; e < 4; ++e) { const float a = fmaxf(v0[e], 0.f), b = fmaxf(v1[e], 0.f), c = fmaxf(v2[e], 0.f), d = fmaxf(v3[e], 0.f); v0[e] = a * a; v1[e] = b * b; v2[e] = c * c; v3[e] = d * d; }
                sl_xpose(sw, pk8(v0, v1), pk8(v2, v3), fr, fq, ra[m], rb[m]); }
#pragma unroll
            for (int m = 0; m < 4; ++m) sl_store<true>(ra[m], rb[m], base + (size_t)(ai * HALF + m * 16) * DFF, (size_t)DFF, fr, fq); }
    }
};
}

namespace att {
__device__ __forceinline__ int crow(int r, int hi) { return (r & 3) + 8 * (r >> 2) + 4 * hi; }
__device__ __forceinline__ int v_st(int k, int c) { const int kk = (k & ~0xC) | ((k & 4) << 1) | ((k & 8) >> 1); return ((kk >> 3) * 4 + (c >> 5)) * 512 + ((kk & 7) * 32 + (c & 31)) * 2; }
__device__ __forceinline__ int v_rd_base(int lane) { return ((lane & 3) << 3) | (((lane >> 2) & 3) << 6) | (((lane >> 4) & 1) << 5) | (((lane >> 5) & 1) << 8); }
constexpr int v_rd_off(int d0, int ks, int half) { return d0 * 512 + ks * 4096 + half * 2048; }
template <int OFF> __device__ __forceinline__ s16x4 tr_read(unsigned vb) {
    s16x4 r; asm volatile("ds_read_b64_tr_b16 %0, %1 offset:%2" : "=&v"(r) : "v"(vb), "i"(OFF) : "memory"); return r;
}
template <int DQK> struct Cn {
    static constexpr float SCALE = DQK == 64 ? 0.125f : (DQK == 128 ? 0.08838834764831845f : 0.07216878364870323f);
    static constexpr float C = SCALE * 1.4426950408889634f;
    static constexpr float THRR = 8.f / SCALE;
};
template <int DQK> __device__ __forceinline__ int kswz(int row) { return (DQK == 128 ? (row & 15) : ((row >> 1) & 7)) << 4; }
template <int DQK>
__device__ __forceinline__ void qkt_h(f32x16& p, const f32x16& cinit, const LAS char* Ks, int rowbase, const bf16x8* qr, int r32, int hi) {
    constexpr int KRB = DQK * 2;
    p = cinit;
    const int sw = kswz<DQK>(r32);
#pragma unroll
    for (int d0 = 0; d0 < DQK / 16; ++d0) { const int cb = (d0 * 2 + hi) * 16;
        const bf16x8 b = *(const LAS bf16x8*)(Ks + (rowbase + r32) * KRB + (cb ^ sw));
        p = __builtin_amdgcn_mfma_f32_32x32x16_bf16(b, qr[d0], p, 0, 0, 0); }
}
template <int DQK>
__device__ __forceinline__ void smx_h(f32x16& p, float negB, float& l_acc, bf16x8& paA, bf16x8& paB) {
#pragma unroll
    for (int r = 0; r < 16; ++r) p[r] = __builtin_amdgcn_exp2f(p[r]);
    float s0 = (p[0] + p[1]) + (p[2] + p[3]), s1 = (p[4] + p[5]) + (p[6] + p[7]), s2 = (p[8] + p[9]) + (p[10] + p[11]), s3 = (p[12] + p[13]) + (p[14] + p[15]);
    l_acc += (s0 + s1) + (s2 + s3);
#define PK4(P, BASE, OUT) do { unsigned a0 = cvtpk(P[BASE + 0], P[BASE + 1]), a1 = cvtpk(P[BASE + 2], P[BASE + 3]);   \
    unsigned b0 = cvtpk(P[BASE + 4], P[BASE + 5]), b1 = cvtpk(P[BASE + 6], P[BASE + 7]);                              \
    auto r0 = __builtin_amdgcn_permlane32_swap(a0, b0, false, false); auto r1 = __builtin_amdgcn_permlane32_swap(a1, b1, false, false); \
    u32x4 w = {r0[0], r1[0], r0[1], r1[1]}; OUT = __builtin_bit_cast(bf16x8, w); } while (0)
    PK4(p, 0, paA); PK4(p, 8, paB);
#undef PK4
}
template <int D0, int KS0> __device__ __forceinline__ void pv_half_one(f32x16& od, unsigned vb, bf16x8 paA, bf16x8 paB) {
    s16x4 l0 = tr_read<v_rd_off(D0, KS0, 0)>(vb), h0 = tr_read<v_rd_off(D0, KS0, 1)>(vb), l1 = tr_read<v_rd_off(D0, KS0 + 1, 0)>(vb), h1 = tr_read<v_rd_off(D0, KS0 + 1, 1)>(vb);
    asm volatile("s_waitcnt lgkmcnt(0)" : "+v"(l0), "+v"(h0), "+v"(l1), "+v"(h1) :: "memory");
#define PK(L, H) (bf16x8){L[0], L[1], L[2], L[3], H[0], H[1], H[2], H[3]}
    od = __builtin_amdgcn_mfma_f32_32x32x16_bf16(paA, PK(l0, h0), od, 0, 0, 0);
    od = __builtin_amdgcn_mfma_f32_32x32x16_bf16(paB, PK(l1, h1), od, 0, 0, 0);
#undef PK
}
template <int KS0> __device__ __forceinline__ void pv_half(f32x16* o, unsigned vb, bf16x8 paA, bf16x8 paB) {
#define TR4(D0) s16x4 l0_##D0 = tr_read<v_rd_off(D0, KS0, 0)>(vb), h0_##D0 = tr_read<v_rd_off(D0, KS0, 1)>(vb), l1_##D0 = tr_read<v_rd_off(D0, KS0 + 1, 0)>(vb), h1_##D0 = tr_read<v_rd_off(D0, KS0 + 1, 1)>(vb)
    TR4(0); TR4(1); TR4(2); TR4(3);
#undef TR4
    asm volatile("s_waitcnt lgkmcnt(0)" : "+v"(l0_0), "+v"(h0_0), "+v"(l1_0), "+v"(h1_0), "+v"(l0_1), "+v"(h0_1), "+v"(l1_1), "+v"(h1_1),
                                          "+v"(l0_2), "+v"(h0_2), "+v"(l1_2), "+v"(h1_2), "+v"(l0_3), "+v"(h0_3), "+v"(l1_3), "+v"(h1_3) :: "memory");
#define PK(L, H) (bf16x8){L[0], L[1], L[2], L[3], H[0], H[1], H[2], H[3]}
#define MM(D0) o[D0] = __builtin_amdgcn_mfma_f32_32x32x16_bf16(paA, PK(l0_##D0, h0_##D0), o[D0], 0, 0, 0); o[D0] = __builtin_amdgcn_mfma_f32_32x32x16_bf16(paB, PK(l1_##D0, h1_##D0), o[D0], 0, 0, 0)
    MM(0); MM(1); MM(2); MM(3);
#undef MM
#undef PK
}
struct VFrag { s16x4 l0[4], h0[4], l1[4], h1[4]; };
template <int KS0> __device__ __forceinline__ void pv_issue(VFrag& f, unsigned vb) {
    f.l0[0] = tr_read<v_rd_off(0, KS0, 0)>(vb); f.h0[0] = tr_read<v_rd_off(0, KS0, 1)>(vb); f.l1[0] = tr_read<v_rd_off(0, KS0 + 1, 0)>(vb); f.h1[0] = tr_read<v_rd_off(0, KS0 + 1, 1)>(vb);
    f.l0[1] = tr_read<v_rd_off(1, KS0, 0)>(vb); f.h0[1] = tr_read<v_rd_off(1, KS0, 1)>(vb); f.l1[1] = tr_read<v_rd_off(1, KS0 + 1, 0)>(vb); f.h1[1] = tr_read<v_rd_off(1, KS0 + 1, 1)>(vb);
    f.l0[2] = tr_read<v_rd_off(2, KS0, 0)>(vb); f.h0[2] = tr_read<v_rd_off(2, KS0, 1)>(vb); f.l1[2] = tr_read<v_rd_off(2, KS0 + 1, 0)>(vb); f.h1[2] = tr_read<v_rd_off(2, KS0 + 1, 1)>(vb);
    f.l0[3] = tr_read<v_rd_off(3, KS0, 0)>(vb); f.h0[3] = tr_read<v_rd_off(3, KS0, 1)>(vb); f.l1[3] = tr_read<v_rd_off(3, KS0 + 1, 0)>(vb); f.h1[3] = tr_read<v_rd_off(3, KS0 + 1, 1)>(vb);
}
__device__ __forceinline__ void pv_wait(VFrag& f) {
    asm volatile("s_waitcnt lgkmcnt(0)" : "+v"(f.l0[0]), "+v"(f.h0[0]), "+v"(f.l1[0]), "+v"(f.h1[0]), "+v"(f.l0[1]), "+v"(f.h0[1]), "+v"(f.l1[1]), "+v"(f.h1[1]),
                                          "+v"(f.l0[2]), "+v"(f.h0[2]), "+v"(f.l1[2]), "+v"(f.h1[2]), "+v"(f.l0[3]), "+v"(f.h0[3]), "+v"(f.l1[3]), "+v"(f.h1[3]) :: "memory");
}
__device__ __forceinline__ void pv_mma(f32x16* o, const VFrag& f, bf16x8 paA, bf16x8 paB) {
#define PK(L, H) (bf16x8){L[0], L[1], L[2], L[3], H[0], H[1], H[2], H[3]}
#pragma unroll
    for (int d = 0; d < 4; ++d) { o[d] = __builtin_amdgcn_mfma_f32_32x32x16_bf16(paA, PK(f.l0[d], f.h0[d]), o[d], 0, 0, 0); o[d] = __builtin_amdgcn_mfma_f32_32x32x16_bf16(paB, PK(f.l1[d], f.h1[d]), o[d], 0, 0, 0); }
#undef PK
}
struct UnitP {
    const bf16* Q; int ldq; int nq;
    const bf16* K; int ldk; const bf16* V; int ldv;
    void* O; int ldo;
    int NT;
    int kvalid;
    int lo_base, lo_step, hi_base, hi_step;
    int qpos0, kpos0; const float* tab;
    float negB;
    int fix_lo, fix_hi;
};
constexpr int LDS_ATT_V = 0, LDS_ATT_K = 49152, LDS_ATT_WS = RING_BYTES + 1024, LDS_ATT_TAB = LDS_ATT_WS + 2048, LDS_ATT_END = LDS_ATT_TAB + 1088;
static_assert(LDS_ATT_K + 3 * 24576 <= RING_BYTES && LDS_ATT_WS >= MISC_OFF + 128 && LDS_ATT_END <= EPI_OFF, "attention LDS");

template <int DQK, bool F32OUT, bool BIAS, bool PIPE2>
__device__ __forceinline__ void attn_unit(const UnitP& P, LAS char* lds) {
    constexpr int NQ = DQK / 16, KRB = DQK * 2, KCH = DQK / 8, KP = DQK / 64;
    constexpr int SHM_V = 16384, SHM_K = 64 * DQK * 2;
    constexpr float NEGINF = -__builtin_huge_valf();
    const int tid = fresh_tid(), wid = __builtin_amdgcn_readfirstlane(tid >> 6), lane = tid & 63, r32 = lane & 31, hi = lane >> 5;
    LAS char* V_lds = lds + LDS_ATT_V; LAS char* K_lds = lds + LDS_ATT_K;
    LAS float* ws = (LAS float*)(lds + LDS_ATT_WS) + wid * 64; LAS float* li_l = ws; LAS float* al_l = ws + 32;
    LAS float* tblS = (LAS float*)(lds + LDS_ATT_TAB);
    const int NT = P.NT, kvalid = P.kvalid;
    int lo_w = P.lo_base + P.lo_step * (wid >> 1); lo_w = lo_w < 0 ? 0 : lo_w;
    const int hi_w = P.hi_base + P.hi_step * (wid >> 1);
    float l_reg = 0.f; const float negB = P.negB; f32x16 o[4] = {}; bf16x8 qr[NQ];
    { int qrow = wid * 32 + r32; qrow = qrow < P.nq ? qrow : P.nq - 1;
      const bf16* Qw = P.Q + (size_t)qrow * P.ldq + hi * 8;
#pragma unroll
      for (int d0 = 0; d0 < NQ; ++d0) qr[d0] = *(const bf16x8*)(Qw + d0 * 16); }
    unsigned voffV[2], voffK[KP];
#pragma unroll
    for (int i = 0; i < 2; ++i) { const int b_ = (tid + 512 * i) * 16, st = b_ >> 9, kk = (st >> 2) * 8 + ((b_ & 511) >> 6), c = (st & 3) * 32 + ((b_ & 63) >> 1), k = (kk & ~0xC) | ((kk & 4) << 1) | ((kk & 8) >> 1);
        voffV[i] = (unsigned)(k * P.ldv + c) * 2u; }
#pragma unroll
    for (int p = 0; p < KP; ++p) { const int G = tid + 512 * p, row = G / KCH, slot = G % KCH, g = slot ^ (kswz<DQK>(row) >> 4); voffK[p] = (unsigned)(row * P.ldk + g * 8) * 2u; }
    const unsigned vb0 = (unsigned)(uintptr_t)V_lds + (unsigned)v_rd_base(lane);
    const bf16* Kh = P.K; const bf16* Vh = P.V; const int ldk = P.ldk, ldv = P.ldv;
#define DMA(b, k0) do { const char* vsrc_ = (const char*)(Vh + (size_t)(k0) * ldv); const char* ksrc_ = (const char*)(Kh + (size_t)(k0) * ldk); \
    _Pragma("unroll") for (int i = 0; i < 2; ++i) __builtin_amdgcn_global_load_lds((const unsigned*)(vsrc_ + voffV[i]), (LAS unsigned*)(V_lds + (b) * SHM_V + wid * 1024 + i * 8192), 16, 0, 0); \
    _Pragma("unroll") for (int p = 0; p < KP; ++p) __builtin_amdgcn_global_load_lds((const unsigned*)(ksrc_ + voffK[p]), (LAS unsigned*)(K_lds + (b) * SHM_K + wid * 1024 + p * 8192), 16, 0, 0); } while (0)
#define FIXUP(p0, p1, jt) do { \
    if ((jt) < P.fix_lo || (jt) >= P.fix_hi) { int kv_ = kvalid, lo_ = lo_w, hi_ = hi_w; asm volatile("; masked-tile path" : "+s"(kv_), "+s"(lo_), "+s"(hi_) :: "memory");     \
      if ((jt) < lo_ || (jt) > hi_) { _Pragma("unroll") for (int r = 0; r < 16; ++r) { p0[r] = NEGINF; p1[r] = NEGINF; } } \
      else if (((jt) + 1) * 64 > kv_) { _Pragma("unroll") for (int r = 0; r < 16; ++r) { const int key = (jt) * 64 + crow(r, hi); if (key >= kv_) p0[r] = NEGINF; if (key + 32 >= kv_) p1[r] = NEGINF; } } } \
    if constexpr (BIAS) { if ((jt) >= lo_w && (jt) <= hi_w) { const int kb_ = P.kpos0 + (jt) * 64, qw_ = P.qpos0 + wid * 32; \
        if (qw_ - (kb_ + 63) >= 128) { const float c_ = tblS[256]; _Pragma("unroll") for (int r = 0; r < 16; ++r) { p0[r] += c_; p1[r] += c_; } } \
        else { const int dq_ = qw_ + r32 - kb_; _Pragma("unroll") for (int r = 0; r < 16; ++r) { int d0_ = dq_ - crow(r, hi), d1_ = d0_ - 32; \
            d0_ = d0_ < -128 ? -128 : (d0_ > 128 ? 128 : d0_); d1_ = d1_ < -128 ? -128 : (d1_ > 128 ? 128 : d1_); p0[r] += tblS[d0_ + 128]; p1[r] += tblS[d1_ + 128]; } } } } \
    } while (0)
    f32x16 pA0, pA1; bf16x8 pa0, pa1, pa2, pa3;
    DMA(0, 0); if (1 < NT) DMA(1, 64);
    if constexpr (BIAS) { if (tid < 257) tblS[tid] = P.tab[tid] * 1.4426950408889634f; }
    if (1 < NT) { if constexpr (KP == 1) asm volatile("s_waitcnt vmcnt(3)" ::: "memory"); else if constexpr (KP == 2) asm volatile("s_waitcnt vmcnt(4)" ::: "memory"); else asm volatile("s_waitcnt vmcnt(5)" ::: "memory"); }
    else asm volatile("s_waitcnt vmcnt(0)" ::: "memory");
    asm volatile("s_waitcnt lgkmcnt(0)\n\ts_barrier" ::: "memory");
    if constexpr (!PIPE2) {
#define FIXUP_H(p, jt, kofs) do { \
    if ((jt) < P.fix_lo || (jt) >= P.fix_hi) { int kv_ = kvalid, lo_ = lo_w, hi_ = hi_w; asm volatile("; masked-tile path" : "+s"(kv_), "+s"(lo_), "+s"(hi_) :: "memory"); \
      if ((jt) < lo_ || (jt) > hi_) { _Pragma("unroll") for (int r = 0; r < 16; ++r) p[r] = NEGINF; } \
      else if (((jt) + 1) * 64 > kv_) { _Pragma("unroll") for (int r = 0; r < 16; ++r) { if ((jt) * 64 + (kofs) + crow(r, hi) >= kv_) p[r] = NEGINF; } } } \
    if constexpr (BIAS) { if ((jt) >= lo_w && (jt) <= hi_w) { const int kb_ = P.kpos0 + (jt) * 64 + (kofs), qw_ = P.qpos0 + wid * 32; \
        if (qw_ - (kb_ + 31) >= 128) { const float c_ = tblS[256]; _Pragma("unroll") for (int r = 0; r < 16; ++r) p[r] += c_; } \
        else { const int dq_ = qw_ + r32 - kb_; _Pragma("unroll") for (int r = 0; r < 16; ++r) { int d0_ = dq_ - crow(r, hi); d0_ = d0_ < -128 ? -128 : (d0_ > 128 ? 128 : d0_); p[r] += tblS[d0_ + 128]; } } } } \
    } while (0)
        static_assert(!PIPE2, "q is pre-scaled: only the half-tile loop is current");
        f32x16 cinit;
#pragma unroll
        for (int r = 0; r < 16; ++r) cinit[r] = negB;
        const bool wave_on = wid * 32 < P.nq;
        int bsel = 0;
        for (int j = 0; j < NT; ++j) {
            const int bn1 = bsel == 2 ? 0 : bsel + 1, bn2 = bn1 == 2 ? 0 : bn1 + 1;
            if (j + 2 < NT) DMA(bn2, (j + 2) * 64);
            if (wave_on && j >= lo_w && j <= hi_w) {
            SBAR(); qkt_h<DQK>(pA0, cinit, K_lds + bsel * SHM_K, 0, qr, r32, hi);
            FIXUP_H(pA0, j, 0);
            SBAR(); qkt_h<DQK>(pA1, cinit, K_lds + bsel * SHM_K, 32, qr, r32, hi); smx_h<DQK>(pA0, negB, l_reg, pa0, pa1);
            FIXUP_H(pA1, j, 32);
            if constexpr (true) {
                VFrag f0, f2; SBAR(); pv_issue<0>(f0, vb0 + bsel * SHM_V); pv_wait(f0); pv_issue<2>(f2, vb0 + bsel * SHM_V);
                pv_mma(o, f0, pa0, pa1); smx_h<DQK>(pA1, negB, l_reg, pa2, pa3);
                SBAR(); pv_wait(f2); pv_mma(o, f2, pa2, pa3); SBAR();
            } else {
            SBAR(); pv_half<0>(o, vb0 + bsel * SHM_V, pa0, pa1); smx_h<DQK>(pA1, negB, l_reg, pa2, pa3);
            SBAR(); pv_half<2>(o, vb0 + bsel * SHM_V, pa2, pa3); SBAR();
            }
            }
            if (j + 2 < NT) { if constexpr (KP == 1) asm volatile("s_waitcnt vmcnt(3) lgkmcnt(0)\n\ts_barrier" ::: "memory"); else if constexpr (KP == 2) asm volatile("s_waitcnt vmcnt(4) lgkmcnt(0)\n\ts_barrier" ::: "memory"); else asm volatile("s_waitcnt vmcnt(5) lgkmcnt(0)\n\ts_barrier" ::: "memory"); }
            else asm volatile("s_waitcnt vmcnt(0) lgkmcnt(0)\n\ts_barrier" ::: "memory");
            bsel = bn1;
        }
#undef FIXUP_H
    }
    { auto rr = __builtin_amdgcn_permlane32_swap(__float_as_uint(l_reg), __float_as_uint(l_reg), false, false); l_reg = __uint_as_float(rr[0]) + __uint_as_float(rr[1]); }
    if (hi == 0) li_l[r32] = l_reg; asm volatile("s_waitcnt lgkmcnt(0)" ::: "memory");
    float rli[16];
#pragma unroll
    for (int r = 0; r < 16; ++r) rli[r] = __builtin_amdgcn_rcpf(li_l[crow(r, hi)]);
    const int nq = P.nq, ldo = P.ldo;
#pragma unroll
    for (int r = 0; r < 16; ++r) { const int orow = wid * 32 + crow(r, hi);
        if (orow < nq) {
            if constexpr (F32OUT) { float* Ow = (float*)P.O + (size_t)orow * ldo + r32;
#pragma unroll
                for (int d0 = 0; d0 < 4; ++d0) Ow[d0 * 32] = o[d0][r] * rli[r]; }
            else { bf16* Ow = (bf16*)P.O + (size_t)orow * ldo + r32;
#pragma unroll
                for (int d0 = 0; d0 < 4; ++d0) Ow[d0 * 32] = (bf16)(cvtpk(o[d0][r] * rli[r], 0.f) & 0xffffu); }
        } }
    __syncthreads();
#undef DMA
#undef FIXUP
}
}

template <class T> __device__ __forceinline__ T* launder(T* p) { asm volatile("" : "+s"(p)); return p; }
struct Frame {
    LAS unsigned char* lds;
    int tid, lane, wave, vcu, G, bx;
    int gw, NGW;
    float* out; unsigned char* ws;
};
struct Args { const float* in[31]; float* out; unsigned char* ws; int ph_lo, ph_hi; int use_bar, pad; };
typedef const __attribute__((address_space(4))) Args* ArgsP;
__device__ __forceinline__ ArgsP fresh_args() { ArgsP p = (ArgsP)__builtin_amdgcn_kernarg_segment_ptr(); asm volatile("" : "+s"(p)); return p; }
enum { I_XP = 0, I_XS, I_CAK, I_CAV, I_CBC, I_CBP, I_CCK, I_CCV, I_ANORM, I_WIN, I_BGATE, I_AQN, I_AKN, I_ALAM, I_ASUB, I_BQAN, I_BKVN, I_WQB, I_WKVB, I_BQN, I_BKN, I_CQN, I_CKN, I_CBIAS,
       I_WBRA, I_WBRB, I_WBRC, I_WO, I_MNORM, I_WUP, I_WDN };

__device__ __forceinline__ void transpose_item(const float* W, int K, int N, bf16* WT, int ldw, int gap_at, int gap, LAS float* scr, int item, int lane) {
    const int nblk = N / 32, kb = item / nblk, nb = item % nblk, k0 = 64 * kb, n0 = 32 * nb;
    float t[32];
#pragma unroll
    for (int i = 0; i < 32; ++i) t[i] = W[(size_t)(k0 + 2 * i + (lane >> 5)) * N + n0 + (lane & 31)];
#pragma unroll
    for (int i = 0; i < 32; ++i) scr[(2 * i + (lane >> 5)) * 33 + (lane & 31)] = t[i];
    LDS_WAIT(); asm volatile("" ::: "memory");
    const int c = lane & 7; const int roff = (n0 >= gap_at) ? gap : 0;
#pragma unroll
    for (int j = 0; j < 4; ++j) { const int n = (lane >> 3) + 8 * j; const LAS float* s = scr + (8 * c) * 33 + n;
        u32x4 o; o.x = cvtpk(s[0 * 33], s[1 * 33]); o.y = cvtpk(s[2 * 33], s[3 * 33]); o.z = cvtpk(s[4 * 33], s[5 * 33]); o.w = cvtpk(s[6 * 33], s[7 * 33]);
        *(u32x4*)(WT + (size_t)(roff + n0 + n) * ldw + k0 + 8 * c) = o; }
    LDS_WAIT(); asm volatile("" ::: "memory");
}

__device__ __forceinline__ void rmsnorm_rows(const Frame& F, ArgsP A, const float* g, bf16* H, bool first, const float* slab, int ns) {
    float* X = F.out + OUT_Y;
    if (!first) {
        LAS float* part = (LAS float*)(F.lds + EPI_OFF);
        for (int rs = F.vcu; rs < MS; rs += F.G) {
            const size_t off = (size_t)rs * DM + 256 * F.wave + 4 * F.lane;
            f32x4 v = *(const f32x4*)(X + (size_t)MP * DM + off);
            const float* sp = slab + off;
            for (int k = 0; k < ns; k += 8) { f32x4 t[8];
#pragma unroll
                for (int q = 0; q < 8; ++q) t[q] = *(const f32x4*)(sp + (size_t)(k + q) * MS * DM);
#pragma unroll
                for (int q = 0; q < 8; ++q) v += t[q]; }
            const float ps = wave_sum((v.x * v.x + v.y * v.y) + (v.z * v.z + v.w * v.w));
            __syncthreads();
            if (F.lane == 0) part[F.wave] = ps;
            __syncthreads();
            float tot = 0.f;
#pragma unroll
            for (int w = 0; w < 8; ++w) tot += part[w];
            const float rstd = rsqrtf(tot * (1.f / DM) + EPS);
            const f32x4 gg = *(const f32x4*)(g + 256 * F.wave + 4 * F.lane);
            u32x2 w; w.x = cvtpk(v.x * rstd * gg.x, v.y * rstd * gg.y); w.y = cvtpk(v.z * rstd * gg.z, v.w * rstd * gg.w);
            *(u32x2*)(H + (size_t)MP * DM + off) = w;
            *(f32x4*)(X + (size_t)MP * DM + off) = v;
        }
    }
    constexpr int RU = 4;
    const int Rn = first ? M : MP;
    f32x4 gg[8];
#pragma unroll
    for (int j = 0; j < 8; ++j) gg[j] = *(const f32x4*)(g + 4 * F.lane + 256 * j);
    for (int row0 = F.gw; row0 < Rn; row0 += RU * F.NGW) {
        f32x4 v[RU][8];
#pragma unroll
        for (int u = 0; u < RU; ++u) { const int row = row0 + u * F.NGW;
            if (row < Rn) { const float* xr = first ? (row < MP ? A->in[I_XP] + (size_t)row * DM : A->in[I_XS] + (size_t)(row - MP) * DM) : X + (size_t)row * DM;
#pragma unroll
                for (int j = 0; j < 8; ++j) v[u][j] = *(const f32x4*)(xr + 4 * F.lane + 256 * j); } }
#pragma unroll
        for (int u = 0; u < RU; ++u) { const int row = row0 + u * F.NGW;
            if (row < Rn) {
                float ss = 0.f;
#pragma unroll
                for (int j = 0; j < 8; ++j) ss += (v[u][j].x * v[u][j].x + v[u][j].y * v[u][j].y) + (v[u][j].z * v[u][j].z + v[u][j].w * v[u][j].w);
                const float rstd = rsqrtf(wave_sum(ss) * (1.f / DM) + EPS);
#pragma unroll
                for (int j = 0; j < 8; ++j) {
                    u32x2 w; w.x = cvtpk(v[u][j].x * rstd * gg[j].x, v[u][j].y * rstd * gg[j].y); w.y = cvtpk(v[u][j].z * rstd * gg[j].z, v[u][j].w * rstd * gg[j].w);
                    *(u32x2*)(H + (size_t)row * DM + 4 * F.lane + 256 * j) = w;
                    if (first) *(f32x4*)(X + (size_t)row * DM + 4 * F.lane + 256 * j) = v[u][j]; } } }
    }
}
__device__ __forceinline__ void final_combine(const Frame& F, const float* slab, int ns) {
    float* X = F.out + OUT_Y;
    for (int rs = F.vcu; rs < MS; rs += F.G) {
        const size_t off = (size_t)rs * DM + 256 * F.wave + 4 * F.lane;
        f32x4 v = *(const f32x4*)(X + (size_t)MP * DM + off);
        const float* sp = slab + off;
        for (int k = 0; k < ns; k += 8) { f32x4 t[8];
#pragma unroll
            for (int q = 0; q < 8; ++q) t[q] = *(const f32x4*)(sp + (size_t)(k + q) * MS * DM);
#pragma unroll
            for (int q = 0; q < 8; ++q) v += t[q]; }
        *(f32x4*)(X + (size_t)MP * DM + off) = v;
    }
}
__device__ __forceinline__ void pre_weights(const Frame& F, ArgsP A, int l, unsigned char* wsw, int gw, int NGW, int it_lo = 0, int it_hi = 1 << 30) {
    LAS float* scr = (LAS float*)(F.lds + F.wave * 16384);
    constexpr int I_IN = (DM / 64) * (INCOLS / 32), I_QB = (512 / 64) * (1536 / 32), I_KVB = (256 / 64) * (2048 / 32), I_BA = (512 / 64) * (DM / 32), I_BB = (1024 / 64) * (DM / 32),
                  I_O = (DM / 64) * (DM / 32), I_UP = (DM / 64) * (DFF / 32), I_DN = (DFF / 64) * (DM / 32);
    constexpr int NITEMS = I_IN + I_QB + I_KVB + 2 * I_BA + I_BB + I_O + I_UP + I_DN;
    const int it_end = it_hi < NITEMS ? it_hi : NITEMS;
    for (int it = it_lo + gw; it < it_end; it += NGW) {
        int r = it;
        if (r < I_IN) { transpose_item(A->in[I_WIN] + (size_t)l * DM * INCOLS, DM, INCOLS, (bf16*)(wsw + WS_WIN), DM, 2368, 192, scr, r, F.lane); continue; } r -= I_IN;
        if (r < I_QB) { transpose_item(A->in[I_WQB] + (size_t)l * 512 * 1536, 512, 1536, (bf16*)(wsw + WS_WQB), 512, 1 << 30, 0, scr, r, F.lane); continue; } r -= I_QB;
        if (r < I_KVB) { transpose_item(A->in[I_WKVB] + (size_t)l * 256 * 2048, 256, 2048, (bf16*)(wsw + WS_WKVB), 256, 1 << 30, 0, scr, r, F.lane); continue; } r -= I_KVB;
        if (r < I_BA) { transpose_item(A->in[I_WBRA] + (size_t)l * 512 * DM, 512, DM, (bf16*)(wsw + WS_WBR), DM, 1 << 30, 0, scr, r, F.lane); continue; } r -= I_BA;
        if (r < I_BB) { transpose_item(A->in[I_WBRB] + (size_t)l * 1024 * DM, 1024, DM, (bf16*)(wsw + WS_WBR) + 512, DM, 1 << 30, 0, scr, r, F.lane); continue; } r -= I_BB;
        if (r < I_BA) { transpose_item(A->in[I_WBRC] + (size_t)l * 512 * DM, 512, DM, (bf16*)(wsw + WS_WBR) + 1536, DM, 1 << 30, 0, scr, r, F.lane); continue; } r -= I_BA;
        if (r < I_O) { transpose_item(A->in[I_WO] + (size_t)l * DM * DM, DM, DM, (bf16*)(wsw + WS_WO), DM, 1 << 30, 0, scr, r, F.lane); continue; } r -= I_O;
        if (r < I_UP) { transpose_item(A->in[I_WUP] + (size_t)l * DM * DFF, DM, DFF, (bf16*)(wsw + WS_WUP), DM, 1 << 30, 0, scr, r, F.lane); continue; } r -= I_UP;
        transpose_item(A->in[I_WDN] + (size_t)l * DFF * DM, DFF, DM, (bf16*)(wsw + WS_WDN), DFF, 1 << 30, 0, scr, r, F.lane);
    }
    const int gt = gw * 64 + F.lane, NGT = NGW * 64;
    if (it_lo == 0) {
        bf16* wz = (bf16*)(wsw + WS_WIN) + (size_t)2368 * DM;
        for (int i = gt; i < 192 * DM / 8; i += NGT) *(u32x4*)(wz + (size_t)i * 8) = (u32x4){0u, 0u, 0u, 0u};
    }
}
__device__ __forceinline__ void pre_caches(const Frame& F, ArgsP A, int l, int gw, int NGW) {
    unsigned char* ws = F.ws; const int gt = gw * 64 + F.lane, NGT = NGW * 64;
    {
        bf16* KA = (bf16*)(ws + WS_KA); bf16* VA = (bf16*)(ws + WS_VA); bf16* CKV = (bf16*)(ws + WS_CKV); float* KPE = (float*)(ws + WS_KPE); bf16* KC = (bf16*)(ws + WS_KC); bf16* VC = (bf16*)(ws + WS_VC);
        const float* cak = A->in[I_CAK] + (size_t)l * DECB * PAST * 512; const float* cav = A->in[I_CAV] + (size_t)l * DECB * PAST * 512;
        const float* cbc = A->in[I_CBC] + (size_t)l * DECB * PAST * 256; const float* cbp = A->in[I_CBP] + (size_t)l * DECB * PAST * 64;
        const float* cck = A->in[I_CCK] + (size_t)l * DECB * CPAST * 512; const float* ccv = A->in[I_CCV] + (size_t)l * DECB * CPAST * 512;
        for (int i0 = gt; i0 < DECB * PAST * 512 / 8; i0 += 4 * NGT) { f32x4 ka[4][2], va[4][2];
#pragma unroll
            for (int u = 0; u < 4; ++u) { const int i = i0 + u * NGT; if (i < DECB * PAST * 512 / 8) { const float* pk = cak + (size_t)i * 8; const float* pv = cav + (size_t)i * 8;
                ka[u][0] = *(const f32x4*)pk; ka[u][1] = *(const f32x4*)(pk + 4); va[u][0] = *(const f32x4*)pv; va[u][1] = *(const f32x4*)(pv + 4); } }
#pragma unroll
            for (int u = 0; u < 4; ++u) { const int i = i0 + u * NGT; if (i < DECB * PAST * 512 / 8) { const int c = (i & 63) * 8, rr = i >> 6, b = rr >> 11, p = rr & 2047; const size_t d = ((size_t)MP + b * SROWS + p) * 512 + c;
                *(u32x4*)(KA + d) = pg8::pk8(ka[u][0], ka[u][1]); *(u32x4*)(VA + d) = pg8::pk8(va[u][0], va[u][1]); } } }
        for (int i0 = gt; i0 < DECB * PAST * 256 / 8; i0 += 4 * NGT) { f32x4 ka[4][2];
#pragma unroll
            for (int u = 0; u < 4; ++u) { const int i = i0 + u * NGT; if (i < DECB * PAST * 256 / 8) { const float* pk = cbc + (size_t)i * 8; ka[u][0] = *(const f32x4*)pk; ka[u][1] = *(const f32x4*)(pk + 4); } }
#pragma unroll
            for (int u = 0; u < 4; ++u) { const int i = i0 + u * NGT; if (i < DECB * PAST * 256 / 8) { const int c = (i & 31) * 8, rr = i >> 5, b = rr >> 11, p = rr & 2047; const size_t d = ((size_t)MP + b * SROWS + p) * 256 + c;
                *(u32x4*)(CKV + d) = pg8::pk8(ka[u][0], ka[u][1]); } } }
        for (int i = gt; i < DECB * PAST * 64 / 8; i += NGT) { const int c = (i & 7) * 8, rr = i >> 3, b = rr >> 11, p = rr & 2047; const size_t d = ((size_t)MP + b * SROWS + p) * 64 + c;
            float v[8]; ld8f(cbp + (size_t)i * 8, v); st8f(KPE + d, v); }
        for (int i0 = gt; i0 < DECB * CPAST * 512 / 8; i0 += 4 * NGT) { f32x4 ka[4][2], va[4][2];
#pragma unroll
            for (int u = 0; u < 4; ++u) { const int i = i0 + u * NGT; if (i < DECB * CPAST * 512 / 8) { const float* pk = cck + (size_t)i * 8; const float* pv = ccv + (size_t)i * 8;
                ka[u][0] = *(const f32x4*)pk; ka[u][1] = *(const f32x4*)(pk + 4); va[u][0] = *(const f32x4*)pv; va[u][1] = *(const f32x4*)(pv + 4); } }
#pragma unroll
            for (int u = 0; u < 4; ++u) { const int i = i0 + u * NGT; if (i < DECB * CPAST * 512 / 8) { const int c = (i & 63) * 8, rr = i >> 6, b = rr >> 9, p = rr & 511; const size_t d = ((size_t)MP + b * CROWS + p) * 512 + c;
                *(u32x4*)(KC + d) = pg8::pk8(ka[u][0], ka[u][1]); *(u32x4*)(VC + d) = pg8::pk8(va[u][0], va[u][1]); } } }
        const u32x4 z4 = (u32x4){0u, 0u, 0u, 0u};
        for (int i = gt; i < DECB * 112 * 64; i += NGT) { const int c = (i & 63) * 8, rr = i >> 6, b = rr / 112, p = rr % 112;
            const size_t d = ((size_t)MP + b * SROWS + PAST + DECS + p) * 512 + c; *(u32x4*)(KA + d) = z4; *(u32x4*)(VA + d) = z4;
            const size_t dc = ((size_t)MP + b * CROWS + CPAST + DECS + p) * 512 + c; *(u32x4*)(KC + dc) = z4; *(u32x4*)(VC + dc) = z4; }
        for (int i = gt; i < DECB * 112 * 32; i += NGT) { const int c = (i & 31) * 8, rr = i >> 5, b = rr / 112, p = rr % 112;
            const size_t d = ((size_t)MP + b * SROWS + PAST + DECS + p) * 256 + c; *(u32x4*)(CKV + d) = z4; }
        for (int i = gt; i < DECB * 112 * 16; i += NGT) { const int c = (i & 15) * 4, rr = i >> 4, b = rr / 112, p = rr % 112;
            const size_t d = ((size_t)MP + b * SROWS + PAST + DECS + p) * 64 + c; *(f32x4*)(KPE + d) = (f32x4){0.f, 0.f, 0.f, 0.f}; }
    }
}
constexpr size_t WS_SLAB_O = WS_R2, WS_SLAB_DN = WS_R2 + 64 * MiB;
constexpr int NS_O = 16, NS_DN = 32;
static_assert(NS_O % 8 == 0 && NS_DN % 8 == 0 && (size_t)NS_O * MS * DM * 4 <= 64 * MiB && (size_t)NS_DN * MS * DM * 4 <= 64 * MiB && WS_SLAB_DN + 64 * MiB <= WS_OALL, "slabs");
constexpr int WCUT1 = 13000, WCUT2 = 26500;
constexpr size_t WS_WSET1 = 1823 * MiB;
static_assert(WS_WDN + WS_WSET1 + (size_t)DM * DFF * 2 <= 2032 * MiB && WS_WIN + WS_WSET1 >= WS_END, "second weight set");
__device__ __forceinline__ void phase_pre(const Frame& F, ArgsP A, int l) {
    if (l == 0) { pre_weights(F, A, 0, F.ws, F.gw, F.NGW); pre_caches(F, A, 0, F.gw, F.NGW); }
    rmsnorm_rows(F, A, A->in[I_ANORM] + (size_t)l * DM, (bf16*)(F.ws + WS_R3), l == 0, (const float*)(F.ws + WS_SLAB_DN), NS_DN);
}

__device__ __forceinline__ float rope_inv(int lane) { return __builtin_amdgcn_exp2f(-(float)(lane & 31) * (18.931568569324174f / 32.f)); }
__device__ __forceinline__ void rope_cs(int pos, float inv, float& cs, float& sn) {
    const float a = (float)pos * inv; const float k = rintf(a * 0.15915494309189535f);
    float r = fmaf(-k, 6.28125f, a); r = fmaf(-k, 1.9353071795864769e-3f, r);
    const float rev = r * 0.15915494309189535f;
    cs = __builtin_amdgcn_cosf(rev); sn = __builtin_amdgcn_sinf(rev);
}

__device__ __forceinline__ void phase_post_in(const Frame& F, ArgsP A, int l) {
    unsigned char* ws = F.ws; const int lane = F.lane;
    const bf16* Z = (const bf16*)(ws + WS_R1);
    bf16* QA = (bf16*)(ws + WS_QA); bf16* KA = (bf16*)(ws + WS_KA); bf16* VA = (bf16*)(ws + WS_VA); bf16* CQ = (bf16*)(ws + WS_CQ); bf16* CKV = (bf16*)(ws + WS_CKV); float* KPE = (float*)(ws + WS_KPE);
    bf16* QC = (bf16*)(ws + WS_QC); bf16* KC = (bf16*)(ws + WS_KC); bf16* VC = (bf16*)(ws + WS_VC);
    const float inv = rope_inv(lane);
    float gq[8], gk[8], gqa[8], gkv[8], gcq[8], gck[8];
    ld8f(A->in[I_AQN] + l * 64 + 8 * (lane & 7), gq); ld8f(A->in[I_AKN] + l * 64 + 8 * (lane & 7), gk);
    ld8f(A->in[I_BQAN] + l * 512 + 8 * lane, gqa); ld8f(A->in[I_BKVN] + l * 256 + 8 * (lane & 31), gkv);
    ld8f(A->in[I_CQN] + l * 128 + 8 * (lane & 15), gcq); ld8f(A->in[I_CKN] + l * 128 + 8 * (lane & 15), gck);
    u32x4 zc[8], zn[8];
    if (F.gw < M) {
#pragma unroll
        for (int q = 0; q < 8; ++q) zc[q] = *(const u32x4*)(Z + (size_t)F.gw * NZ + 8 * lane + 512 * q); }
    for (int row = F.gw; row < M; row += F.NGW) {
        { const int nrow = row + F.NGW;
          if (nrow < M) {
#pragma unroll
              for (int q = 0; q < 8; ++q) zn[q] = *(const u32x4*)(Z + (size_t)nrow * NZ + 8 * lane + 512 * q); } }
        const bool samp = row >= MP; int b, t, pos;
        if (!samp) { b = row >> 14; t = row & (SEQ - 1); pos = t; } else { const int r = row - MP; b = r >> 4; t = r & 15; pos = PAST + t; }
        const size_t kvrow = samp ? (size_t)MP + b * SROWS + PAST + t : (size_t)row;
        const size_t ccrow = samp ? (size_t)MP + b * CROWS + CPAST + t : (size_t)row;
        float* o_ak = F.out + (samp ? OUT_AK_S + ((size_t)l * MS + (row - MP)) * 512 : OUT_AK_P + ((size_t)l * MP + row) * 512) + 8 * lane;
        float* o_av = F.out + (samp ? OUT_AV_S + ((size_t)l * MS + (row - MP)) * 512 : OUT_AV_P + ((size_t)l * MP + row) * 512) + 8 * lane;
        float* o_bc = F.out + (samp ? OUT_BC_S + ((size_t)l * MS + (row - MP)) * 256 : OUT_BC_P + ((size_t)l * MP + row) * 256) + 8 * (lane & 31);
        float* o_bp = F.out + (samp ? OUT_BP_S + ((size_t)l * MS + (row - MP)) * 64 : OUT_BP_P + ((size_t)l * MP + row) * 64) + 8 * (lane & 7);
        const bool cout = samp || t >= SEQ - 512;
        float* o_ck = F.out + (samp ? OUT_CK_S + ((size_t)l * MS + (row - MP)) * 512 : OUT_CK_P + (((size_t)l * NBATCH + b) * 512 + (t - (SEQ - 512))) * 512) + 8 * lane;
        float* o_cv = F.out + (samp ? OUT_CV_S + ((size_t)l * MS + (row - MP)) * 512 : OUT_CV_P + (((size_t)l * NBATCH + b) * 512 + (t - (SEQ - 512))) * 512) + 8 * lane;
        float cs, sn; rope_cs(pos, inv, cs, sn);
        float v[8], y[8];
#pragma unroll
        for (int seg = 0; seg < 2; ++seg) {
            unpack8(zc[seg], v);
            float ss = sumsq8(v); ss += __shfl_xor(ss, 1); ss += __shfl_xor(ss, 2); ss += __shfl_xor(ss, 4);
            const float rstd = rsqrtf(ss * (1.f / 64) + EPS);
#pragma unroll
            for (int e = 0; e < 8; ++e) y[e] = v[e] * rstd * (seg == 0 ? gq[e] : gk[e]);
#pragma unroll
            for (int e = 0; e < 8; ++e) { const float part = __shfl_xor(y[e], 1), c = __shfl(cs, 4 * e), s = __shfl(sn, 4 * e);
                if ((lane & 7) == 0) y[e] = y[e] * c - part * s; else if ((lane & 7) == 1) y[e] = y[e] * c + part * s; }
            if (seg == 0) { float yq[8];
#pragma unroll
                for (int e = 0; e < 8; ++e) yq[e] = y[e] * att::Cn<64>::C;
                *(u32x4*)(QA + (size_t)row * 512 + 8 * lane) = pack8(yq); }
            else { *(u32x4*)(KA + kvrow * 512 + 8 * lane) = pack8(y); st8f_nt(o_ak, y); }
        }
        { const u32x4 w = zc[2]; *(u32x4*)(VA + kvrow * 512 + 8 * lane) = w; unpack8(w, v); st8f_nt(o_av, v); }
        { unpack8(zc[3], v); const float rstd = rsqrtf(wave_sum(sumsq8(v)) * (1.f / 512) + EPS);
#pragma unroll
          for (int e = 0; e < 8; ++e) y[e] = v[e] * rstd * gqa[e];
          *(u32x4*)(CQ + (size_t)row * 512 + 8 * lane) = pack8(y); }
        { unpack8(zc[4], v);
          float ss = sumsq8(v); ss += __shfl_xor(ss, 1); ss += __shfl_xor(ss, 2); ss += __shfl_xor(ss, 4); ss += __shfl_xor(ss, 8); ss += __shfl_xor(ss, 16);
          const float rstd = rsqrtf(ss * (1.f / 256) + EPS);
          const int i = lane & 7;
#pragma unroll
          for (int e = 0; e < 8; ++e) { const float part = __shfl_xor(v[e], 4); const int fi = 8 * (i & 3) + e; const float c = __shfl(cs, fi), s = __shfl(sn, fi);
              y[e] = (lane < 32) ? v[e] * rstd * gkv[e] : ((i < 4) ? v[e] * c - part * s : v[e] * c + part * s); }
          if (lane < 32) { *(u32x4*)(CKV + kvrow * 256 + 8 * lane) = pack8(y); st8f_nt(o_bc, y); }
          else if (lane < 40) { st8f(KPE + kvrow * 64 + 8 * i, y); st8f_nt(o_bp, y); } }
#pragma unroll
        for (int seg = 0; seg < 2; ++seg) {
            unpack8(zc[5 + seg], v);
            float ss = sumsq8(v); ss += __shfl_xor(ss, 1); ss += __shfl_xor(ss, 2); ss += __shfl_xor(ss, 4); ss += __shfl_xor(ss, 8);
            const float rstd = rsqrtf(ss * (1.f / 128) + EPS);
#pragma unroll
            for (int e = 0; e < 8; ++e) y[e] = v[e] * rstd * (seg == 0 ? gcq[e] * att::Cn<128>::C : gck[e]);
            if (seg == 0) *(u32x4*)(QC + (size_t)row * 512 + 8 * lane) = pack8(y);
            else { *(u32x4*)(KC + ccrow * 512 + 8 * lane) = pack8(y); if (cout) st8f_nt(o_ck, y); }
        }
        { const u32x4 w = zc[7]; *(u32x4*)(VC + ccrow * 512 + 8 * lane) = w; if (cout) { unpack8(w, v); st8f_nt(o_cv, v); } }
#pragma unroll
        for (int q = 0; q < 8; ++q) zc[q] = zn[q];
    }
}

__device__ __forceinline__ void phase_post_b(const Frame& F, ArgsP A, int l) {
    unsigned char* ws = F.ws; const int lane = F.lane, h = lane >> 3, i = lane & 7;
    const bf16* QBR = (const bf16*)(ws + WS_R2); const bf16* KVR = (const bf16*)(ws + WS_R1); const float* KPE = (const float*)(ws + WS_KPE);
    bf16* QB = (bf16*)(ws + WS_QB); bf16* KB = (bf16*)(ws + WS_R3);
    const float inv = rope_inv(lane);
    float g0[8], g1[8], g2[8];
    ld8f(A->in[I_BQN] + l * 192 + 8 * i, g0); ld8f(A->in[I_BQN] + l * 192 + 64 + 8 * i, g1); ld8f(A->in[I_BQN] + l * 192 + 128 + 8 * i, g2);
    constexpr int RU = 4;
    for (int row0 = F.gw; row0 < M; row0 += RU * F.NGW) {
        u32x4 w0[RU], w1[RU], w2[RU];
#pragma unroll
        for (int u = 0; u < RU; ++u) { const int row = row0 + u * F.NGW;
            if (row < M) { const bf16* src = QBR + (size_t)row * 1536 + 192 * h + 8 * i; w0[u] = *(const u32x4*)src; w1[u] = *(const u32x4*)(src + 64); w2[u] = *(const u32x4*)(src + 128); } }
#pragma unroll
        for (int u = 0; u < RU; ++u) { const int row = row0 + u * F.NGW;
            if (row < M) {
                const int pos = row < MP ? (row & (SEQ - 1)) : PAST + ((row - MP) & 15);
                float cs, sn; rope_cs(pos, inv, cs, sn);
                float v0[8], v1[8], v2[8]; unpack8(w0[u], v0); unpack8(w1[u], v1); unpack8(w2[u], v2);
#pragma unroll
                for (int e = 0; e < 8; ++e) { const float part = __shfl_xor(v2[e], 4); const int fi = 8 * (i & 3) + e; const float c = __shfl(cs, fi), s = __shfl(sn, fi);
                    v2[e] = (i < 4) ? v2[e] * c - part * s : v2[e] * c + part * s; }
                float ss = sumsq8(v0) + sumsq8(v1) + sumsq8(v2); ss += __shfl_xor(ss, 1); ss += __shfl_xor(ss, 2); ss += __shfl_xor(ss, 4);
                const float rstd = rsqrtf(ss * (1.f / 192) + EPS);
#pragma unroll
                for (int e = 0; e < 8; ++e) { v0[e] *= rstd * g0[e] * att::Cn<192>::C; v1[e] *= rstd * g1[e] * att::Cn<192>::C; v2[e] *= rstd * g2[e] * att::Cn<192>::C; }
                bf16* dst = QB + (size_t)row * 1536 + 192 * h + 8 * i;
                *(u32x4*)dst = pack8(v0); *(u32x4*)(dst + 64) = pack8(v1); *(u32x4*)(dst + 128) = pack8(v2); } }
    }
    ld8f(A->in[I_BKN] + l * 192 + 8 * i, g0); ld8f(A->in[I_BKN] + l * 192 + 64 + 8 * i, g1); ld8f(A->in[I_BKN] + l * 192 + 128 + 8 * i, g2);
    for (int row0 = F.gw; row0 < M2; row0 += RU * F.NGW) {
        u32x4 w0[RU], w1[RU]; f32x4 p0[RU], p1[RU];
#pragma unroll
        for (int u = 0; u < RU; ++u) { const int row = row0 + u * F.NGW;
            if (row < M2) { const bf16* src = KVR + (size_t)row * 2048 + 256 * h + 8 * i; w0[u] = *(const u32x4*)src; w1[u] = *(const u32x4*)(src + 64);
                const float* kp = KPE + (size_t)row * 64 + 8 * i; p0[u] = *(const f32x4*)kp; p1[u] = *(const f32x4*)(kp + 4); } }
#pragma unroll
        for (int u = 0; u < RU; ++u) { const int row = row0 + u * F.NGW;
            if (row < M2) {
                float v0[8], v1[8], v2[8]; unpack8(w0[u], v0); unpack8(w1[u], v1);
                v2[0] = p0[u].x; v2[1] = p0[u].y; v2[2] = p0[u].z; v2[3] = p0[u].w; v2[4] = p1[u].x; v2[5] = p1[u].y; v2[6] = p1[u].z; v2[7] = p1[u].w;
                float ss = sumsq8(v0) + sumsq8(v1) + sumsq8(v2); ss += __shfl_xor(ss, 1); ss += __shfl_xor(ss, 2); ss += __shfl_xor(ss, 4);
                const float rstd = rsqrtf(ss * (1.f / 192) + EPS);
#pragma unroll
                for (int e = 0; e < 8; ++e) { v0[e] *= rstd * g0[e]; v1[e] *= rstd * g1[e]; v2[e] *= rstd * g2[e]; }
                bf16* dst = KB + (size_t)row * 1536 + 192 * h + 8 * i;
                *(u32x4*)dst = pack8(v0); *(u32x4*)(dst + 64) = pack8(v1); *(u32x4*)(dst + 128) = pack8(v2); } }
    }
}

__device__ __forceinline__ void phase_post_a(const Frame& F, ArgsP A, int l) {
    unsigned char* ws = F.ws; const int lane = F.lane, h = lane >> 4, i = lane & 15;
    const float* OAR = (const float*)(ws + WS_R2); bf16* OA = (bf16*)(ws + WS_OALL);
    const float* lf = A->in[I_ALAM] + l * 256;
    const float s1 = wave_sum(lf[lane] * lf[64 + lane]), s2 = wave_sum(lf[128 + lane] * lf[192 + lane]);
    const float lam_init = 0.8f - 0.6f * expf(-0.3f * (float)l);
    const float lam = expf(s1) - expf(s2) + lam_init, og = 1.f - lam_init;
    float g[8]; ld8f(A->in[I_ASUB] + l * 128 + 8 * i, g);
    constexpr int RU = 4;
    for (int row0 = F.gw; row0 < M; row0 += RU * F.NGW) {
        f32x4 a0[RU], a1[RU], b0[RU], b1[RU];
#pragma unroll
        for (int u = 0; u < RU; ++u) { const int row = row0 + u * F.NGW;
            if (row < M) { const float* src = OAR + (size_t)row * 1024 + 256 * h + 8 * i; a0[u] = *(const f32x4*)src; a1[u] = *(const f32x4*)(src + 4); b0[u] = *(const f32x4*)(src + 128); b1[u] = *(const f32x4*)(src + 132); } }
#pragma unroll
        for (int u = 0; u < RU; ++u) { const int row = row0 + u * F.NGW;
            if (row < M) {
                float d[8];
                d[0] = a0[u].x - lam * b0[u].x; d[1] = a0[u].y - lam * b0[u].y; d[2] = a0[u].z - lam * b0[u].z; d[3] = a0[u].w - lam * b0[u].w;
                d[4] = a1[u].x - lam * b1[u].x; d[5] = a1[u].y - lam * b1[u].y; d[6] = a1[u].z - lam * b1[u].z; d[7] = a1[u].w - lam * b1[u].w;
                float ss = sumsq8(d); ss += __shfl_xor(ss, 1); ss += __shfl_xor(ss, 2); ss += __shfl_xor(ss, 4); ss += __shfl_xor(ss, 8);
                const float rstd = rsqrtf(ss * (1.f / 128) + EPS) * og;
#pragma unroll
                for (int e = 0; e < 8; ++e) d[e] *= rstd * g[e];
                *(u32x4*)(OA + (size_t)row * 2048 + 128 * h + 8 * i) = pack8(d); } }
    }
}

template <int N> __device__ __forceinline__ float absmax_part(const float* g, int lane) {
    float v[(N + 63) / 64];
#pragma unroll
    for (int k = 0; k < (N + 63) / 64; ++k) { const int i = lane + 64 * k; v[k] = g[i < N ? i : N - 1]; }
    float m = 0.f;
#pragma unroll
    for (int k = 0; k < (N + 63) / 64; ++k) m = fmaxf(m, fabsf(v[k]));
    return m;
}
__device__ __forceinline__ float wave_max(float m) {
#pragma unroll
    for (int o = 1; o < 64; o <<= 1) m = fmaxf(m, __shfl_xor(m, o));
    return __uint_as_float(__builtin_amdgcn_readfirstlane(__float_as_uint(m)));
}
__device__ __forceinline__ void phase_attn(const Frame& F, ArgsP A, int l) {
    unsigned char* ws = F.ws; LAS char* lds = (LAS char*)F.lds;
    const bf16* QA = (const bf16*)(ws + WS_QA); const bf16* KA = (const bf16*)(ws + WS_KA); const bf16* VA = (const bf16*)(ws + WS_VA);
    const bf16* QB = (const bf16*)(ws + WS_QB); const bf16* KB = (const bf16*)(ws + WS_R3); const bf16* KVR = (const bf16*)(ws + WS_R1);
    const bf16* QC = (const bf16*)(ws + WS_QC); const bf16* KC = (const bf16*)(ws + WS_KC); const bf16* VC = (const bf16*)(ws + WS_VC);
    float* OAR = (float*)(ws + WS_R2); bf16* OB = (bf16*)(ws + WS_OALL) + 512; bf16* OC = (bf16*)(ws + WS_OALL) + 1536;
    const float p_aq = absmax_part<64>(A->in[I_AQN] + l * 64, F.lane), p_ak = absmax_part<64>(A->in[I_AKN] + l * 64, F.lane);
    const float p_bq = absmax_part<192>(A->in[I_BQN] + l * 192, F.lane), p_bk = absmax_part<192>(A->in[I_BKN] + l * 192, F.lane);
    const float p_cq = absmax_part<128>(A->in[I_CQN] + l * 128, F.lane), p_ck = absmax_part<128>(A->in[I_CKN] + l * 128, F.lane);
    const float p_cb = absmax_part<4 * 257>(A->in[I_CBIAS] + (size_t)l * 4 * 257, F.lane);
    const float negB_A = -1.4426950408889634f * 1.02f * 8.f * wave_max(p_aq) * wave_max(p_ak);
    const float negB_B = -1.4426950408889634f * 1.02f * 13.856406460551018f * wave_max(p_bq) * wave_max(p_bk);
    const float negB_C = -1.4426950408889634f * (1.02f * 11.313708498984761f * wave_max(p_cq) * wave_max(p_ck) + wave_max(p_cb));
#ifndef ATTM
#define ATTM 7
#endif
    if (ATTM & 1) for (int n = F.vcu; n < 1024 + 128; n += F.G) {
        att::UnitP P; P.ldq = 512; P.ldk = 512; P.ldv = 512; P.ldo = 1024; P.qpos0 = 0; P.kpos0 = 0; P.tab = nullptr; P.lo_base = 0; P.lo_step = 0;
        if (n < 1024) { const int v = n & 255, slot = n >> 8, x = v >> 5, j = v & 31, combo = 2 * x + (slot >> 1), b = combo >> 3, vh = combo & 7, i = (slot & 1) ? j : 63 - j;
            const size_t qrow = (size_t)b * SEQ + 256 * i, krow = (size_t)b * SEQ;
            P.Q = QA + qrow * 512 + 64 * vh; P.nq = 256; P.K = KA + krow * 512 + 64 * vh; P.V = VA + krow * 512 + 128 * (vh >> 1); P.O = OAR + qrow * 1024 + 128 * vh;
            P.NT = 4 * i + 4; P.kvalid = P.NT * 64; P.hi_base = 4 * i; P.hi_step = 1; P.fix_lo = 0; P.fix_hi = P.NT - 3;
        } else { const int s = n - 1024, b = s >> 3, vh = s & 7; const size_t qrow = (size_t)MP + 16 * b, krow = (size_t)MP + (size_t)b * SROWS;
            P.Q = QA + qrow * 512 + 64 * vh; P.nq = 16; P.K = KA + krow * 512 + 64 * vh; P.V = VA + krow * 512 + 128 * (vh >> 1); P.O = OAR + qrow * 1024 + 128 * vh;
            P.NT = SROWS / 64; P.kvalid = PAST + DECS; P.hi_base = SROWS / 64; P.hi_step = 0; P.fix_lo = 0; P.fix_hi = (PAST + DECS) / 64; }
        P.negB = negB_A; att::attn_unit<64, true, false, false>(P, lds);
    }
    if (ATTM & 2) for (int n = F.vcu; n < 1024 + 256; n += F.G) {
        att::UnitP P; P.ldq = 1536; P.ldk = 1536; P.ldv = 2048; P.ldo = 2048; P.qpos0 = 0; P.kpos0 = 0; P.tab = nullptr; P.lo_base = 0; P.lo_step = 0;
        if (n < 1024) { const int v = n & 255, slot = n >> 8, x = v >> 5, j = v & 31, combo = 2 * x + (slot >> 1), b = combo >> 3, hh = combo & 7, i = (slot & 1) ? j : 63 - j;
            const size_t qrow = (size_t)b * SEQ + 256 * i, krow = (size_t)b * SEQ;
            P.Q = QB + qrow * 1536 + 192 * hh; P.nq = 256; P.K = KB + krow * 1536 + 192 * hh; P.V = KVR + krow * 2048 + 256 * hh + 128; P.O = OB + qrow * 2048 + 128 * hh;
            P.NT = 4 * i + 4; P.kvalid = P.NT * 64; P.hi_base = 4 * i; P.hi_step = 1; P.fix_lo = 0; P.fix_hi = P.NT - 3;
        } else { const int s = n - 1024 - 128; if (s < 0) continue; const int b = s >> 3, hh = s & 7; const size_t qrow = (size_t)MP + 16 * b, krow = (size_t)MP + (size_t)b * SROWS;
            P.Q = QB + qrow * 1536 + 192 * hh; P.nq = 16; P.K = KB + krow * 1536 + 192 * hh; P.V = KVR + krow * 2048 + 256 * hh + 128; P.O = OB + qrow * 2048 + 128 * hh;
            P.NT = SROWS / 64; P.kvalid = PAST + DECS; P.hi_base = SROWS / 64; P.hi_step = 0; P.fix_lo = 0; P.fix_hi = (PAST + DECS) / 64; }
        P.negB = negB_B; att::attn_unit<192, false, false, false>(P, lds);
    }
    if (ATTM & 4) for (int n = F.vcu; n < 512 + 64; n += F.G) {
        att::UnitP P; P.ldq = 512; P.ldk = 512; P.ldv = 512; P.ldo = 2048;
        if (n < 512) { const int v = n & 255, slot = n >> 8, x = v >> 5, j = v & 31, b = x >> 2, hh = x & 3, i = j + 32 * slot, c0 = 4 * i, T0 = c0 >= 8 ? c0 - 8 : 0;
            const size_t qrow = (size_t)b * SEQ + 256 * i, krow = (size_t)b * SEQ + 64 * T0;
            P.Q = QC + qrow * 512 + 128 * hh; P.nq = 256; P.K = KC + krow * 512 + 128 * hh; P.V = VC + krow * 512 + 128 * hh; P.O = OC + qrow * 2048 + 128 * hh;
            P.NT = c0 + 4 - T0; P.kvalid = P.NT * 64; P.hi_base = c0 - T0; P.hi_step = 1; P.lo_base = c0 - 8 - T0; P.lo_step = 1; P.qpos0 = 256 * i; P.kpos0 = 64 * T0; P.fix_lo = 3; P.fix_hi = P.NT - 3;
            P.tab = A->in[I_CBIAS] + ((size_t)l * 4 + hh) * 257;
        } else { const int s = n - 512, b = s >> 2, hh = s & 3; const size_t qrow = (size_t)MP + 16 * b, krow = (size_t)MP + (size_t)b * CROWS;
            P.Q = QC + qrow * 512 + 128 * hh; P.nq = 16; P.K = KC + krow * 512 + 128 * hh; P.V = VC + krow * 512 + 128 * hh; P.O = OC + qrow * 2048 + 128 * hh;
            P.NT = CROWS / 64; P.kvalid = CPAST + DECS; P.hi_base = CROWS / 64; P.hi_step = 0; P.lo_base = 0; P.lo_step = 0; P.qpos0 = PAST; P.kpos0 = PAST - CPAST; P.fix_lo = 0; P.fix_hi = (CPAST + DECS) / 64;
            P.tab = A->in[I_CBIAS] + ((size_t)l * 4 + hh) * 257; }
        P.negB = negB_C; att::attn_unit<128, false, true, false>(P, lds);
    }
}

constexpr int NPH = 12, NPHASES = NPH * DEPTH + 1;

template <int l>
__device__ __forceinline__ void layer_body(Frame& F, LAS unsigned char* lds0, volatile LAS unsigned* MISC, const int lo, const int hi) {
#ifndef PHM
#define PHM 0xfff
#endif
#define IN(k) (((PHM >> ((k) % NPH)) & 1) && lo <= (k) && (k) < hi)
#define SEAM(k) do { if (IN(k) && IN((k) + 1)) { XcdBarrier b2; b2.bar = (unsigned*)(fresh_args()->ws + WS_CTL) + CW_BAR; b2.x = xb_xcc_id(); b2.st = MISC + 8; xcd_barrier(b2); } } while (0)
    bf16 *H, *Zb, *GT, *U; float* X;
#define FRESH() do { Ap = fresh_args(); F.tid = fresh_tid(); F.lane = F.tid & 63; F.wave = __builtin_amdgcn_readfirstlane(F.tid >> 6); \
    { int bx_ = blockIdx.x, G_ = gridDim.x; asm volatile("" : "+s"(bx_), "+s"(G_)); F.bx = bx_; F.G = G_; F.vcu = (G_ % 8 == 0) ? (bx_ % 8) * (G_ / 8) + bx_ / 8 : bx_; F.gw = F.vcu * 8 + F.wave; F.NGW = G_ * 8; } \
    { unsigned lb_ = 0; asm volatile("" : "+s"(lb_)); F.lds = lds0 + lb_; } \
    F.ws = Ap->ws; F.out = Ap->out; ws = F.ws; H = (bf16*)(ws + WS_R3); Zb = (bf16*)(ws + WS_R1); GT = (bf16*)(ws + WS_GATES); U = (bf16*)(ws + WS_R1); X = F.out + OUT_Y; } while (0)
    ArgsP Ap; unsigned char* ws;
    constexpr size_t WSET = (l & 1) ? WS_WSET1 : 0, WSET_NEXT = (l & 1) ? 0 : WS_WSET1;
        const int pb = NPH * l;
        if (IN(pb + 0)) { FRESH(); phase_pre(F, Ap, l); } SEAM(pb + 0);
        if (IN(pb + 1)) {
            FRESH(); ArgsP A = Ap;
            pg8::Gemm g{H, (const bf16*)(ws + WSET + WS_WIN), M, NIN, DM, DM, DM}; pg8::StaticOrder S; S.init(M, NIN, DM, F.G, F.bx, 4);
            pg8::EpiIn E{Zb, GT, A->in[I_BGATE] + (size_t)l * NGATE, F.lds + EPI_OFF};
            pg8::gemm_phase(F.lds, g, S, E);
            if (l + 1 < DEPTH) { const int nlast = ((M / 256) * (NIN / 256)) % F.G;
                if (nlast != 0 && F.bx >= nlast) pre_weights(F, Ap, l + 1, ws + WSET_NEXT, (F.bx - nlast) * 8 + F.wave, (F.G - nlast) * 8, 0, WCUT1); }
        } SEAM(pb + 1);
        if (IN(pb + 2)) { FRESH(); phase_post_in(F, Ap, l); } SEAM(pb + 2);
        if (IN(pb + 3)) {
            FRESH();
#pragma unroll 1
            for (int gi = 0; gi < 2; ++gi) {
                const bf16* Ain = (const bf16*)(ws + (gi == 0 ? WS_CQ : WS_CKV)); const bf16* Bt = (const bf16*)(ws + WSET + (gi == 0 ? WS_WQB : WS_WKVB));
                const int Mg = gi == 0 ? M : M2, Ng = gi == 0 ? 1536 : 2048, Kg = gi == 0 ? 512 : 256;
                pg8::Gemm g{Ain, Bt, Mg, Ng, Kg, Kg, Kg}; pg8::StaticOrder S; S.init(Mg, Ng, Kg, F.G, gi == 0 ? F.bx : (F.bx + F.G / 2) % F.G);
                pg8::EpiPlain E{(bf16*)(ws + (gi == 0 ? WS_R2 : WS_R1)), Ng, F.lds + EPI_OFF}; pg8::gemm_phase(F.lds, g, S, E);
            }
        } SEAM(pb + 3);
        if (IN(pb + 4)) { FRESH(); phase_post_b(F, Ap, l); } SEAM(pb + 4);
        if (IN(pb + 5)) { FRESH(); phase_attn(F, Ap, l); } SEAM(pb + 5);
        if (IN(pb + 6)) { FRESH(); phase_post_a(F, Ap, l); } SEAM(pb + 6);
        if (IN(pb + 7)) {
            FRESH();
            pg8::Gemm g{(const bf16*)(ws + WS_OALL), (const bf16*)(ws + WSET + WS_WBR), M, DM, DM, DM, DM}; pg8::StaticOrder S; S.init(M, DM, DM, F.G, F.bx, 4);
            pg8::EpiMerge E{GT, H, F.lds + EPI_OFF}; pg8::gemm_phase(F.lds, g, S, E);
            if (l + 1 < DEPTH) { const int nlast = ((M / 256) * (DM / 256)) % F.G;
                if (nlast != 0 && F.bx >= nlast) pre_caches(F, Ap, l + 1, (F.bx - nlast) * 8 + F.wave, (F.G - nlast) * 8); else if (nlast == 0) pre_caches(F, Ap, l + 1, F.gw, F.NGW); }
        } SEAM(pb + 7);
        if (IN(pb + 8)) {
            FRESH();
            { pg8::Gemm g{H, (const bf16*)(ws + WSET + WS_WO), M, DM, DM, DM, DM}; pg8::CombinedOrder S; S.init(MP, DM, DM, NS_O, F.G, F.bx);
              pg8::EpiResidSplit E{X, (float*)(ws + WS_SLAB_O), MP / 256, DM / NS_O, F.lds + EPI_OFF}; pg8::gemm_phase(F.lds, g, S, E); }
        } SEAM(pb + 8);
        if (IN(pb + 9)) { FRESH(); rmsnorm_rows(F, Ap, Ap->in[I_MNORM] + (size_t)l * DM, H, false, (const float*)(ws + WS_SLAB_O), NS_O); } SEAM(pb + 9);
        if (IN(pb + 10)) {
            FRESH();
            pg8::Gemm g{H, (const bf16*)(ws + WSET + WS_WUP), M, DFF, DM, DM, DM}; pg8::StaticOrder S; S.init(M, DFF, DM, F.G, F.bx, 4);
            pg8::EpiUp E{U, F.lds + EPI_OFF}; pg8::gemm_phase(F.lds, g, S, E);
            if (l + 1 < DEPTH) { const int nlast = ((M / 256) * (DFF / 256)) % F.G;
                if (nlast != 0 && F.bx >= nlast) pre_weights(F, Ap, l + 1, ws + WSET_NEXT, (F.bx - nlast) * 8 + F.wave, (F.G - nlast) * 8, WCUT1, WCUT2); }
        } SEAM(pb + 10);
        if (IN(pb + 11)) {
            FRESH();
            { pg8::Gemm g{U, (const bf16*)(ws + WSET + WS_WDN), M, DM, DFF, DFF, DFF}; pg8::CombinedOrder S; S.init(MP, DM, DFF, NS_DN, F.G, F.bx);
              pg8::EpiResidSplit E{X, (float*)(ws + WS_SLAB_DN), MP / 256, DFF / NS_DN, F.lds + EPI_OFF}; pg8::gemm_phase(F.lds, g, S, E); }
            if (l + 1 < DEPTH) { const int n1 = ((M / 256) * (NIN / 256)) % F.G, n2 = ((M / 256) * (DFF / 256)) % F.G;
                pre_weights(F, Ap, l + 1, ws + WSET_NEXT, F.gw, F.NGW, n1 != 0 ? (n2 != 0 ? WCUT2 : WCUT1) : 0, 1 << 30); }
        } SEAM(pb + 11);
    #undef IN
#undef SEAM
#undef FRESH
}

__global__ void __launch_bounds__(512, 2) fwd(Args args) {
    extern __shared__ __attribute__((aligned(16))) unsigned char lds_raw[];
    Frame F;
    F.lds = (LAS unsigned char*)lds_raw;
    F.tid = threadIdx.x; F.lane = F.tid & 63; F.wave = __builtin_amdgcn_readfirstlane(F.tid >> 6);
    F.G = gridDim.x; { const int bx = blockIdx.x; F.vcu = (F.G % 8 == 0) ? (bx % 8) * (F.G / 8) + bx / 8 : bx; }
    F.gw = F.vcu * 8 + F.wave; F.NGW = F.G * 8;
    F.out = args.out; F.ws = args.ws;
    unsigned char* ws = args.ws;
    volatile LAS unsigned* MISC = (volatile LAS unsigned*)(F.lds + MISC_OFF);
    for (int u = F.tid; u < (LDS_BYTES - LDSCTL_OFF) / 4; u += 512) ((LAS unsigned*)(F.lds + LDSCTL_OFF))[u] = 0u;
    __syncthreads();
    XcdBarrier bar; bar.bar = (unsigned*)(ws + WS_CTL) + CW_BAR; bar.x = 0; bar.st = nullptr;
    if (args.use_bar) bar = xcd_barrier_post((unsigned*)(ws + WS_CTL) + CW_BAR, MISC + 8);
    const int lo = args.ph_lo, hi = args.ph_hi;
    layer_body<0>(F, (LAS unsigned char*)lds_raw, MISC, lo, hi);
    layer_body<1>(F, (LAS unsigned char*)lds_raw, MISC, lo, hi);
    layer_body<2>(F, (LAS unsigned char*)lds_raw, MISC, lo, hi);
    layer_body<3>(F, (LAS unsigned char*)lds_raw, MISC, lo, hi);
    if (lo <= NPH * DEPTH && NPH * DEPTH < hi) {
        ArgsP Ap = fresh_args(); F.tid = fresh_tid(); F.lane = F.tid & 63; F.ws = Ap->ws; F.out = Ap->out;
        final_combine(F, (const float*)(F.ws + WS_SLAB_DN), NS_DN);
    }
}

extern "C" void kernel_launch(void* const* d_in, const int* in_sizes, int n_in, void* d_out, int out_size, void* d_ws, size_t ws_size, hipStream_t stream) {
    static int grid = 0;
    if (grid == 0) {
        if (n_in != 31 || (size_t)out_size != OUT_END || ws_size < WS_END) { fprintf(stderr, "kernel_launch: shape mismatch (n_in %d, out %d, ws %zu)\n", n_in, out_size, ws_size); grid = -1; return; }
        int dev = 0, cus = 0;
        if (hipGetDevice(&dev) != hipSuccess || hipDeviceGetAttribute(&cus, hipDeviceAttributeMultiprocessorCount, dev) != hipSuccess) { grid = -1; return; }
        if (hipFuncSetAttribute((const void*)fwd, hipFuncAttributeMaxDynamicSharedMemorySize, LDS_BYTES) != hipSuccess) { fprintf(stderr, "kernel_launch: hipFuncSetAttribute failed\n"); grid = -1; return; }
        int per_cu = 0;
        if (hipOccupancyMaxActiveBlocksPerMultiprocessor(&per_cu, (const void*)fwd, 512, LDS_BYTES) != hipSuccess || per_cu < 1) fprintf(stderr, "kernel_launch: occupancy query reports %d\n", per_cu);
        (void)hipGetLastError();
        grid = cus;
    }
    if (grid < 0) return;
    (void)hipMemsetAsync((char*)d_ws + WS_CTL, 0, CTL_ZERO_BYTES, stream);
    Args a{};
    for (int i = 0; i < 31; ++i) a.in[i] = (const float*)d_in[i];
    a.out = (float*)d_out; a.ws = (unsigned char*)d_ws; a.pad = 0;
#if MK_SPLIT
    for (int p = 0; p < NPHASES; ++p) { a.ph_lo = p; a.ph_hi = p + 1; a.use_bar = 0; hipLaunchKernelGGL(fwd, dim3(grid), dim3(512), LDS_BYTES, stream, a); }
#else
    a.ph_lo = 0; a.ph_hi = NPHASES; a.use_bar = 1; hipLaunchKernelGGL(fwd, dim3(grid), dim3(512), LDS_BYTES, stream, a);
#endif
}
```

```cpp
#include <hip/hip_runtime.h>
#include <cstdio>
#include <cstdint>
#include <cmath>

#ifndef MK_SPLIT
#define MK_SPLIT 0
#endif

#define GAS __attribute__((address_space(1)))
#define LAS __attribute__((address_space(3)))
typedef unsigned short bf16;
typedef short bf16x8 __attribute__((ext_vector_type(8)));
typedef short s16x4 __attribute__((ext_vector_type(4)));
typedef float f32x4 __attribute__((ext_vector_type(4)));
typedef float f32x16 __attribute__((ext_vector_type(16)));
typedef unsigned u32x4 __attribute__((ext_vector_type(4)));
typedef unsigned u32x2 __attribute__((ext_vector_type(2)));

constexpr int DM = 2048, SEQ = 16384, NBATCH = 2, DEPTH = 4, DECB = 16, DECS = 16, PAST = 2048;
constexpr int MP = NBATCH * SEQ, MS = DECB * DECS, M = MP + MS;
constexpr int SROWS = 2176, CROWS = 640, CPAST = 512;
constexpr int M2 = MP + DECB * SROWS;
constexpr int MC = MP + DECB * CROWS;
constexpr int NIN = 10240, NZ = 4096, NGATE = 6144, DFF = 8192, INCOLS = 10048;
constexpr float EPS = 1e-6f;
static_assert(M % 256 == 0 && M2 % 256 == 0, "row counts are whole 256-row panels");

constexpr size_t OUT_Y = 0;
constexpr size_t OUT_AK_P = OUT_Y + (size_t)M * DM;
constexpr size_t OUT_AV_P = OUT_AK_P + (size_t)DEPTH * MP * 512;
constexpr size_t OUT_BC_P = OUT_AV_P + (size_t)DEPTH * MP * 512;
constexpr size_t OUT_BP_P = OUT_BC_P + (size_t)DEPTH * MP * 256;
constexpr size_t OUT_CK_P = OUT_BP_P + (size_t)DEPTH * MP * 64;
constexpr size_t OUT_CV_P = OUT_CK_P + (size_t)DEPTH * NBATCH * 512 * 512;
constexpr size_t OUT_AK_S = OUT_CV_P + (size_t)DEPTH * NBATCH * 512 * 512;
constexpr size_t OUT_AV_S = OUT_AK_S + (size_t)DEPTH * MS * 512;
constexpr size_t OUT_BC_S = OUT_AV_S + (size_t)DEPTH * MS * 512;
constexpr size_t OUT_BP_S = OUT_BC_S + (size_t)DEPTH * MS * 256;
constexpr size_t OUT_CK_S = OUT_BP_S + (size_t)DEPTH * MS * 64;
constexpr size_t OUT_CV_S = OUT_CK_S + (size_t)DEPTH * MS * 512;
constexpr size_t OUT_END = OUT_CV_S + (size_t)DEPTH * MS * 512;
static_assert(OUT_END == 250413056ull, "output size");

constexpr size_t MiB = 1u << 20;
constexpr size_t WS_CTL = 0, CTL_ZERO_BYTES = 1 * MiB;
constexpr size_t WS_WIN = 1 * MiB;
constexpr size_t WS_WQB = 41 * MiB;
constexpr size_t WS_WKVB = 43 * MiB;
constexpr size_t WS_WBR = 44 * MiB;
constexpr size_t WS_WO = 52 * MiB;
constexpr size_t WS_WUP = 60 * MiB;
constexpr size_t WS_WDN = 92 * MiB;
constexpr size_t WS_R3 = 124 * MiB;
constexpr size_t WS_R1 = 322 * MiB;
constexpr size_t WS_GATES = 586 * MiB;
constexpr size_t WS_QA = 973 * MiB;
constexpr size_t WS_KA = 1006 * MiB;
constexpr size_t WS_VA = 1072 * MiB;
constexpr size_t WS_CQ = 1138 * MiB;
constexpr size_t WS_CKV = 1171 * MiB;
constexpr size_t WS_KPE = 1204 * MiB;
constexpr size_t WS_QC = 1221 * MiB;
constexpr size_t WS_KC = 1254 * MiB;
constexpr size_t WS_VC = 1296 * MiB;
constexpr size_t WS_R2 = 1338 * MiB;
constexpr size_t WS_OALL = 1596 * MiB;
constexpr size_t WS_QB = 1727 * MiB;
constexpr size_t WS_END = 1824 * MiB;
static_assert(WS_WIN + (size_t)NIN * DM * 2 <= WS_WQB && WS_WDN + (size_t)DM * DFF * 2 <= WS_R3, "weights");
static_assert(WS_R3 + (size_t)M2 * 1536 * 2 <= WS_R1 && WS_R1 + (size_t)M2 * 2048 * 2 <= WS_GATES && WS_GATES + (size_t)M * NGATE * 2 <= WS_QA, "R3/R1/gates");
static_assert(WS_R1 + (size_t)M * DFF * 2 <= WS_QA, "u overlay");
static_assert(WS_QA + (size_t)M * 512 * 2 <= WS_KA && WS_KA + (size_t)M2 * 512 * 2 <= WS_VA && WS_VA + (size_t)M2 * 512 * 2 <= WS_CQ, "A");
static_assert(WS_CQ + (size_t)M * 512 * 2 <= WS_CKV && WS_CKV + (size_t)M2 * 256 * 2 <= WS_KPE && WS_KPE + (size_t)M2 * 64 * 4 <= WS_QC, "B");
static_assert(WS_QC + (size_t)M * 512 * 2 <= WS_KC && WS_KC + (size_t)MC * 512 * 2 <= WS_VC && WS_VC + (size_t)MC * 512 * 2 <= WS_R2, "C");
static_assert(WS_R2 + (size_t)M * 2048 * 4 <= WS_OALL && WS_OALL + (size_t)M * 2048 * 2 <= WS_QB && WS_QB + (size_t)M * 1536 * 2 <= WS_END, "tail");

constexpr int CW_BAR = 4096;

constexpr int RING_BYTES = 131072;
constexpr int LDSCTL_OFF = RING_BYTES, MISC_OFF = LDSCTL_OFF + 320;
constexpr int LDS_BYTES = 155648;
constexpr int EPI_OFF = RING_BYTES + 8192;
static_assert(EPI_OFF + 8 * 2048 <= LDS_BYTES, "epilogue staging");

#define LDS_WAIT() asm volatile("s_waitcnt lgkmcnt(0)" ::: "memory")
#define VM_WAIT() asm volatile("s_waitcnt vmcnt(0)" ::: "memory")
#define SBAR() __builtin_amdgcn_sched_barrier(0)
__device__ __forceinline__ int fresh_tid() { int t = threadIdx.x; asm volatile("" : "+v"(t)); return t; }
__device__ __forceinline__ unsigned cvtpk(float lo, float hi) { unsigned r; asm volatile("v_cvt_pk_bf16_f32 %0, %1, %2" : "=v"(r) : "v"(lo), "v"(hi)); return r; }
__device__ __forceinline__ float bf_lo(unsigned u) { return __uint_as_float(u << 16); }
__device__ __forceinline__ float bf_hi(unsigned u) { return __uint_as_float(u & 0xffff0000u); }
__device__ __forceinline__ void unpack8(u32x4 w, float (&v)[8]) { v[0] = bf_lo(w.x); v[1] = bf_hi(w.x); v[2] = bf_lo(w.y); v[3] = bf_hi(w.y); v[4] = bf_lo(w.z); v[5] = bf_hi(w.z); v[6] = bf_lo(w.w); v[7] = bf_hi(w.w); }
__device__ __forceinline__ u32x4 pack8(const float (&v)[8]) { u32x4 w; w.x = cvtpk(v[0], v[1]); w.y = cvtpk(v[2], v[3]); w.z = cvtpk(v[4], v[5]); w.w = cvtpk(v[6], v[7]); return w; }
__device__ __forceinline__ void ld8bf(const bf16* p, float (&v)[8]) { unpack8(*(const u32x4*)p, v); }
__device__ __forceinline__ void ld8f(const float* p, float (&v)[8]) { const f32x4 a = *(const f32x4*)p, b = *(const f32x4*)(p + 4); v[0] = a.x; v[1] = a.y; v[2] = a.z; v[3] = a.w; v[4] = b.x; v[5] = b.y; v[6] = b.z; v[7] = b.w; }
__device__ __forceinline__ void st8f(float* p, const float (&v)[8]) { *(f32x4*)p = (f32x4){v[0], v[1], v[2], v[3]}; *(f32x4*)(p + 4) = (f32x4){v[4], v[5], v[6], v[7]}; }
__device__ __forceinline__ void st8f_nt(float* p, const float (&v)[8]) { __builtin_nontemporal_store((f32x4){v[0], v[1], v[2], v[3]}, (f32x4*)p); __builtin_nontemporal_store((f32x4){v[4], v[5], v[6], v[7]}, (f32x4*)(p + 4)); }
__device__ __forceinline__ float wave_sum(float v) {
#pragma unroll
    for (int o = 1; o < 64; o <<= 1) v += __shfl_xor(v, o);
    return v;
}
__device__ __forceinline__ float sumsq8(const float (&v)[8]) { float s = 0.f;
#pragma unroll
    for (int e = 0; e < 8; ++e) s += v[e] * v[e];
    return s; }

#define XB_TMO      128
#define XB_XCNT(j)  (256  + 64 * (j))
#define XB_XSUB(j)  (1280 + 64 * (j))
#define XB_XGEN(j)  (2304 + 64 * (j))
#define XB_TOP      3328
#define XB_TOPGEN   3392
#define XCD_BAR_WORDS 3456
#define XB_SPIN_CAP (1u << 18)
__device__ __forceinline__ unsigned xb_ld(unsigned* p)              { return __hip_atomic_load(p, __ATOMIC_RELAXED, __HIP_MEMORY_SCOPE_AGENT); }
__device__ __forceinline__ unsigned xb_add(unsigned* p, unsigned v) { return __hip_atomic_fetch_add(p, v, __ATOMIC_RELAXED, __HIP_MEMORY_SCOPE_AGENT); }
__device__ __forceinline__ unsigned xb_xcc_id() { return (unsigned)__builtin_amdgcn_s_getreg((3 << 11) | 20) & 0xFu; }
#define XB_SPIN(cond, bar) do { unsigned _sp = 0; while (cond) { __builtin_amdgcn_s_sleep(1); \
    if ((++_sp & 255u) == 0u) { if (xb_ld(&(bar)[XB_TMO])) break; if (_sp > XB_SPIN_CAP) { atomicAdd(&(bar)[XB_TMO], 1u); break; } } } } while (0)
struct XcdBarrier { unsigned* bar; unsigned x; volatile LAS unsigned* st; };
__device__ __forceinline__ XcdBarrier xcd_barrier_post(unsigned* bar, volatile LAS unsigned* st) {
    XcdBarrier b; b.bar = bar; b.x = xb_xcc_id(); b.st = st;
    if (threadIdx.x == 0) (void)xb_add(&bar[XB_XCNT(b.x)], 1u);
    return b;
}
__device__ __forceinline__ void xcd_barrier_complete(unsigned* bar, unsigned x, unsigned& nloc, unsigned& nx) {
    const unsigned G = gridDim.x * gridDim.y * gridDim.z;
    unsigned sum, cnt, mine, sp = 0u;
    for (;;) {
        sum = 0u; cnt = 0u; mine = 0u;
#pragma unroll
        for (unsigned j = 0; j < 16; ++j) { const unsigned c = xb_ld(&bar[XB_XCNT(j)]); sum += c; cnt += (c > 0u) ? 1u : 0u; mine = (j == x) ? c : mine; }
        if (sum == G) break;
        __builtin_amdgcn_s_sleep(1);
        if ((++sp & 255u) == 0u) { if (xb_ld(&bar[XB_TMO])) break; if (sp > XB_SPIN_CAP) { atomicAdd(&bar[XB_TMO], 1u); break; } }
    }
    nloc = mine > 0u ? mine : 1u; nx = cnt > 0u ? cnt : 1u;
}
__device__ __forceinline__ void xcd_barrier(const XcdBarrier& b) {
    asm volatile("s_waitcnt vmcnt(0)" ::: "memory");
    __syncthreads();
    if (threadIdx.x == 0) {
        unsigned* bar = b.bar;
        __builtin_amdgcn_s_waitcnt(0);
        unsigned nloc = b.st[0], nx = b.st[1];
        if (nloc == 0u) { xcd_barrier_complete(bar, b.x, nloc, nx); b.st[0] = nloc; b.st[1] = nx; }
        const unsigned old = xb_add(&bar[XB_XSUB(b.x)], 1u);
        const unsigned gen = old / nloc;
        if (old + 1u == (gen + 1u) * nloc) {
            __builtin_amdgcn_fence(__ATOMIC_RELEASE, "agent");
            asm volatile("s_waitcnt vmcnt(0)" ::: "memory");
            const unsigned og = xb_add(&bar[XB_TOP], 1u);
            const unsigned tg = og / nx;
            if (og + 1u == (tg + 1u) * nx) xb_add(&bar[XB_TOPGEN], 1u);
            else XB_SPIN(xb_ld(&bar[XB_TOPGEN]) == tg, bar);
            __builtin_amdgcn_fence(__ATOMIC_ACQUIRE, "agent");
            xb_add(&bar[XB_XGEN(b.x)], 1u);
            asm volatile("s_waitcnt vmcnt(0)" ::: "memory");
        } else {
            XB_SPIN(xb_ld(&bar[XB_XGEN(b.x)]) == gen, bar);
            __builtin_amdgcn_fence(__ATOMIC_ACQUIRE, "agent");
            asm volatile("s_waitcnt vmcnt(0)" ::: "memory");
        }
    }
    __syncthreads();
}

namespace pg8 {
constexpr int BM = 256, BK = 64, HALF = 128, HTB = HALF * BK * 2, NXCD = 8, WGM = 8;
__host__ __device__ __forceinline__ int lds_byte(int r, int c) { return r * 128 + ((((c >> 3) ^ ((r >> 1) & 7))) << 4) + (c & 7) * 2; }
__host__ __device__ __forceinline__ void stage_rc(int b, int& R, int& C) { R = b >> 7; const int slot = (b & 127) >> 4; C = (slot ^ ((R >> 1) & 7)) * 8; }
__host__ __device__ __forceinline__ int perm32(int rho) { const int n = rho >> 4, i = rho & 15; return 8 * (i >> 2) + 4 * n + (i & 3); }
struct Unit { int pm, pn, koff, nt; };
struct Gemm { const bf16* A; const bf16* Bt; int M, N, K, lda, ldb; };
struct StaticOrder {
    int nM, nN, nwg, G, c, nt, wgm;
    __device__ void init(int M_, int N_, int K_, int G_, int c_, int wgm_ = WGM) { nM = M_ / BM; nN = N_ / BM; nwg = nM * nN; G = G_; c = c_; nt = K_ / BK; wgm = wgm_; }
    __device__ bool next(int i, Unit& u) const {
        const long L = (long)i * G + c; if (L >= nwg) return false;
        int wgid = (int)L; { const int q = nwg / NXCD, r = nwg % NXCD, xcd = wgid % NXCD, off = wgid / NXCD; wgid = (xcd < r ? xcd * (q + 1) : r * (q + 1) + (xcd - r) * q) + off; }
        const int nig = wgm * nN, gid = wgid / nig, fm = gid * wgm, gsz = (nM - fm) < wgm ? (nM - fm) : wgm;
        u.pm = fm + ((wgid % nig) % gsz); u.pn = (wgid % nig) / gsz; u.koff = 0; u.nt = nt; return true;
    }
};
struct CombinedOrder {
    StaticOrder S0; int pmS, nN, np, KS;
    __device__ void init(int Mmain, int N_, int K_, int NS_, int G_, int c_) { S0.init(Mmain, N_, K_, G_, c_, 4); pmS = Mmain / BM; nN = N_ / BM; np = nN * NS_; KS = K_ / NS_; }
    __device__ bool next(int i, Unit& u) const { const long L = (long)i * S0.G + S0.c; if (L < S0.nwg) return S0.next(i, u);
        const int p = (int)(L - S0.nwg); if (p >= np) return false; u.pm = pmS; u.pn = p % nN; u.koff = (p / nN) * KS; u.nt = KS / BK; return true; }
};
template <class Epi, class Order>
__device__ __forceinline__ void gemm_phase(LAS unsigned char* lds, const Gemm g, const Order& S, const Epi& E) {
    const int tid = fresh_tid(), wid = __builtin_amdgcn_readfirstlane(tid >> 6), lane = tid & 63, wr = wid >> 2, wc = wid & 3, fr = lane & 15, fq = lane >> 4;
    unsigned voffA[2], voffB[2];
#pragma unroll
    for (int i = 0; i < 2; ++i) { int R, C; stage_rc(tid * 16 + i * 8192, R, C); const int Rb = 64 * (R >> 5) + perm32(R & 31);
        voffA[i] = (unsigned)(R * g.lda + C) * 2u; voffB[i] = (unsigned)(Rb * g.ldb + C) * 2u; }
    const size_t kstep = (size_t)(BK * 2);
    const size_t hstepA = (size_t)HALF * g.lda * 2, hstepB = (size_t)32 * g.ldb * 2;
    const size_t tstepA = 2 * hstepA, tstepB = (size_t)BM * g.ldb * 2;
    const unsigned ldsw = (unsigned)wid * 1024u;
    const int aoff = lds_byte(wr * 64 + fr, fq * 8), boff = lds_byte(wc * 32 + fr, fq * 8), aoff1 = aoff ^ 64, boff1 = boff ^ 64;
#define PG8_SA(b, h) (((b) * 2 + (h)) * HTB)
#define PG8_SB(b, h) ((4 + (b) * 2 + (h)) * HTB)
#define PG8_STAGE(bufoff, gbase, voff) do { _Pragma("unroll") for (int _i = 0; _i < 2; ++_i) \
        __builtin_amdgcn_global_load_lds((const unsigned*)((const char*)(gbase) + (voff)[_i]), (LAS unsigned*)(lds + (bufoff) + ldsw + _i * 8192), 16, 0, 0); } while (0)
#define PG8_LDA(dst, b, h) do { _Pragma("unroll") for (int m = 0; m < 4; ++m) _Pragma("unroll") for (int k = 0; k < 2; ++k) dst[m][k] = *(const LAS bf16x8*)(lds + PG8_SA(b, h) + (k ? aoff1 : aoff) + m * 2048); } while (0)
#define PG8_LDB(dst, b, h) do { _Pragma("unroll") for (int n = 0; n < 2; ++n) _Pragma("unroll") for (int k = 0; k < 2; ++k) dst[n][k] = *(const LAS bf16x8*)(lds + PG8_SB(b, h) + (k ? boff1 : boff) + n * 2048); } while (0)
#define PG8_MMA(ai, bj, At, Bt) do { __builtin_amdgcn_s_setprio(1); _Pragma("unroll") for (int m = 0; m < 4; ++m) _Pragma("unroll") for (int n = 0; n < 2; ++n) _Pragma("unroll") for (int k = 0; k < 2; ++k) \
        acc[ai][bj][m][n] = __builtin_amdgcn_mfma_f32_16x16x32_bf16(Bt[n][k], At[m][k], acc[ai][bj][m][n], 0, 0, 0); __builtin_amdgcn_s_setprio(0); } while (0)
#define PG8_WAIT_V(n) asm volatile("s_waitcnt vmcnt(" #n ")" ::: "memory")
#define PG8_WAIT_L(n) asm volatile("s_waitcnt lgkmcnt(" #n ")" ::: "memory")
#define PG8_BAR __builtin_amdgcn_s_barrier()
#define PG8_SCHED __builtin_amdgcn_sched_barrier(0)
    Unit cur, nxt; int ui = 0;
    if (!S.next(0, cur)) return;
    f32x4 acc[2][2][4][2];
#pragma unroll
    for (int a = 0; a < 2; ++a)
#pragma unroll
        for (int b = 0; b < 2; ++b)
#pragma unroll
            for (int m = 0; m < 4; ++m)
#pragma unroll
                for (int n = 0; n < 2; ++n) acc[a][b][m][n] = (f32x4){0.f, 0.f, 0.f, 0.f};
    bf16x8 At[4][2], B0[2][2], B1[2][2];
    const char* cA = (const char*)g.A + (size_t)cur.pm * tstepA + (size_t)cur.koff * 2; const char* cB = (const char*)g.Bt + (size_t)cur.pn * tstepB + (size_t)cur.koff * 2;
    PG8_STAGE(PG8_SB(0, 0), cB, voffB); PG8_STAGE(PG8_SB(0, 1), cB + hstepB, voffB); PG8_STAGE(PG8_SA(0, 0), cA, voffA); PG8_STAGE(PG8_SA(0, 1), cA + hstepA, voffA);
    if (wr == 1) PG8_BAR;
    PG8_WAIT_V(2); PG8_BAR;
    PG8_STAGE(PG8_SB(1, 0), cB + kstep, voffB); PG8_STAGE(PG8_SA(1, 0), cA + kstep, voffA); PG8_STAGE(PG8_SB(1, 1), cB + hstepB + kstep, voffB);
    PG8_WAIT_V(6); PG8_BAR;
    for (;;) {
        const bool has_next = S.next(ui + 1, nxt);
        const char* nA = has_next ? (const char*)g.A + (size_t)nxt.pm * tstepA + (size_t)nxt.koff * 2 : cA; const char* nB = has_next ? (const char*)g.Bt + (size_t)nxt.pn * tstepB + (size_t)nxt.koff * 2 : cB;
        const int nt = cur.nt;
        for (int t = 0; t < nt; t += 2) {
            if constexpr (Epi::HOOK) { if (t == 8 || t == 24) E.mid(acc, cur, wr, wc, fr, fq, t); }
            const bool last = (t == nt - 2);
            const char* a1 = cA + (size_t)(t + 1) * kstep;
            const char* a2 = last ? nA : cA + (size_t)(t + 2) * kstep; const char* b2 = last ? nB : cB + (size_t)(t + 2) * kstep;
            const char* a3 = a2 + kstep; const char* b3 = b2 + kstep;
            PG8_LDB(B0, 0, 0); PG8_LDB(B1, 0, 1); PG8_SCHED; PG8_LDA(At, 0, 0); PG8_STAGE(PG8_SA(1, 1), a1 + hstepA, voffA);
            PG8_WAIT_V(8); PG8_WAIT_L(0); PG8_BAR; PG8_MMA(0, 0, At, B0); PG8_MMA(0, 1, At, B1); PG8_BAR; PG8_SCHED;
            PG8_LDA(At, 0, 1); PG8_STAGE(PG8_SB(0, 0), b2, voffB); PG8_STAGE(PG8_SB(0, 1), b2 + hstepB, voffB); PG8_STAGE(PG8_SA(0, 0), a2, voffA);
            PG8_WAIT_V(8); PG8_WAIT_L(0); PG8_BAR; PG8_MMA(1, 0, At, B0); PG8_MMA(1, 1, At, B1); PG8_BAR; PG8_SCHED;
            PG8_LDB(B0, 1, 0); PG8_LDB(B1, 1, 1); PG8_SCHED; PG8_LDA(At, 1, 0); PG8_STAGE(PG8_SA(0, 1), a2 + hstepA, voffA);
            PG8_WAIT_V(8); PG8_WAIT_L(0); PG8_BAR; PG8_MMA(0, 0, At, B0); PG8_MMA(0, 1, At, B1); PG8_BAR; PG8_SCHED;
            PG8_LDA(At, 1, 1); PG8_STAGE(PG8_SB(1, 0), b3, voffB); PG8_STAGE(PG8_SB(1, 1), b3 + hstepB, voffB); PG8_STAGE(PG8_SA(1, 0), a3, voffA);
            PG8_WAIT_V(8); PG8_WAIT_L(0); PG8_BAR; PG8_MMA(1, 0, At, B0); PG8_MMA(1, 1, At, B1); PG8_BAR; PG8_SCHED;
        }
        if (wr == 0) PG8_BAR;
        E(acc, cur, wr, wc, fr, fq);
        if (!has_next) break;
#pragma unroll
        for (int a = 0; a < 2; ++a)
#pragma unroll
            for (int b = 0; b < 2; ++b)
#pragma unroll
                for (int m = 0; m < 4; ++m)
#pragma unroll
                    for (int n = 0; n < 2; ++n) acc[a][b][m][n] = (f32x4){0.f, 0.f, 0.f, 0.f};
        cur = nxt; cA = nA; cB = nB; ++ui;
        if (wr == 1) PG8_BAR;
    }
    PG8_WAIT_V(0);
    PG8_BAR;
#undef PG8_SA
#undef PG8_SB
#undef PG8_STAGE
#undef PG8_LDA
#undef PG8_LDB
#undef PG8_MMA
#undef PG8_WAIT_V
#undef PG8_WAIT_L
#undef PG8_BAR
#undef PG8_SCHED
}

#define EPI_LOOP_BEGIN const int row0 = u.pm * BM + wr * 64 + fr, col0 = u.pn * BM + wc * 64 + 8 * fq; \
    _Pragma("unroll") for (int ai = 0; ai < 2; ++ai) _Pragma("unroll") for (int m = 0; m < 4; ++m) { const size_t row = (size_t)(row0 + ai * HALF + m * 16); \
    _Pragma("unroll") for (int bj = 0; bj < 2; ++bj) { const int col = col0 + bj * 32; f32x4 v0 = acc[ai][bj][m][0], v1 = acc[ai][bj][m][1];
#define EPI_LOOP_END } }
__device__ __forceinline__ u32x4 pk8(f32x4 v0, f32x4 v1) { u32x4 w; w.x = cvtpk(v0[0], v0[1]); w.y = cvtpk(v0[2], v0[3]); w.z = cvtpk(v1[0], v1[1]); w.w = cvtpk(v1[2], v1[3]); return w; }
__device__ __forceinline__ float sigm2(float v, float nb) { return __builtin_amdgcn_rcpf(1.f + __builtin_amdgcn_exp2f(__builtin_fmaf(v, -1.4426950408889634f, nb))); }
__device__ __forceinline__ float sigm(float v) { return __builtin_amdgcn_rcpf(1.f + __builtin_amdgcn_exp2f(-1.4426950408889634f * v)); }

template <bool NT> __device__ __forceinline__ void st_lines(LAS unsigned char* scr, u32x4 w0, u32x4 w1, bf16* tile, size_t ldc, int fr, int fq) {
    const int lane = fq * 16 + fr, rr = lane >> 3, c = lane & 7;
    *(LAS u32x4*)(scr + fr * 128 + ((fq ^ (fr & 7)) << 4)) = w0;
    *(LAS u32x4*)(scr + fr * 128 + (((4 + fq) ^ (fr & 7)) << 4)) = w1;
    const u32x4 a = *(const LAS u32x4*)(scr + rr * 128 + ((c ^ rr) << 4)), b = *(const LAS u32x4*)(scr + (8 + rr) * 128 + ((c ^ rr) << 4));
    bf16* d = tile + (size_t)rr * ldc + c * 8;
    if constexpr (NT) { __builtin_nontemporal_store(a, (u32x4*)d); __builtin_nontemporal_store(b, (u32x4*)(d + 8 * ldc)); }
    else { *(u32x4*)d = a; *(u32x4*)(d + 8 * ldc) = b; }
}
__device__ __forceinline__ void sl_xpose(LAS unsigned char* scr, u32x4 w0, u32x4 w1, int fr, int fq, u32x4& a, u32x4& b) {
    const int lane = fq * 16 + fr, rr = lane >> 3, c = lane & 7;
    *(LAS u32x4*)(scr + fr * 128 + ((fq ^ (fr & 7)) << 4)) = w0;
    *(LAS u32x4*)(scr + fr * 128 + (((4 + fq) ^ (fr & 7)) << 4)) = w1;
    a = *(const LAS u32x4*)(scr + rr * 128 + ((c ^ rr) << 4)); b = *(const LAS u32x4*)(scr + (8 + rr) * 128 + ((c ^ rr) << 4));
}
template <bool NT> __device__ __forceinline__ void sl_store(u32x4 a, u32x4 b, bf16* tile, size_t ldc, int fr, int fq) {
    const int lane = fq * 16 + fr, rr = lane >> 3, c = lane & 7;
    bf16* d = tile + (size_t)rr * ldc + c * 8;
    if constexpr (NT) { __builtin_nontemporal_store(a, (u32x4*)d); __builtin_nontemporal_store(b, (u32x4*)(d + 8 * ldc)); }
    else { *(u32x4*)d = a; *(u32x4*)(d + 8 * ldc) = b; }
}
struct EpiIn {
    static constexpr bool HOOK = false;
    bf16* Z; bf16* G; const float* bg; LAS unsigned char* scr;
    __device__ __forceinline__ void operator()(const f32x4 (&acc)[2][2][4][2], const Unit& u, int wr, int wc, int fr, int fq) const {
        const bool isg = u.pn * BM >= NZ;
        const int colw = u.pn * BM + wc * 64 - (isg ? NZ : 0);
        bf16* base = (isg ? G : Z) + (size_t)(u.pm * BM + wr * 64) * (isg ? NGATE : NZ) + colw; const size_t ldc = isg ? NGATE : NZ;
        LAS unsigned char* sw = scr + (wr * 4 + wc) * 2048;
        f32x4 b00, b01, b10, b11;
        if (isg) { const float* bp = bg + colw + 8 * fq; b00 = *(const f32x4*)bp * -1.4426950408889634f; b01 = *(const f32x4*)(bp + 4) * -1.4426950408889634f; b10 = *(const f32x4*)(bp + 32) * -1.4426950408889634f; b11 = *(const f32x4*)(bp + 36) * -1.4426950408889634f; }
#pragma unroll
        for (int ai = 0; ai < 2; ++ai) { u32x4 ra[4], rb[4];
#pragma unroll
            for (int m = 0; m < 4; ++m) {
                f32x4 v0 = acc[ai][0][m][0], v1 = acc[ai][0][m][1], v2 = acc[ai][1][m][0], v3 = acc[ai][1][m][1];
                if (isg) {
#pragma unroll
                    for (int e = 0; e < 4; ++e) { v0[e] = sigm2(v0[e], b00[e]); v1[e] = sigm2(v1[e], b01[e]); v2[e] = sigm2(v2[e], b10[e]); v3[e] = sigm2(v3[e], b11[e]); } }
                sl_xpose(sw, pk8(v0, v1), pk8(v2, v3), fr, fq, ra[m], rb[m]); }
#pragma unroll
            for (int m = 0; m < 4; ++m) sl_store<true>(ra[m], rb[m], base + (size_t)(ai * HALF + m * 16) * ldc, ldc, fr, fq); }
    }
};
struct EpiPlain {
    static constexpr bool HOOK = false;
    bf16* O; int ldc; LAS unsigned char* scr;
    __device__ __forceinline__ void operator()(const f32x4 (&acc)[2][2][4][2], const Unit& u, int wr, int wc, int fr, int fq) const {
        bf16* base = O + (size_t)(u.pm * BM + wr * 64) * ldc + u.pn * BM + wc * 64; LAS unsigned char* sw = scr + (wr * 4 + wc) * 2048;
#pragma unroll
        for (int ai = 0; ai < 2; ++ai) { u32x4 ra[4], rb[4];
#pragma unroll
            for (int m = 0; m < 4; ++m) sl_xpose(sw, pk8(acc[ai][0][m][0], acc[ai][0][m][1]), pk8(acc[ai][1][m][0], acc[ai][1][m][1]), fr, fq, ra[m], rb[m]);
#pragma unroll
            for (int m = 0; m < 4; ++m) sl_store<false>(ra[m], rb[m], base + (size_t)(ai * HALF + m * 16) * ldc, (size_t)ldc, fr, fq); }
    }
};
struct EpiMerge {
    static constexpr bool HOOK = true;
    const bf16* G; bf16* Ob; LAS unsigned char* scr;
    __device__ __forceinline__ void mid(f32x4 (&acc)[2][2][4][2], const Unit& u, int wr, int wc, int fr, int fq, int t) const {
        const __amdgpu_buffer_rsrc_t rs = __builtin_amdgcn_make_buffer_rsrc((void*)G, 0, (int)((size_t)M * NGATE * 2), 0x00020000);
        const int gx = (t == 8) ? 0 : DM;
        const int voff = ((u.pm * BM + wr * 64 + fr) * NGATE + u.pn * BM + wc * 64 + 8 * fq + gx) * 2;
#pragma unroll
        for (int ai = 0; ai < 2; ++ai) {
            u32x4 wa[4][2], wb[4][2];
#pragma unroll
            for (int m = 0; m < 4; ++m)
#pragma unroll
                for (int bj = 0; bj < 2; ++bj) { const int so = ((ai * HALF + m * 16) * NGATE + bj * 32) * 2;
                    wa[m][bj] = __builtin_amdgcn_raw_buffer_load_b128(rs, voff, so, 0); wb[m][bj] = __builtin_amdgcn_raw_buffer_load_b128(rs, voff, so + DM * 2, 0); }
#pragma unroll
            for (int m = 0; m < 4; ++m)
#pragma unroll
                for (int bj = 0; bj < 2; ++bj) {
                    float a[8], b[8]; unpack8(wa[m][bj], a); unpack8(wb[m][bj], b);
#pragma unroll
                    for (int e = 0; e < 8; ++e) a[e] = a[e] * __builtin_amdgcn_rcpf(fmaxf(b[e], 1e-30f));
                    f32x4& v0 = acc[ai][bj][m][0]; f32x4& v1 = acc[ai][bj][m][1];
                    v0[0] *= a[0]; v0[1] *= a[1]; v0[2] *= a[2]; v0[3] *= a[3]; v1[0] *= a[4]; v1[1] *= a[5]; v1[2] *= a[6]; v1[3] *= a[7]; }
            SBAR(); }
    }
    __device__ __forceinline__ void operator()(const f32x4 (&acc)[2][2][4][2], const Unit& u, int wr, int wc, int fr, int fq) const {
        bf16* base = Ob + (size_t)(u.pm * BM + wr * 64) * DM + u.pn * BM + wc * 64; LAS unsigned char* sw = scr + (wr * 4 + wc) * 2048;
        const bf16* gb = G + (size_t)(u.pm * BM + wr * 64 + fr) * NGATE + 2 * DM + u.pn * BM + wc * 64 + 8 * fq;
        u32x4 gq[2][4][2];
#pragma unroll
        for (int ai = 0; ai < 2; ++ai)
#pragma unroll
            for (int m = 0; m < 4; ++m) { const bf16* gp = gb + (size_t)(ai * HALF + m * 16) * NGATE; gq[ai][m][0] = *(const u32x4*)gp; gq[ai][m][1] = *(const u32x4*)(gp + 32); }
#pragma unroll
        for (int ai = 0; ai < 2; ++ai) { u32x4 ra[4], rb[4];
#pragma unroll
            for (int m = 0; m < 4; ++m) {
                float g0[8], g1[8]; unpack8(gq[ai][m][0], g0); unpack8(gq[ai][m][1], g1);
                f32x4 v0 = acc[ai][0][m][0], v1 = acc[ai][0][m][1], v2 = acc[ai][1][m][0], v3 = acc[ai][1][m][1];
                v0[0] *= g0[0]; v0[1] *= g0[1]; v0[2] *= g0[2]; v0[3] *= g0[3]; v1[0] *= g0[4]; v1[1] *= g0[5]; v1[2] *= g0[6]; v1[3] *= g0[7];
                v2[0] *= g1[0]; v2[1] *= g1[1]; v2[2] *= g1[2]; v2[3] *= g1[3]; v3[0] *= g1[4]; v3[1] *= g1[5]; v3[2] *= g1[6]; v3[3] *= g1[7];
                sl_xpose(sw, pk8(v0, v1), pk8(v2, v3), fr, fq, ra[m], rb[m]); }
#pragma unroll
            for (int m = 0; m < 4; ++m) sl_store<false>(ra[m], rb[m], base + (size_t)(ai * HALF + m * 16) * DM, (size_t)DM, fr, fq); }
    }
};
struct EpiResidSplit {
    static constexpr bool HOOK = false;
    float* X; float* P; int pmS, KS; LAS unsigned char* scr;
    __device__ __forceinline__ void operator()(const f32x4 (&acc)[2][2][4][2], const Unit& u, int wr, int wc, int fr, int fq) const {
        const bool piece = u.pm >= pmS;
        float* base = (piece ? P + (size_t)(u.koff / KS) * (MS * DM) - (size_t)u.pm * BM * DM : X) + (size_t)(u.pm * BM + wr * 64) * DM + u.pn * BM + wc * 64;
        LAS unsigned char* sw = scr + (wr * 4 + wc) * 2048;
        const int lane = fq * 16 + fr, rr = lane >> 3, c = lane & 7;
        float* drow = base + (size_t)rr * DM + c * 4;
#define RS_OFF(st) ((size_t)((((st) >> 3) & 1) * HALF + (((st) >> 1) & 3) * 16) * DM + ((st) & 1) * 32)
        f32x4 xa[2][4], xb[2][4];
        if (!piece) {
#pragma unroll
            for (int q = 0; q < 4; ++q) { const float* d = drow + RS_OFF(q); xa[0][q] = *(const f32x4*)d; xb[0][q] = *(const f32x4*)(d + 8 * DM); } }
#pragma unroll
        for (int bt = 0; bt < 4; ++bt) {
            if (!piece && bt < 3) {
#pragma unroll
                for (int q = 0; q < 4; ++q) { const float* d = drow + RS_OFF(4 * (bt + 1) + q); xa[(bt + 1) & 1][q] = *(const f32x4*)d; xb[(bt + 1) & 1][q] = *(const f32x4*)(d + 8 * DM); } }
            f32x4 ta[4], tb[4];
#pragma unroll
            for (int q = 0; q < 4; ++q) { const int st = 4 * bt + q, ai = (st >> 3) & 1, m = (st >> 1) & 3, bj = st & 1;
                *(LAS f32x4*)(sw + fr * 128 + (((2 * fq) ^ (fr & 7)) << 4)) = acc[ai][bj][m][0];
                *(LAS f32x4*)(sw + fr * 128 + (((2 * fq + 1) ^ (fr & 7)) << 4)) = acc[ai][bj][m][1];
                ta[q] = *(const LAS f32x4*)(sw + rr * 128 + ((c ^ rr) << 4)); tb[q] = *(const LAS f32x4*)(sw + (8 + rr) * 128 + ((c ^ rr) << 4)); }
#pragma unroll
            for (int q = 0; q < 4; ++q) { const int st = 4 * bt + q;
                f32x4 a = ta[q], b = tb[q];
                float* d = drow + RS_OFF(st);
                if (!piece) { a += xa[bt & 1][q]; b += xb[bt & 1][q]; }
                *(f32x4*)d = a; *(f32x4*)(d + 8 * DM) = b; }
        }
#undef RS_OFF
    }
};
struct EpiUp {
    static constexpr bool HOOK = false;
    bf16* U; LAS unsigned char* scr;
    __device__ __forceinline__ void operator()(const f32x4 (&acc)[2][2][4][2], const Unit& u, int wr, int wc, int fr, int fq) const {
        bf16* base = U + (size_t)(u.pm * BM + wr * 64) * DFF + u.pn * BM + wc * 64; LAS unsigned char* sw = scr + (wr * 4 + wc) * 2048;
#pragma unroll
        for (int ai = 0; ai < 2; ++ai) { u32x4 ra[4], rb[4];
#pragma unroll
            for (int m = 0; m < 4; ++m) {
                f32x4 v0 = acc[ai][0][m][0], v1 = acc[ai][0][m][1], v2 = acc[ai][1][m][0], v3 = acc[ai][1][m][1];
#pragma unroll
                for (int e = 0; e < 4; ++e) { const float a = fmaxf(v0[e], 0.f), b = fmaxf(v1[e], 0.f), c = fmaxf(v2[e], 0.f), d = fmaxf(v3[e], 0.f); v0[e] = a * a; v1[e] = b * b; v2[e] = c * c; v3[e] = d * d; }
                sl_xpose(sw, pk8(v0, v1), pk8(v2, v3), fr, fq, ra[m], rb[m]); }
#pragma unroll
            for (int m = 0; m < 4; ++m) sl_store<true>(ra[m], rb[m], base + (size_t)(ai * HALF + m * 16) * DFF, (size_t)DFF, fr, fq); }
    }
};
}

namespace att {
__device__ __forceinline__ int crow(int r, int hi) { return (r & 3) + 8 * (r >> 2) + 4 * hi; }
__device__ __forceinline__ int v_st(int k, int c) { const int kk = (k & ~0xC) | ((k & 4) << 1) | ((k & 8) >> 1); return ((kk >> 3) * 4 + (c >> 5)) * 512 + ((kk & 7) * 32 + (c & 31)) * 2; }
__device__ __forceinline__ int v_rd_base(int lane) { return ((lane & 3) << 3) | (((lane >> 2) & 3) << 6) | (((lane >> 4) & 1) << 5) | (((lane >> 5) & 1) << 8); }
constexpr int v_rd_off(int d0, int ks, int half) { return d0 * 512 + ks * 4096 + half * 2048; }
template <int OFF> __device__ __forceinline__ s16x4 tr_read(unsigned vb) {
    s16x4 r; asm volatile("ds_read_b64_tr_b16 %0, %1 offset:%2" : "=&v"(r) : "v"(vb), "i"(OFF) : "memory"); return r;
}
template <int DQK> struct Cn {
    static constexpr float SCALE = DQK == 64 ? 0.125f : (DQK == 128 ? 0.08838834764831845f : 0.07216878364870323f);
    static constexpr float C = SCALE * 1.4426950408889634f;
    static constexpr float THRR = 8.f / SCALE;
};
template <int DQK> __device__ __forceinline__ int kswz(int row) { return (DQK == 128 ? (row & 15) : ((row >> 1) & 7)) << 4; }
template <int DQK>
__device__ __forceinline__ void qkt_h(f32x16& p, const f32x16& cinit, const LAS char* Ks, int rowbase, const bf16x8* qr, int r32, int hi) {
    constexpr int KRB = DQK * 2;
    p = cinit;
    const int sw = kswz<DQK>(r32);
#pragma unroll
    for (int d0 = 0; d0 < DQK / 16; ++d0) { const int cb = (d0 * 2 + hi) * 16;
        const bf16x8 b = *(const LAS bf16x8*)(Ks + (rowbase + r32) * KRB + (cb ^ sw));
        p = __builtin_amdgcn_mfma_f32_32x32x16_bf16(b, qr[d0], p, 0, 0, 0); }
}
template <int DQK>
__device__ __forceinline__ void smx_h(f32x16& p, float negB, float& l_acc, bf16x8& paA, bf16x8& paB) {
#pragma unroll
    for (int r = 0; r < 16; ++r) p[r] = __builtin_amdgcn_exp2f(p[r]);
    float s0 = (p[0] + p[1]) + (p[2] + p[3]), s1 = (p[4] + p[5]) + (p[6] + p[7]), s2 = (p[8] + p[9]) + (p[10] + p[11]), s3 = (p[12] + p[13]) + (p[14] + p[15]);
    l_acc += (s0 + s1) + (s2 + s3);
#define PK4(P, BASE, OUT) do { unsigned a0 = cvtpk(P[BASE + 0], P[BASE + 1]), a1 = cvtpk(P[BASE + 2], P[BASE + 3]);   \
    unsigned b0 = cvtpk(P[BASE + 4], P[BASE + 5]), b1 = cvtpk(P[BASE + 6], P[BASE + 7]);                              \
    auto r0 = __builtin_amdgcn_permlane32_swap(a0, b0, false, false); auto r1 = __builtin_amdgcn_permlane32_swap(a1, b1, false, false); \
    u32x4 w = {r0[0], r1[0], r0[1], r1[1]}; OUT = __builtin_bit_cast(bf16x8, w); } while (0)
    PK4(p, 0, paA); PK4(p, 8, paB);
#undef PK4
}
template <int D0, int KS0> __device__ __forceinline__ void pv_half_one(f32x16& od, unsigned vb, bf16x8 paA, bf16x8 paB) {
    s16x4 l0 = tr_read<v_rd_off(D0, KS0, 0)>(vb), h0 = tr_read<v_rd_off(D0, KS0, 1)>(vb), l1 = tr_read<v_rd_off(D0, KS0 + 1, 0)>(vb), h1 = tr_read<v_rd_off(D0, KS0 + 1, 1)>(vb);
    asm volatile("s_waitcnt lgkmcnt(0)" : "+v"(l0), "+v"(h0), "+v"(l1), "+v"(h1) :: "memory");
#define PK(L, H) (bf16x8){L[0], L[1], L[2], L[3], H[0], H[1], H[2], H[3]}
    od = __builtin_amdgcn_mfma_f32_32x32x16_bf16(paA, PK(l0, h0), od, 0, 0, 0);
    od = __builtin_amdgcn_mfma_f32_32x32x16_bf16(paB, PK(l1, h1), od, 0, 0, 0);
#undef PK
}
template <int KS0> __device__ __forceinline__ void pv_half(f32x16* o, unsigned vb, bf16x8 paA, bf16x8 paB) {
#define TR4(D0) s16x4 l0_##D0 = tr_read<v_rd_off(D0, KS0, 0)>(vb), h0_##D0 = tr_read<v_rd_off(D0, KS0, 1)>(vb), l1_##D0 = tr_read<v_rd_off(D0, KS0 + 1, 0)>(vb), h1_##D0 = tr_read<v_rd_off(D0, KS0 + 1, 1)>(vb)
    TR4(0); TR4(1); TR4(2); TR4(3);
#undef TR4
    asm volatile("s_waitcnt lgkmcnt(0)" : "+v"(l0_0), "+v"(h0_0), "+v"(l1_0), "+v"(h1_0), "+v"(l0_1), "+v"(h0_1), "+v"(l1_1), "+v"(h1_1),
                                          "+v"(l0_2), "+v"(h0_2), "+v"(l1_2), "+v"(h1_2), "+v"(l0_3), "+v"(h0_3), "+v"(l1_3), "+v"(h1_3) :: "memory");
#define PK(L, H) (bf16x8){L[0], L[1], L[2], L[3], H[0], H[1], H[2], H[3]}
#define MM(D0) o[D0] = __builtin_amdgcn_mfma_f32_32x32x16_bf16(paA, PK(l0_##D0, h0_##D0), o[D0], 0, 0, 0); o[D0] = __builtin_amdgcn_mfma_f32_32x32x16_bf16(paB, PK(l1_##D0, h1_##D0), o[D0], 0, 0, 0)
    MM(0); MM(1); MM(2); MM(3);
#undef MM
#undef PK
}
struct VFrag { s16x4 l0[4], h0[4], l1[4], h1[4]; };
template <int KS0> __device__ __forceinline__ void pv_issue(VFrag& f, unsigned vb) {
    f.l0[0] = tr_read<v_rd_off(0, KS0, 0)>(vb); f.h0[0] = tr_read<v_rd_off(0, KS0, 1)>(vb); f.l1[0] = tr_read<v_rd_off(0, KS0 + 1, 0)>(vb); f.h1[0] = tr_read<v_rd_off(0, KS0 + 1, 1)>(vb);
    f.l0[1] = tr_read<v_rd_off(1, KS0, 0)>(vb); f.h0[1] = tr_read<v_rd_off(1, KS0, 1)>(vb); f.l1[1] = tr_read<v_rd_off(1, KS0 + 1, 0)>(vb); f.h1[1] = tr_read<v_rd_off(1, KS0 + 1, 1)>(vb);
    f.l0[2] = tr_read<v_rd_off(2, KS0, 0)>(vb); f.h0[2] = tr_read<v_rd_off(2, KS0, 1)>(vb); f.l1[2] = tr_read<v_rd_off(2, KS0 + 1, 0)>(vb); f.h1[2] = tr_read<v_rd_off(2, KS0 + 1, 1)>(vb);
    f.l0[3] = tr_read<v_rd_off(3, KS0, 0)>(vb); f.h0[3] = tr_read<v_rd_off(3, KS0, 1)>(vb); f.l1[3] = tr_read<v_rd_off(3, KS0 + 1, 0)>(vb); f.h1[3] = tr_read<v_rd_off(3, KS0 + 1, 1)>(vb);
}
__device__ __forceinline__ void pv_wait(VFrag& f) {
    asm volatile("s_waitcnt lgkmcnt(0)" : "+v"(f.l0[0]), "+v"(f.h0[0]), "+v"(f.l1[0]), "+v"(f.h1[0]), "+v"(f.l0[1]), "+v"(f.h0[1]), "+v"(f.l1[1]), "+v"(f.h1[1]),
                                          "+v"(f.l0[2]), "+v"(f.h0[2]), "+v"(f.l1[2]), "+v"(f.h1[2]), "+v"(f.l0[3]), "+v"(f.h0[3]), "+v"(f.l1[3]), "+v"(f.h1[3]) :: "memory");
}
__device__ __forceinline__ void pv_mma(f32x16* o, const VFrag& f, bf16x8 paA, bf16x8 paB) {
#define PK(L, H) (bf16x8){L[0], L[1], L[2], L[3], H[0], H[1], H[2], H[3]}
#pragma unroll
    for (int d = 0; d < 4; ++d) { o[d] = __builtin_amdgcn_mfma_f32_32x32x16_bf16(paA, PK(f.l0[d], f.h0[d]), o[d], 0, 0, 0); o[d] = __builtin_amdgcn_mfma_f32_32x32x16_bf16(paB, PK(f.l1[d], f.h1[d]), o[d], 0, 0, 0); }
#undef PK
}
struct UnitP {
    const bf16* Q; int ldq; int nq;
    const bf16* K; int ldk; const bf16* V; int ldv;
    void* O; int ldo;
    int NT;
    int kvalid;
    int lo_base, lo_step, hi_base, hi_step;
    int qpos0, kpos0; const float* tab;
    float negB;
    int fix_lo, fix_hi;
};
constexpr int LDS_ATT_V = 0, LDS_ATT_K = 49152, LDS_ATT_WS = RING_BYTES + 1024, LDS_ATT_TAB = LDS_ATT_WS + 2048, LDS_ATT_END = LDS_ATT_TAB + 1088;
static_assert(LDS_ATT_K + 3 * 24576 <= RING_BYTES && LDS_ATT_WS >= MISC_OFF + 128 && LDS_ATT_END <= EPI_OFF, "attention LDS");

template <int DQK, bool F32OUT, bool BIAS, bool PIPE2>
__device__ __forceinline__ void attn_unit(const UnitP& P, LAS char* lds) {
    constexpr int NQ = DQK / 16, KRB = DQK * 2, KCH = DQK / 8, KP = DQK / 64;
    constexpr int SHM_V = 16384, SHM_K = 64 * DQK * 2;
    constexpr float NEGINF = -__builtin_huge_valf();
    const int tid = fresh_tid(), wid = __builtin_amdgcn_readfirstlane(tid >> 6), lane = tid & 63, r32 = lane & 31, hi = lane >> 5;
    LAS char* V_lds = lds + LDS_ATT_V; LAS char* K_lds = lds + LDS_ATT_K;
    LAS float* ws = (LAS float*)(lds + LDS_ATT_WS) + wid * 64; LAS float* li_l = ws; LAS float* al_l = ws + 32;
    LAS float* tblS = (LAS float*)(lds + LDS_ATT_TAB);
    const int NT = P.NT, kvalid = P.kvalid;
    int lo_w = P.lo_base + P.lo_step * (wid >> 1); lo_w = lo_w < 0 ? 0 : lo_w;
    const int hi_w = P.hi_base + P.hi_step * (wid >> 1);
    float l_reg = 0.f; const float negB = P.negB; f32x16 o[4] = {}; bf16x8 qr[NQ];
    { int qrow = wid * 32 + r32; qrow = qrow < P.nq ? qrow : P.nq - 1;
      const bf16* Qw = P.Q + (size_t)qrow * P.ldq + hi * 8;
#pragma unroll
      for (int d0 = 0; d0 < NQ; ++d0) qr[d0] = *(const bf16x8*)(Qw + d0 * 16); }
    unsigned voffV[2], voffK[KP];
#pragma unroll
    for (int i = 0; i < 2; ++i) { const int b_ = (tid + 512 * i) * 16, st = b_ >> 9, kk = (st >> 2) * 8 + ((b_ & 511) >> 6), c = (st & 3) * 32 + ((b_ & 63) >> 1), k = (kk & ~0xC) | ((kk & 4) << 1) | ((kk & 8) >> 1);
        voffV[i] = (unsigned)(k * P.ldv + c) * 2u; }
#pragma unroll
    for (int p = 0; p < KP; ++p) { const int G = tid + 512 * p, row = G / KCH, slot = G % KCH, g = slot ^ (kswz<DQK>(row) >> 4); voffK[p] = (unsigned)(row * P.ldk + g * 8) * 2u; }
    const unsigned vb0 = (unsigned)(uintptr_t)V_lds + (unsigned)v_rd_base(lane);
    const bf16* Kh = P.K; const bf16* Vh = P.V; const int ldk = P.ldk, ldv = P.ldv;
#define DMA(b, k0) do { const char* vsrc_ = (const char*)(Vh + (size_t)(k0) * ldv); const char* ksrc_ = (const char*)(Kh + (size_t)(k0) * ldk); \
    _Pragma("unroll") for (int i = 0; i < 2; ++i) __builtin_amdgcn_global_load_lds((const unsigned*)(vsrc_ + voffV[i]), (LAS unsigned*)(V_lds + (b) * SHM_V + wid * 1024 + i * 8192), 16, 0, 0); \
    _Pragma("unroll") for (int p = 0; p < KP; ++p) __builtin_amdgcn_global_load_lds((const unsigned*)(ksrc_ + voffK[p]), (LAS unsigned*)(K_lds + (b) * SHM_K + wid * 1024 + p * 8192), 16, 0, 0); } while (0)
#define FIXUP(p0, p1, jt) do { \
    if ((jt) < P.fix_lo || (jt) >= P.fix_hi) { int kv_ = kvalid, lo_ = lo_w, hi_ = hi_w; asm volatile("; masked-tile path" : "+s"(kv_), "+s"(lo_), "+s"(hi_) :: "memory");     \
      if ((jt) < lo_ || (jt) > hi_) { _Pragma("unroll") for (int r = 0; r < 16; ++r) { p0[r] = NEGINF; p1[r] = NEGINF; } } \
      else if (((jt) + 1) * 64 > kv_) { _Pragma("unroll") for (int r = 0; r < 16; ++r) { const int key = (jt) * 64 + crow(r, hi); if (key >= kv_) p0[r] = NEGINF; if (key + 32 >= kv_) p1[r] = NEGINF; } } } \
    if constexpr (BIAS) { if ((jt) >= lo_w && (jt) <= hi_w) { const int kb_ = P.kpos0 + (jt) * 64, qw_ = P.qpos0 + wid * 32; \
        if (qw_ - (kb_ + 63) >= 128) { const float c_ = tblS[256]; _Pragma("unroll") for (int r = 0; r < 16; ++r) { p0[r] += c_; p1[r] += c_; } } \
        else { const int dq_ = qw_ + r32 - kb_; _Pragma("unroll") for (int r = 0; r < 16; ++r) { int d0_ = dq_ - crow(r, hi), d1_ = d0_ - 32; \
            d0_ = d0_ < -128 ? -128 : (d0_ > 128 ? 128 : d0_); d1_ = d1_ < -128 ? -128 : (d1_ > 128 ? 128 : d1_); p0[r] += tblS[d0_ + 128]; p1[r] += tblS[d1_ + 128]; } } } } \
    } while (0)
    f32x16 pA0, pA1; bf16x8 pa0, pa1, pa2, pa3;
    DMA(0, 0); if (1 < NT) DMA(1, 64);
    if constexpr (BIAS) { if (tid < 257) tblS[tid] = P.tab[tid] * 1.4426950408889634f; }
    if (1 < NT) { if constexpr (KP == 1) asm volatile("s_waitcnt vmcnt(3)" ::: "memory"); else if constexpr (KP == 2) asm volatile("s_waitcnt vmcnt(4)" ::: "memory"); else asm volatile("s_waitcnt vmcnt(5)" ::: "memory"); }
    else asm volatile("s_waitcnt vmcnt(0)" ::: "memory");
    asm volatile("s_waitcnt lgkmcnt(0)\n\ts_barrier" ::: "memory");
    if constexpr (!PIPE2) {
#define FIXUP_H(p, jt, kofs) do { \
    if ((jt) < P.fix_lo || (jt) >= P.fix_hi) { int kv_ = kvalid, lo_ = lo_w, hi_ = hi_w; asm volatile("; masked-tile path" : "+s"(kv_), "+s"(lo_), "+s"(hi_) :: "memory"); \
      if ((jt) < lo_ || (jt) > hi_) { _Pragma("unroll") for (int r = 0; r < 16; ++r) p[r] = NEGINF; } \
      else if (((jt) + 1) * 64 > kv_) { _Pragma("unroll") for (int r = 0; r < 16; ++r) { if ((jt) * 64 + (kofs) + crow(r, hi) >= kv_) p[r] = NEGINF; } } } \
    if constexpr (BIAS) { if ((jt) >= lo_w && (jt) <= hi_w) { const int kb_ = P.kpos0 + (jt) * 64 + (kofs), qw_ = P.qpos0 + wid * 32; \
        if (qw_ - (kb_ + 31) >= 128) { const float c_ = tblS[256]; _Pragma("unroll") for (int r = 0; r < 16; ++r) p[r] += c_; } \
        else { const int dq_ = qw_ + r32 - kb_; _Pragma("unroll") for (int r = 0; r < 16; ++r) { int d0_ = dq_ - crow(r, hi); d0_ = d0_ < -128 ? -128 : (d0_ > 128 ? 128 : d0_); p[r] += tblS[d0_ + 128]; } } } } \
    } while (0)
        static_assert(!PIPE2, "q is pre-scaled: only the half-tile loop is current");
        f32x16 cinit;
#pragma unroll
        for (int r = 0; r < 16; ++r) cinit[r] = negB;
        const bool wave_on = wid * 32 < P.nq;
        int bsel = 0;
        for (int j = 0; j < NT; ++j) {
            const int bn1 = bsel == 2 ? 0 : bsel + 1, bn2 = bn1 == 2 ? 0 : bn1 + 1;
            if (j + 2 < NT) DMA(bn2, (j + 2) * 64);
            if (wave_on && j >= lo_w && j <= hi_w) {
            SBAR(); qkt_h<DQK>(pA0, cinit, K_lds + bsel * SHM_K, 0, qr, r32, hi);
            FIXUP_H(pA0, j, 0);
            SBAR(); qkt_h<DQK>(pA1, cinit, K_lds + bsel * SHM_K, 32, qr, r32, hi); smx_h<DQK>(pA0, negB, l_reg, pa0, pa1);
            FIXUP_H(pA1, j, 32);
            if constexpr (true) {
                VFrag f0, f2; SBAR(); pv_issue<0>(f0, vb0 + bsel * SHM_V); pv_wait(f0); pv_issue<2>(f2, vb0 + bsel * SHM_V);
                pv_mma(o, f0, pa0, pa1); smx_h<DQK>(pA1, negB, l_reg, pa2, pa3);
                SBAR(); pv_wait(f2); pv_mma(o, f2, pa2, pa3); SBAR();
            } else {
            SBAR(); pv_half<0>(o, vb0 + bsel * SHM_V, pa0, pa1); smx_h<DQK>(pA1, negB, l_reg, pa2, pa3);
            SBAR(); pv_half<2>(o, vb0 + bsel * SHM_V, pa2, pa3); SBAR();
            }
            }
            if (j + 2 < NT) { if constexpr (KP == 1) asm volatile("s_waitcnt vmcnt(3) lgkmcnt(0)\n\ts_barrier" ::: "memory"); else if constexpr (KP == 2) asm volatile("s_waitcnt vmcnt(4) lgkmcnt(0)\n\ts_barrier" ::: "memory"); else asm volatile("s_waitcnt vmcnt(5) lgkmcnt(0)\n\ts_barrier" ::: "memory"); }
            else asm volatile("s_waitcnt vmcnt(0) lgkmcnt(0)\n\ts_barrier" ::: "memory");
            bsel = bn1;
        }
#undef FIXUP_H
    }
    { auto rr = __builtin_amdgcn_permlane32_swap(__float_as_uint(l_reg), __float_as_uint(l_reg), false, false); l_reg = __uint_as_float(rr[0]) + __uint_as_float(rr[1]); }
    if (hi == 0) li_l[r32] = l_reg; asm volatile("s_waitcnt lgkmcnt(0)" ::: "memory");
    float rli[16];
#pragma unroll
    for (int r = 0; r < 16; ++r) rli[r] = __builtin_amdgcn_rcpf(li_l[crow(r, hi)]);
    const int nq = P.nq, ldo = P.ldo;
#pragma unroll
    for (int r = 0; r < 16; ++r) { const int orow = wid * 32 + crow(r, hi);
        if (orow < nq) {
            if constexpr (F32OUT) { float* Ow = (float*)P.O + (size_t)orow * ldo + r32;
#pragma unroll
                for (int d0 = 0; d0 < 4; ++d0) Ow[d0 * 32] = o[d0][r] * rli[r]; }
            else { bf16* Ow = (bf16*)P.O + (size_t)orow * ldo + r32;
#pragma unroll
                for (int d0 = 0; d0 < 4; ++d0) Ow[d0 * 32] = (bf16)(cvtpk(o[d0][r] * rli[r], 0.f) & 0xffffu); }
        } }
    __syncthreads();
#undef DMA
#undef FIXUP
}
}

template <class T> __device__ __forceinline__ T* launder(T* p) { asm volatile("" : "+s"(p)); return p; }
struct Frame {
    LAS unsigned char* lds;
    int tid, lane, wave, vcu, G, bx;
    int gw, NGW;
    float* out; unsigned char* ws;
};
struct Args { const float* in[31]; float* out; unsigned char* ws; int ph_lo, ph_hi; int use_bar, pad; };
typedef const __attribute__((address_space(4))) Args* ArgsP;
__device__ __forceinline__ ArgsP fresh_args() { ArgsP p = (ArgsP)__builtin_amdgcn_kernarg_segment_ptr(); asm volatile("" : "+s"(p)); return p; }
enum { I_XP = 0, I_XS, I_CAK, I_CAV, I_CBC, I_CBP, I_CCK, I_CCV, I_ANORM, I_WIN, I_BGATE, I_AQN, I_AKN, I_ALAM, I_ASUB, I_BQAN, I_BKVN, I_WQB, I_WKVB, I_BQN, I_BKN, I_CQN, I_CKN, I_CBIAS,
       I_WBRA, I_WBRB, I_WBRC, I_WO, I_MNORM, I_WUP, I_WDN };

__device__ __forceinline__ void transpose_item(const float* W, int K, int N, bf16* WT, int ldw, int gap_at, int gap, LAS float* scr, int item, int lane) {
    const int nblk = N / 32, kb = item / nblk, nb = item % nblk, k0 = 64 * kb, n0 = 32 * nb;
    float t[32];
#pragma unroll
    for (int i = 0; i < 32; ++i) t[i] = W[(size_t)(k0 + 2 * i + (lane >> 5)) * N + n0 + (lane & 31)];
#pragma unroll
    for (int i = 0; i < 32; ++i) scr[(2 * i + (lane >> 5)) * 33 + (lane & 31)] = t[i];
    LDS_WAIT(); asm volatile("" ::: "memory");
    const int c = lane & 7; const int roff = (n0 >= gap_at) ? gap : 0;
#pragma unroll
    for (int j = 0; j < 4; ++j) { const int n = (lane >> 3) + 8 * j; const LAS float* s = scr + (8 * c) * 33 + n;
        u32x4 o; o.x = cvtpk(s[0 * 33], s[1 * 33]); o.y = cvtpk(s[2 * 33], s[3 * 33]); o.z = cvtpk(s[4 * 33], s[5 * 33]); o.w = cvtpk(s[6 * 33], s[7 * 33]);
        *(u32x4*)(WT + (size_t)(roff + n0 + n) * ldw + k0 + 8 * c) = o; }
    LDS_WAIT(); asm volatile("" ::: "memory");
}

__device__ __forceinline__ void rmsnorm_rows(const Frame& F, ArgsP A, const float* g, bf16* H, bool first, const float* slab, int ns) {
    float* X = F.out + OUT_Y;
    if (!first) {
        LAS float* part = (LAS float*)(F.lds + EPI_OFF);
        for (int rs = F.vcu; rs < MS; rs += F.G) {
            const size_t off = (size_t)rs * DM + 256 * F.wave + 4 * F.lane;
            f32x4 v = *(const f32x4*)(X + (size_t)MP * DM + off);
            const float* sp = slab + off;
            for (int k = 0; k < ns; k += 8) { f32x4 t[8];
#pragma unroll
                for (int q = 0; q < 8; ++q) t[q] = *(const f32x4*)(sp + (size_t)(k + q) * MS * DM);
#pragma unroll
                for (int q = 0; q < 8; ++q) v += t[q]; }
            const float ps = wave_sum((v.x * v.x + v.y * v.y) + (v.z * v.z + v.w * v.w));
            __syncthreads();
            if (F.lane == 0) part[F.wave] = ps;
            __syncthreads();
            float tot = 0.f;
#pragma unroll
            for (int w = 0; w < 8; ++w) tot += part[w];
            const float rstd = rsqrtf(tot * (1.f / DM) + EPS);
            const f32x4 gg = *(const f32x4*)(g + 256 * F.wave + 4 * F.lane);
            u32x2 w; w.x = cvtpk(v.x * rstd * gg.x, v.y * rstd * gg.y); w.y = cvtpk(v.z * rstd * gg.z, v.w * rstd * gg.w);
            *(u32x2*)(H + (size_t)MP * DM + off) = w;
            *(f32x4*)(X + (size_t)MP * DM + off) = v;
        }
    }
    constexpr int RU = 4;
    const int Rn = first ? M : MP;
    f32x4 gg[8];
#pragma unroll
    for (int j = 0; j < 8; ++j) gg[j] = *(const f32x4*)(g + 4 * F.lane + 256 * j);
    for (int row0 = F.gw; row0 < Rn; row0 += RU * F.NGW) {
        f32x4 v[RU][8];
#pragma unroll
        for (int u = 0; u < RU; ++u) { const int row = row0 + u * F.NGW;
            if (row < Rn) { const float* xr = first ? (row < MP ? A->in[I_XP] + (size_t)row * DM : A->in[I_XS] + (size_t)(row - MP) * DM) : X + (size_t)row * DM;
#pragma unroll
                for (int j = 0; j < 8; ++j) v[u][j] = *(const f32x4*)(xr + 4 * F.lane + 256 * j); } }
#pragma unroll
        for (int u = 0; u < RU; ++u) { const int row = row0 + u * F.NGW;
            if (row < Rn) {
                float ss = 0.f;
#pragma unroll
                for (int j = 0; j < 8; ++j) ss += (v[u][j].x * v[u][j].x + v[u][j].y * v[u][j].y) + (v[u][j].z * v[u][j].z + v[u][j].w * v[u][j].w);
                const float rstd = rsqrtf(wave_sum(ss) * (1.f / DM) + EPS);
#pragma unroll
                for (int j = 0; j < 8; ++j) {
                    u32x2 w; w.x = cvtpk(v[u][j].x * rstd * gg[j].x, v[u][j].y * rstd * gg[j].y); w.y = cvtpk(v[u][j].z * rstd * gg[j].z, v[u][j].w * rstd * gg[j].w);
                    *(u32x2*)(H + (size_t)row * DM + 4 * F.lane + 256 * j) = w;
                    if (first) *(f32x4*)(X + (size_t)row * DM + 4 * F.lane + 256 * j) = v[u][j]; } } }
    }
}
__device__ __forceinline__ void final_combine(const Frame& F, const float* slab, int ns) {
    float* X = F.out + OUT_Y;
    for (int rs = F.vcu; rs < MS; rs += F.G) {
        const size_t off = (size_t)rs * DM + 256 * F.wave + 4 * F.lane;
        f32x4 v = *(const f32x4*)(X + (size_t)MP * DM + off);
        const float* sp = slab + off;
        for (int k = 0; k < ns; k += 8) { f32x4 t[8];
#pragma unroll
            for (int q = 0; q < 8; ++q) t[q] = *(const f32x4*)(sp + (size_t)(k + q) * MS * DM);
#pragma unroll
            for (int q = 0; q < 8; ++q) v += t[q]; }
        *(f32x4*)(X + (size_t)MP * DM + off) = v;
    }
}
__device__ __forceinline__ void pre_weights(const Frame& F, ArgsP A, int l, unsigned char* wsw, int gw, int NGW, int it_lo = 0, int it_hi = 1 << 30) {
    LAS float* scr = (LAS float*)(F.lds + F.wave * 16384);
    constexpr int I_IN = (DM / 64) * (INCOLS / 32), I_QB = (512 / 64) * (1536 / 32), I_KVB = (256 / 64) * (2048 / 32), I_BA = (512 / 64) * (DM / 32), I_BB = (1024 / 64) * (DM / 32),
                  I_O = (DM / 64) * (DM / 32), I_UP = (DM / 64) * (DFF / 32), I_DN = (DFF / 64) * (DM / 32);
    constexpr int NITEMS = I_IN + I_QB + I_KVB + 2 * I_BA + I_BB + I_O + I_UP + I_DN;
    const int it_end = it_hi < NITEMS ? it_hi : NITEMS;
    for (int it = it_lo + gw; it < it_end; it += NGW) {
        int r = it;
        if (r < I_IN) { transpose_item(A->in[I_WIN] + (size_t)l * DM * INCOLS, DM, INCOLS, (bf16*)(wsw + WS_WIN), DM, 2368, 192, scr, r, F.lane); continue; } r -= I_IN;
        if (r < I_QB) { transpose_item(A->in[I_WQB] + (size_t)l * 512 * 1536, 512, 1536, (bf16*)(wsw + WS_WQB), 512, 1 << 30, 0, scr, r, F.lane); continue; } r -= I_QB;
        if (r < I_KVB) { transpose_item(A->in[I_WKVB] + (size_t)l * 256 * 2048, 256, 2048, (bf16*)(wsw + WS_WKVB), 256, 1 << 30, 0, scr, r, F.lane); continue; } r -= I_KVB;
        if (r < I_BA) { transpose_item(A->in[I_WBRA] + (size_t)l * 512 * DM, 512, DM, (bf16*)(wsw + WS_WBR), DM, 1 << 30, 0, scr, r, F.lane); continue; } r -= I_BA;
        if (r < I_BB) { transpose_item(A->in[I_WBRB] + (size_t)l * 1024 * DM, 1024, DM, (bf16*)(wsw + WS_WBR) + 512, DM, 1 << 30, 0, scr, r, F.lane); continue; } r -= I_BB;
        if (r < I_BA) { transpose_item(A->in[I_WBRC] + (size_t)l * 512 * DM, 512, DM, (bf16*)(wsw + WS_WBR) + 1536, DM, 1 << 30, 0, scr, r, F.lane); continue; } r -= I_BA;
        if (r < I_O) { transpose_item(A->in[I_WO] + (size_t)l * DM * DM, DM, DM, (bf16*)(wsw + WS_WO), DM, 1 << 30, 0, scr, r, F.lane); continue; } r -= I_O;
        if (r < I_UP) { transpose_item(A->in[I_WUP] + (size_t)l * DM * DFF, DM, DFF, (bf16*)(wsw + WS_WUP), DM, 1 << 30, 0, scr, r, F.lane); continue; } r -= I_UP;
        transpose_item(A->in[I_WDN] + (size_t)l * DFF * DM, DFF, DM, (bf16*)(wsw + WS_WDN), DFF, 1 << 30, 0, scr, r, F.lane);
    }
    const int gt = gw * 64 + F.lane, NGT = NGW * 64;
    if (it_lo == 0) {
        bf16* wz = (bf16*)(wsw + WS_WIN) + (size_t)2368 * DM;
        for (int i = gt; i < 192 * DM / 8; i += NGT) *(u32x4*)(wz + (size_t)i * 8) = (u32x4){0u, 0u, 0u, 0u};
    }
}
__device__ __forceinline__ void pre_caches(const Frame& F, ArgsP A, int l, int gw, int NGW) {
    unsigned char* ws = F.ws; const int gt = gw * 64 + F.lane, NGT = NGW * 64;
    {
        bf16* KA = (bf16*)(ws + WS_KA); bf16* VA = (bf16*)(ws + WS_VA); bf16* CKV = (bf16*)(ws + WS_CKV); float* KPE = (float*)(ws + WS_KPE); bf16* KC = (bf16*)(ws + WS_KC); bf16* VC = (bf16*)(ws + WS_VC);
        const float* cak = A->in[I_CAK] + (size_t)l * DECB * PAST * 512; const float* cav = A->in[I_CAV] + (size_t)l * DECB * PAST * 512;
        const float* cbc = A->in[I_CBC] + (size_t)l * DECB * PAST * 256; const float* cbp = A->in[I_CBP] + (size_t)l * DECB * PAST * 64;
        const float* cck = A->in[I_CCK] + (size_t)l * DECB * CPAST * 512; const float* ccv = A->in[I_CCV] + (size_t)l * DECB * CPAST * 512;
        for (int i0 = gt; i0 < DECB * PAST * 512 / 8; i0 += 4 * NGT) { f32x4 ka[4][2], va[4][2];
#pragma unroll
            for (int u = 0; u < 4; ++u) { const int i = i0 + u * NGT; if (i < DECB * PAST * 512 / 8) { const float* pk = cak + (size_t)i * 8; const float* pv = cav + (size_t)i * 8;
                ka[u][0] = *(const f32x4*)pk; ka[u][1] = *(const f32x4*)(pk + 4); va[u][0] = *(const f32x4*)pv; va[u][1] = *(const f32x4*)(pv + 4); } }
#pragma unroll
            for (int u = 0; u < 4; ++u) { const int i = i0 + u * NGT; if (i < DECB * PAST * 512 / 8) { const int c = (i & 63) * 8, rr = i >> 6, b = rr >> 11, p = rr & 2047; const size_t d = ((size_t)MP + b * SROWS + p) * 512 + c;
                *(u32x4*)(KA + d) = pg8::pk8(ka[u][0], ka[u][1]); *(u32x4*)(VA + d) = pg8::pk8(va[u][0], va[u][1]); } } }
        for (int i0 = gt; i0 < DECB * PAST * 256 / 8; i0 += 4 * NGT) { f32x4 ka[4][2];
#pragma unroll
            for (int u = 0; u < 4; ++u) { const int i = i0 + u * NGT; if (i < DECB * PAST * 256 / 8) { const float* pk = cbc + (size_t)i * 8; ka[u][0] = *(const f32x4*)pk; ka[u][1] = *(const f32x4*)(pk + 4); } }
#pragma unroll
            for (int u = 0; u < 4; ++u) { const int i = i0 + u * NGT; if (i < DECB * PAST * 256 / 8) { const int c = (i & 31) * 8, rr = i >> 5, b = rr >> 11, p = rr & 2047; const size_t d = ((size_t)MP + b * SROWS + p) * 256 + c;
                *(u32x4*)(CKV + d) = pg8::pk8(ka[u][0], ka[u][1]); } } }
        for (int i = gt; i < DECB * PAST * 64 / 8; i += NGT) { const int c = (i & 7) * 8, rr = i >> 3, b = rr >> 11, p = rr & 2047; const size_t d = ((size_t)MP + b * SROWS + p) * 64 + c;
            float v[8]; ld8f(cbp + (size_t)i * 8, v); st8f(KPE + d, v); }
        for (int i0 = gt; i0 < DECB * CPAST * 512 / 8; i0 += 4 * NGT) { f32x4 ka[4][2], va[4][2];
#pragma unroll
            for (int u = 0; u < 4; ++u) { const int i = i0 + u * NGT; if (i < DECB * CPAST * 512 / 8) { const float* pk = cck + (size_t)i * 8; const float* pv = ccv + (size_t)i * 8;
                ka[u][0] = *(const f32x4*)pk; ka[u][1] = *(const f32x4*)(pk + 4); va[u][0] = *(const f32x4*)pv; va[u][1] = *(const f32x4*)(pv + 4); } }
#pragma unroll
            for (int u = 0; u < 4; ++u) { const int i = i0 + u * NGT; if (i < DECB * CPAST * 512 / 8) { const int c = (i & 63) * 8, rr = i >> 6, b = rr >> 9, p = rr & 511; const size_t d = ((size_t)MP + b * CROWS + p) * 512 + c;
                *(u32x4*)(KC + d) = pg8::pk8(ka[u][0], ka[u][1]); *(u32x4*)(VC + d) = pg8::pk8(va[u][0], va[u][1]); } } }
        const u32x4 z4 = (u32x4){0u, 0u, 0u, 0u};
        for (int i = gt; i < DECB * 112 * 64; i += NGT) { const int c = (i & 63) * 8, rr = i >> 6, b = rr / 112, p = rr % 112;
            const size_t d = ((size_t)MP + b * SROWS + PAST + DECS + p) * 512 + c; *(u32x4*)(KA + d) = z4; *(u32x4*)(VA + d) = z4;
            const size_t dc = ((size_t)MP + b * CROWS + CPAST + DECS + p) * 512 + c; *(u32x4*)(KC + dc) = z4; *(u32x4*)(VC + dc) = z4; }
        for (int i = gt; i < DECB * 112 * 32; i += NGT) { const int c = (i & 31) * 8, rr = i >> 5, b = rr / 112, p = rr % 112;
            const size_t d = ((size_t)MP + b * SROWS + PAST + DECS + p) * 256 + c; *(u32x4*)(CKV + d) = z4; }
        for (int i = gt; i < DECB * 112 * 16; i += NGT) { const int c = (i & 15) * 4, rr = i >> 4, b = rr / 112, p = rr % 112;
            const size_t d = ((size_t)MP + b * SROWS + PAST + DECS + p) * 64 + c; *(f32x4*)(KPE + d) = (f32x4){0.f, 0.f, 0.f, 0.f}; }
    }
}
constexpr size_t WS_SLAB_O = WS_R2, WS_SLAB_DN = WS_R2 + 64 * MiB;
constexpr int NS_O = 16, NS_DN = 32;
static_assert(NS_O % 8 == 0 && NS_DN % 8 == 0 && (size_t)NS_O * MS * DM * 4 <= 64 * MiB && (size_t)NS_DN * MS * DM * 4 <= 64 * MiB && WS_SLAB_DN + 64 * MiB <= WS_OALL, "slabs");
constexpr int WCUT1 = 13000, WCUT2 = 26500;
constexpr size_t WS_WSET1 = 1823 * MiB;
static_assert(WS_WDN + WS_WSET1 + (size_t)DM * DFF * 2 <= 2032 * MiB && WS_WIN + WS_WSET1 >= WS_END, "second weight set");
__device__ __forceinline__ void phase_pre(const Frame& F, ArgsP A, int l) {
    if (l == 0) { pre_weights(F, A, 0, F.ws, F.gw, F.NGW); pre_caches(F, A, 0, F.gw, F.NGW); }
    rmsnorm_rows(F, A, A->in[I_ANORM] + (size_t)l * DM, (bf16*)(F.ws + WS_R3), l == 0, (const float*)(F.ws + WS_SLAB_DN), NS_DN);
}

__device__ __forceinline__ float rope_inv(int lane) { return __builtin_amdgcn_exp2f(-(float)(lane & 31) * (18.931568569324174f / 32.f)); }
__device__ __forceinline__ void rope_cs(int pos, float inv, float& cs, float& sn) {
    const float a = (float)pos * inv; const float k = rintf(a * 0.15915494309189535f);
    float r = fmaf(-k, 6.28125f, a); r = fmaf(-k, 1.9353071795864769e-3f, r);
    const float rev = r * 0.15915494309189535f;
    cs = __builtin_amdgcn_cosf(rev); sn = __builtin_amdgcn_sinf(rev);
}

__device__ __forceinline__ void phase_post_in(const Frame& F, ArgsP A, int l) {
    unsigned char* ws = F.ws; const int lane = F.lane;
    const bf16* Z = (const bf16*)(ws + WS_R1);
    bf16* QA = (bf16*)(ws + WS_QA); bf16* KA = (bf16*)(ws + WS_KA); bf16* VA = (bf16*)(ws + WS_VA); bf16* CQ = (bf16*)(ws + WS_CQ); bf16* CKV = (bf16*)(ws + WS_CKV); float* KPE = (float*)(ws + WS_KPE);
    bf16* QC = (bf16*)(ws + WS_QC); bf16* KC = (bf16*)(ws + WS_KC); bf16* VC = (bf16*)(ws + WS_VC);
    const float inv = rope_inv(lane);
    float gq[8], gk[8], gqa[8], gkv[8], gcq[8], gck[8];
    ld8f(A->in[I_AQN] + l * 64 + 8 * (lane & 7), gq); ld8f(A->in[I_AKN] + l * 64 + 8 * (lane & 7), gk);
    ld8f(A->in[I_BQAN] + l * 512 + 8 * lane, gqa); ld8f(A->in[I_BKVN] + l * 256 + 8 * (lane & 31), gkv);
    ld8f(A->in[I_CQN] + l * 128 + 8 * (lane & 15), gcq); ld8f(A->in[I_CKN] + l * 128 + 8 * (lane & 15), gck);
    u32x4 zc[8], zn[8];
    if (F.gw < M) {
#pragma unroll
        for (int q = 0; q < 8; ++q) zc[q] = *(const u32x4*)(Z + (size_t)F.gw * NZ + 8 * lane + 512 * q); }
    for (int row = F.gw; row < M; row += F.NGW) {
        { const int nrow = row + F.NGW;
          if (nrow < M) {
#pragma unroll
              for (int q = 0; q < 8; ++q) zn[q] = *(const u32x4*)(Z + (size_t)nrow * NZ + 8 * lane + 512 * q); } }
        const bool samp = row >= MP; int b, t, pos;
        if (!samp) { b = row >> 14; t = row & (SEQ - 1); pos = t; } else { const int r = row - MP; b = r >> 4; t = r & 15; pos = PAST + t; }
        const size_t kvrow = samp ? (size_t)MP + b * SROWS + PAST + t : (size_t)row;
        const size_t ccrow = samp ? (size_t)MP + b * CROWS + CPAST + t : (size_t)row;
        float* o_ak = F.out + (samp ? OUT_AK_S + ((size_t)l * MS + (row - MP)) * 512 : OUT_AK_P + ((size_t)l * MP + row) * 512) + 8 * lane;
        float* o_av = F.out + (samp ? OUT_AV_S + ((size_t)l * MS + (row - MP)) * 512 : OUT_AV_P + ((size_t)l * MP + row) * 512) + 8 * lane;
        float* o_bc = F.out + (samp ? OUT_BC_S + ((size_t)l * MS + (row - MP)) * 256 : OUT_BC_P + ((size_t)l * MP + row) * 256) + 8 * (lane & 31);
        float* o_bp = F.out + (samp ? OUT_BP_S + ((size_t)l * MS + (row - MP)) * 64 : OUT_BP_P + ((size_t)l * MP + row) * 64) + 8 * (lane & 7);
        const bool cout = samp || t >= SEQ - 512;
        float* o_ck = F.out + (samp ? OUT_CK_S + ((size_t)l * MS + (row - MP)) * 512 : OUT_CK_P + (((size_t)l * NBATCH + b) * 512 + (t - (SEQ - 512))) * 512) + 8 * lane;
        float* o_cv = F.out + (samp ? OUT_CV_S + ((size_t)l * MS + (row - MP)) * 512 : OUT_CV_P + (((size_t)l * NBATCH + b) * 512 + (t - (SEQ - 512))) * 512) + 8 * lane;
        float cs, sn; rope_cs(pos, inv, cs, sn);
        float v[8], y[8];
#pragma unroll
        for (int seg = 0; seg < 2; ++seg) {
            unpack8(zc[seg], v);
            float ss = sumsq8(v); ss += __shfl_xor(ss, 1); ss += __shfl_xor(ss, 2); ss += __shfl_xor(ss, 4);
            const float rstd = rsqrtf(ss * (1.f / 64) + EPS);
#pragma unroll
            for (int e = 0; e < 8; ++e) y[e] = v[e] * rstd * (seg == 0 ? gq[e] : gk[e]);
#pragma unroll
            for (int e = 0; e < 8; ++e) { const float part = __shfl_xor(y[e], 1), c = __shfl(cs, 4 * e), s = __shfl(sn, 4 * e);
                if ((lane & 7) == 0) y[e] = y[e] * c - part * s; else if ((lane & 7) == 1) y[e] = y[e] * c + part * s; }
            if (seg == 0) { float yq[8];
#pragma unroll
                for (int e = 0; e < 8; ++e) yq[e] = y[e] * att::Cn<64>::C;
                *(u32x4*)(QA + (size_t)row * 512 + 8 * lane) = pack8(yq); }
            else { *(u32x4*)(KA + kvrow * 512 + 8 * lane) = pack8(y); st8f_nt(o_ak, y); }
        }
        { const u32x4 w = zc[2]; *(u32x4*)(VA + kvrow * 512 + 8 * lane) = w; unpack8(w, v); st8f_nt(o_av, v); }
        { unpack8(zc[3], v); const float rstd = rsqrtf(wave_sum(sumsq8(v)) * (1.f / 512) + EPS);
#pragma unroll
          for (int e = 0; e < 8; ++e) y[e] = v[e] * rstd * gqa[e];
          *(u32x4*)(CQ + (size_t)row * 512 + 8 * lane) = pack8(y); }
        { unpack8(zc[4], v);
          float ss = sumsq8(v); ss += __shfl_xor(ss, 1); ss += __shfl_xor(ss, 2); ss += __shfl_xor(ss, 4); ss += __shfl_xor(ss, 8); ss += __shfl_xor(ss, 16);
          const float rstd = rsqrtf(ss * (1.f / 256) + EPS);
          const int i = lane & 7;
#pragma unroll
          for (int e = 0; e < 8; ++e) { const float part = __shfl_xor(v[e], 4); const int fi = 8 * (i & 3) + e; const float c = __shfl(cs, fi), s = __shfl(sn, fi);
              y[e] = (lane < 32) ? v[e] * rstd * gkv[e] : ((i < 4) ? v[e] * c - part * s : v[e] * c + part * s); }
          if (lane < 32) { *(u32x4*)(CKV + kvrow * 256 + 8 * lane) = pack8(y); st8f_nt(o_bc, y); }
          else if (lane < 40) { st8f(KPE + kvrow * 64 + 8 * i, y); st8f_nt(o_bp, y); } }
#pragma unroll
        for (int seg = 0; seg < 2; ++seg) {
            unpack8(zc[5 + seg], v);
            float ss = sumsq8(v); ss += __shfl_xor(ss, 1); ss += __shfl_xor(ss, 2); ss += __shfl_xor(ss, 4); ss += __shfl_xor(ss, 8);
            const float rstd = rsqrtf(ss * (1.f / 128) + EPS);
#pragma unroll
            for (int e = 0; e < 8; ++e) y[e] = v[e] * rstd * (seg == 0 ? gcq[e] * att::Cn<128>::C : gck[e]);
            if (seg == 0) *(u32x4*)(QC + (size_t)row * 512 + 8 * lane) = pack8(y);
            else { *(u32x4*)(KC + ccrow * 512 + 8 * lane) = pack8(y); if (cout) st8f_nt(o_ck, y); }
        }
        { const u32x4 w = zc[7]; *(u32x4*)(VC + ccrow * 512 + 8 * lane) = w; if (cout) { unpack8(w, v); st8f_nt(o_cv, v); } }
#pragma unroll
        for (int q = 0; q < 8; ++q) zc[q] = zn[q];
    }
}

__device__ __forceinline__ void phase_post_b(const Frame& F, ArgsP A, int l) {
    unsigned char* ws = F.ws; const int lane = F.lane, h = lane >> 3, i = lane & 7;
    const bf16* QBR = (const bf16*)(ws + WS_R2); const bf16* KVR = (const bf16*)(ws + WS_R1); const float* KPE = (const float*)(ws + WS_KPE);
    bf16* QB = (bf16*)(ws + WS_QB); bf16* KB = (bf16*)(ws + WS_R3);
    const float inv = rope_inv(lane);
    float g0[8], g1[8], g2[8];
    ld8f(A->in[I_BQN] + l * 192 + 8 * i, g0); ld8f(A->in[I_BQN] + l * 192 + 64 + 8 * i, g1); ld8f(A->in[I_BQN] + l * 192 + 128 + 8 * i, g2);
    constexpr int RU = 4;
    for (int row0 = F.gw; row0 < M; row0 += RU * F.NGW) {
        u32x4 w0[RU], w1[RU], w2[RU];
#pragma unroll
        for (int u = 0; u < RU; ++u) { const int row = row0 + u * F.NGW;
            if (row < M) { const bf16* src = QBR + (size_t)row * 1536 + 192 * h + 8 * i; w0[u] = *(const u32x4*)src; w1[u] = *(const u32x4*)(src + 64); w2[u] = *(const u32x4*)(src + 128); } }
#pragma unroll
        for (int u = 0; u < RU; ++u) { const int row = row0 + u * F.NGW;
            if (row < M) {
                const int pos = row < MP ? (row & (SEQ - 1)) : PAST + ((row - MP) & 15);
                float cs, sn; rope_cs(pos, inv, cs, sn);
                float v0[8], v1[8], v2[8]; unpack8(w0[u], v0); unpack8(w1[u], v1); unpack8(w2[u], v2);
#pragma unroll
                for (int e = 0; e < 8; ++e) { const float part = __shfl_xor(v2[e], 4); const int fi = 8 * (i & 3) + e; const float c = __shfl(cs, fi), s = __shfl(sn, fi);
                    v2[e] = (i < 4) ? v2[e] * c - part * s : v2[e] * c + part * s; }
                float ss = sumsq8(v0) + sumsq8(v1) + sumsq8(v2); ss += __shfl_xor(ss, 1); ss += __shfl_xor(ss, 2); ss += __shfl_xor(ss, 4);
                const float rstd = rsqrtf(ss * (1.f / 192) + EPS);
#pragma unroll
                for (int e = 0; e < 8; ++e) { v0[e] *= rstd * g0[e] * att::Cn<192>::C; v1[e] *= rstd * g1[e] * att::Cn<192>::C; v2[e] *= rstd * g2[e] * att::Cn<192>::C; }
                bf16* dst = QB + (size_t)row * 1536 + 192 * h + 8 * i;
                *(u32x4*)dst = pack8(v0); *(u32x4*)(dst + 64) = pack8(v1); *(u32x4*)(dst + 128) = pack8(v2); } }
    }
    ld8f(A->in[I_BKN] + l * 192 + 8 * i, g0); ld8f(A->in[I_BKN] + l * 192 + 64 + 8 * i, g1); ld8f(A->in[I_BKN] + l * 192 + 128 + 8 * i, g2);
    for (int row0 = F.gw; row0 < M2; row0 += RU * F.NGW) {
        u32x4 w0[RU], w1[RU]; f32x4 p0[RU], p1[RU];
#pragma unroll
        for (int u = 0; u < RU; ++u) { const int row = row0 + u * F.NGW;
            if (row < M2) { const bf16* src = KVR + (size_t)row * 2048 + 256 * h + 8 * i; w0[u] = *(const u32x4*)src; w1[u] = *(const u32x4*)(src + 64);
                const float* kp = KPE + (size_t)row * 64 + 8 * i; p0[u] = *(const f32x4*)kp; p1[u] = *(const f32x4*)(kp + 4); } }
#pragma unroll
        for (int u = 0; u < RU; ++u) { const int row = row0 + u * F.NGW;
            if (row < M2) {
                float v0[8], v1[8], v2[8]; unpack8(w0[u], v0); unpack8(w1[u], v1);
                v2[0] = p0[u].x; v2[1] = p0[u].y; v2[2] = p0[u].z; v2[3] = p0[u].w; v2[4] = p1[u].x; v2[5] = p1[u].y; v2[6] = p1[u].z; v2[7] = p1[u].w;
                float ss = sumsq8(v0) + sumsq8(v1) + sumsq8(v2); ss += __shfl_xor(ss, 1); ss += __shfl_xor(ss, 2); ss += __shfl_xor(ss, 4);
                const float rstd = rsqrtf(ss * (1.f / 192) + EPS);
#pragma unroll
                for (int e = 0; e < 8; ++e) { v0[e] *= rstd * g0[e]; v1[e] *= rstd * g1[e]; v2[e] *= rstd * g2[e]; }
                bf16* dst = KB + (size_t)row * 1536 + 192 * h + 8 * i;
                *(u32x4*)dst = pack8(v0); *(u32x4*)(dst + 64) = pack8(v1); *(u32x4*)(dst + 128) = pack8(v2); } }
    }
}

__device__ __forceinline__ void phase_post_a(const Frame& F, ArgsP A, int l) {
    unsigned char* ws = F.ws; const int lane = F.lane, h = lane >> 4, i = lane & 15;
    const float* OAR = (const float*)(ws + WS_R2); bf16* OA = (bf16*)(ws + WS_OALL);
    const float* lf = A->in[I_ALAM] + l * 256;
    const float s1 = wave_sum(lf[lane] * lf[64 + lane]), s2 = wave_sum(lf[128 + lane] * lf[192 + lane]);
    const float lam_init = 0.8f - 0.6f * expf(-0.3f * (float)l);
    const float lam = expf(s1) - expf(s2) + lam_init, og = 1.f - lam_init;
    float g[8]; ld8f(A->in[I_ASUB] + l * 128 + 8 * i, g);
    constexpr int RU = 4;
    for (int row0 = F.gw; row0 < M; row0 += RU * F.NGW) {
        f32x4 a0[RU], a1[RU], b0[RU], b1[RU];
#pragma unroll
        for (int u = 0; u < RU; ++u) { const int row = row0 + u * F.NGW;
            if (row < M) { const float* src = OAR + (size_t)row * 1024 + 256 * h + 8 * i; a0[u] = *(const f32x4*)src; a1[u] = *(const f32x4*)(src + 4); b0[u] = *(const f32x4*)(src + 128); b1[u] = *(const f32x4*)(src + 132); } }
#pragma unroll
        for (int u = 0; u < RU; ++u) { const int row = row0 + u * F.NGW;
            if (row < M) {
                float d[8];
                d[0] = a0[u].x - lam * b0[u].x; d[1] = a0[u].y - lam * b0[u].y; d[2] = a0[u].z - lam * b0[u].z; d[3] = a0[u].w - lam * b0[u].w;
                d[4] = a1[u].x - lam * b1[u].x; d[5] = a1[u].y - lam * b1[u].y; d[6] = a1[u].z - lam * b1[u].z; d[7] = a1[u].w - lam * b1[u].w;
                float ss = sumsq8(d); ss += __shfl_xor(ss, 1); ss += __shfl_xor(ss, 2); ss += __shfl_xor(ss, 4); ss += __shfl_xor(ss, 8);
                const float rstd = rsqrtf(ss * (1.f / 128) + EPS) * og;
#pragma unroll
                for (int e = 0; e < 8; ++e) d[e] *= rstd * g[e];
                *(u32x4*)(OA + (size_t)row * 2048 + 128 * h + 8 * i) = pack8(d); } }
    }
}

template <int N> __device__ __forceinline__ float absmax_part(const float* g, int lane) {
    float v[(N + 63) / 64];
#pragma unroll
    for (int k = 0; k < (N + 63) / 64; ++k) { const int i = lane + 64 * k; v[k] = g[i < N ? i : N - 1]; }
    float m = 0.f;
#pragma unroll
    for (int k = 0; k < (N + 63) / 64; ++k) m = fmaxf(m, fabsf(v[k]));
    return m;
}
__device__ __forceinline__ float wave_max(float m) {
#pragma unroll
    for (int o = 1; o < 64; o <<= 1) m = fmaxf(m, __shfl_xor(m, o));
    return __uint_as_float(__builtin_amdgcn_readfirstlane(__float_as_uint(m)));
}
__device__ __forceinline__ void phase_attn(const Frame& F, ArgsP A, int l) {
    unsigned char* ws = F.ws; LAS char* lds = (LAS char*)F.lds;
    const bf16* QA = (const bf16*)(ws + WS_QA); const bf16* KA = (const bf16*)(ws + WS_KA); const bf16* VA = (const bf16*)(ws + WS_VA);
    const bf16* QB = (const bf16*)(ws + WS_QB); const bf16* KB = (const bf16*)(ws + WS_R3); const bf16* KVR = (const bf16*)(ws + WS_R1);
    const bf16* QC = (const bf16*)(ws + WS_QC); const bf16* KC = (const bf16*)(ws + WS_KC); const bf16* VC = (const bf16*)(ws + WS_VC);
    float* OAR = (float*)(ws + WS_R2); bf16* OB = (bf16*)(ws + WS_OALL) + 512; bf16* OC = (bf16*)(ws + WS_OALL) + 1536;
    const float p_aq = absmax_part<64>(A->in[I_AQN] + l * 64, F.lane), p_ak = absmax_part<64>(A->in[I_AKN] + l * 64, F.lane);
    const float p_bq = absmax_part<192>(A->in[I_BQN] + l * 192, F.lane), p_bk = absmax_part<192>(A->in[I_BKN] + l * 192, F.lane);
    const float p_cq = absmax_part<128>(A->in[I_CQN] + l * 128, F.lane), p_ck = absmax_part<128>(A->in[I_CKN] + l * 128, F.lane);
    const float p_cb = absmax_part<4 * 257>(A->in[I_CBIAS] + (size_t)l * 4 * 257, F.lane);
    const float negB_A = -1.4426950408889634f * 1.02f * 8.f * wave_max(p_aq) * wave_max(p_ak);
    const float negB_B = -1.4426950408889634f * 1.02f * 13.856406460551018f * wave_max(p_bq) * wave_max(p_bk);
    const float negB_C = -1.4426950408889634f * (1.02f * 11.313708498984761f * wave_max(p_cq) * wave_max(p_ck) + wave_max(p_cb));
#ifndef ATTM
#define ATTM 7
#endif
    if (ATTM & 1) for (int n = F.vcu; n < 1024 + 128; n += F.G) {
        att::UnitP P; P.ldq = 512; P.ldk = 512; P.ldv = 512; P.ldo = 1024; P.qpos0 = 0; P.kpos0 = 0; P.tab = nullptr; P.lo_base = 0; P.lo_step = 0;
        if (n < 1024) { const int v = n & 255, slot = n >> 8, x = v >> 5, j = v & 31, combo = 2 * x + (slot >> 1), b = combo >> 3, vh = combo & 7, i = (slot & 1) ? j : 63 - j;
            const size_t qrow = (size_t)b * SEQ + 256 * i, krow = (size_t)b * SEQ;
            P.Q = QA + qrow * 512 + 64 * vh; P.nq = 256; P.K = KA + krow * 512 + 64 * vh; P.V = VA + krow * 512 + 128 * (vh >> 1); P.O = OAR + qrow * 1024 + 128 * vh;
            P.NT = 4 * i + 4; P.kvalid = P.NT * 64; P.hi_base = 4 * i; P.hi_step = 1; P.fix_lo = 0; P.fix_hi = P.NT - 3;
        } else { const int s = n - 1024, b = s >> 3, vh = s & 7; const size_t qrow = (size_t)MP + 16 * b, krow = (size_t)MP + (size_t)b * SROWS;
            P.Q = QA + qrow * 512 + 64 * vh; P.nq = 16; P.K = KA + krow * 512 + 64 * vh; P.V = VA + krow * 512 + 128 * (vh >> 1); P.O = OAR + qrow * 1024 + 128 * vh;
            P.NT = SROWS / 64; P.kvalid = PAST + DECS; P.hi_base = SROWS / 64; P.hi_step = 0; P.fix_lo = 0; P.fix_hi = (PAST + DECS) / 64; }
        P.negB = negB_A; att::attn_unit<64, true, false, false>(P, lds);
    }
    if (ATTM & 2) for (int n = F.vcu; n < 1024 + 256; n += F.G) {
        att::UnitP P; P.ldq = 1536; P.ldk = 1536; P.ldv = 2048; P.ldo = 2048; P.qpos0 = 0; P.kpos0 = 0; P.tab = nullptr; P.lo_base = 0; P.lo_step = 0;
        if (n < 1024) { const int v = n & 255, slot = n >> 8, x = v >> 5, j = v & 31, combo = 2 * x + (slot >> 1), b = combo >> 3, hh = combo & 7, i = (slot & 1) ? j : 63 - j;
            const size_t qrow = (size_t)b * SEQ + 256 * i, krow = (size_t)b * SEQ;
            P.Q = QB + qrow * 1536 + 192 * hh; P.nq = 256; P.K = KB + krow * 1536 + 192 * hh; P.V = KVR + krow * 2048 + 256 * hh + 128; P.O = OB + qrow * 2048 + 128 * hh;
            P.NT = 4 * i + 4; P.kvalid = P.NT * 64; P.hi_base = 4 * i; P.hi_step = 1; P.fix_lo = 0; P.fix_hi = P.NT - 3;
        } else { const int s = n - 1024 - 128; if (s < 0) continue; const int b = s >> 3, hh = s & 7; const size_t qrow = (size_t)MP + 16 * b, krow = (size_t)MP + (size_t)b * SROWS;
            P.Q = QB + qrow * 1536 + 192 * hh; P.nq = 16; P.K = KB + krow * 1536 + 192 * hh; P.V = KVR + krow * 2048 + 256 * hh + 128; P.O = OB + qrow * 2048 + 128 * hh;
            P.NT = SROWS / 64; P.kvalid = PAST + DECS; P.hi_base = SROWS / 64; P.hi_step = 0; P.fix_lo = 0; P.fix_hi = (PAST + DECS) / 64; }
        P.negB = negB_B; att::attn_unit<192, false, false, false>(P, lds);
    }
    if (ATTM & 4) for (int n = F.vcu; n < 512 + 64; n += F.G) {
        att::UnitP P; P.ldq = 512; P.ldk = 512; P.ldv = 512; P.ldo = 2048;
        if (n < 512) { const int v = n & 255, slot = n >> 8, x = v >> 5, j = v & 31, b = x >> 2, hh = x & 3, i = j + 32 * slot, c0 = 4 * i, T0 = c0 >= 8 ? c0 - 8 : 0;
            const size_t qrow = (size_t)b * SEQ + 256 * i, krow = (size_t)b * SEQ + 64 * T0;
            P.Q = QC + qrow * 512 + 128 * hh; P.nq = 256; P.K = KC + krow * 512 + 128 * hh; P.V = VC + krow * 512 + 128 * hh; P.O = OC + qrow * 2048 + 128 * hh;
            P.NT = c0 + 4 - T0; P.kvalid = P.NT * 64; P.hi_base = c0 - T0; P.hi_step = 1; P.lo_base = c0 - 8 - T0; P.lo_step = 1; P.qpos0 = 256 * i; P.kpos0 = 64 * T0; P.fix_lo = 3; P.fix_hi = P.NT - 3;
            P.tab = A->in[I_CBIAS] + ((size_t)l * 4 + hh) * 257;
        } else { const int s = n - 512, b = s >> 2, hh = s & 3; const size_t qrow = (size_t)MP + 16 * b, krow = (size_t)MP + (size_t)b * CROWS;
            P.Q = QC + qrow * 512 + 128 * hh; P.nq = 16; P.K = KC + krow * 512 + 128 * hh; P.V = VC + krow * 512 + 128 * hh; P.O = OC + qrow * 2048 + 128 * hh;
            P.NT = CROWS / 64; P.kvalid = CPAST + DECS; P.hi_base = CROWS / 64; P.hi_step = 0; P.lo_base = 0; P.lo_step = 0; P.qpos0 = PAST; P.kpos0 = PAST - CPAST; P.fix_lo = 0; P.fix_hi = (CPAST + DECS) / 64;
            P.tab = A->in[I_CBIAS] + ((size_t)l * 4 + hh) * 257; }
        P.negB = negB_C; att::attn_unit<128, false, true, false>(P, lds);
    }
}

constexpr int NPH = 12, NPHASES = NPH * DEPTH + 1;

template <int l>
__device__ __forceinline__ void layer_body(Frame& F, LAS unsigned char* lds0, volatile LAS unsigned* MISC, const int lo, const int hi) {
#ifndef PHM
#define PHM 0xfff
#endif
#define IN(k) (((PHM >> ((k) % NPH)) & 1) && lo <= (k) && (k) < hi)
#define SEAM(k) do { if (IN(k) && IN((k) + 1)) { XcdBarrier b2; b2.bar = (unsigned*)(fresh_args()->ws + WS_CTL) + CW_BAR; b2.x = xb_xcc_id(); b2.st = MISC + 8; xcd_barrier(b2); } } while (0)
    bf16 *H, *Zb, *GT, *U; float* X;
#define FRESH() do { Ap = fresh_args(); F.tid = fresh_tid(); F.lane = F.tid & 63; F.wave = __builtin_amdgcn_readfirstlane(F.tid >> 6); \
    { int bx_ = blockIdx.x, G_ = gridDim.x; asm volatile("" : "+s"(bx_), "+s"(G_)); F.bx = bx_; F.G = G_; F.vcu = (G_ % 8 == 0) ? (bx_ % 8) * (G_ / 8) + bx_ / 8 : bx_; F.gw = F.vcu * 8 + F.wave; F.NGW = G_ * 8; } \
    { unsigned lb_ = 0; asm volatile("" : "+s"(lb_)); F.lds = lds0 + lb_; } \
    F.ws = Ap->ws; F.out = Ap->out; ws = F.ws; H = (bf16*)(ws + WS_R3); Zb = (bf16*)(ws + WS_R1); GT = (bf16*)(ws + WS_GATES); U = (bf16*)(ws + WS_R1); X = F.out + OUT_Y; } while (0)
    ArgsP Ap; unsigned char* ws;
    constexpr size_t WSET = (l & 1) ? WS_WSET1 : 0, WSET_NEXT = (l & 1) ? 0 : WS_WSET1;
        const int pb = NPH * l;
        if (IN(pb + 0)) { FRESH(); phase_pre(F, Ap, l); } SEAM(pb + 0);
        if (IN(pb + 1)) {
            FRESH(); ArgsP A = Ap;
            pg8::Gemm g{H, (const bf16*)(ws + WSET + WS_WIN), M, NIN, DM, DM, DM}; pg8::StaticOrder S; S.init(M, NIN, DM, F.G, F.bx, 4);
            pg8::EpiIn E{Zb, GT, A->in[I_BGATE] + (size_t)l * NGATE, F.lds + EPI_OFF};
            pg8::gemm_phase(F.lds, g, S, E);
            if (l + 1 < DEPTH) { const int nlast = ((M / 256) * (NIN / 256)) % F.G;
                if (nlast != 0 && F.bx >= nlast) pre_weights(F, Ap, l + 1, ws + WSET_NEXT, (F.bx - nlast) * 8 + F.wave, (F.G - nlast) * 8, 0, WCUT1); }
        } SEAM(pb + 1);
        if (IN(pb + 2)) { FRESH(); phase_post_in(F, Ap, l); } SEAM(pb + 2);
        if (IN(pb + 3)) {
            FRESH();
#pragma unroll 1
            for (int gi = 0; gi < 2; ++gi) {
                const bf16* Ain = (const bf16*)(ws + (gi == 0 ? WS_CQ : WS_CKV)); const bf16* Bt = (const bf16*)(ws + WSET + (gi == 0 ? WS_WQB : WS_WKVB));
                const int Mg = gi == 0 ? M : M2, Ng = gi == 0 ? 1536 : 2048, Kg = gi == 0 ? 512 : 256;
                pg8::Gemm g{Ain, Bt, Mg, Ng, Kg, Kg, Kg}; pg8::StaticOrder S; S.init(Mg, Ng, Kg, F.G, gi == 0 ? F.bx : (F.bx + F.G / 2) % F.G);
                pg8::EpiPlain E{(bf16*)(ws + (gi == 0 ? WS_R2 : WS_R1)), Ng, F.lds + EPI_OFF}; pg8::gemm_phase(F.lds, g, S, E);
            }
        } SEAM(pb + 3);
        if (IN(pb + 4)) { FRESH(); phase_post_b(F, Ap, l); } SEAM(pb + 4);
        if (IN(pb + 5)) { FRESH(); phase_attn(F, Ap, l); } SEAM(pb + 5);
        if (IN(pb + 6)) { FRESH(); phase_post_a(F, Ap, l); } SEAM(pb + 6);
        if (IN(pb + 7)) {
            FRESH();
            pg8::Gemm g{(const bf16*)(ws + WS_OALL), (const bf16*)(ws + WSET + WS_WBR), M, DM, DM, DM, DM}; pg8::StaticOrder S; S.init(M, DM, DM, F.G, F.bx, 4);
            pg8::EpiMerge E{GT, H, F.lds + EPI_OFF}; pg8::gemm_phase(F.lds, g, S, E);
            if (l + 1 < DEPTH) { const int nlast = ((M / 256) * (DM / 256)) % F.G;
                if (nlast != 0 && F.bx >= nlast) pre_caches(F, Ap, l + 1, (F.bx - nlast) * 8 + F.wave, (F.G - nlast) * 8); else if (nlast == 0) pre_caches(F, Ap, l + 1, F.gw, F.NGW); }
        } SEAM(pb + 7);
        if (IN(pb + 8)) {
            FRESH();
            { pg8::Gemm g{H, (const bf16*)(ws + WSET + WS_WO), M, DM, DM, DM, DM}; pg8::CombinedOrder S; S.init(MP, DM, DM, NS_O, F.G, F.bx);
              pg8::EpiResidSplit E{X, (float*)(ws + WS_SLAB_O), MP / 256, DM / NS_O, F.lds + EPI_OFF}; pg8::gemm_phase(F.lds, g, S, E); }
        } SEAM(pb + 8);
        if (IN(pb + 9)) { FRESH(); rmsnorm_rows(F, Ap, Ap->in[I_MNORM] + (size_t)l * DM, H, false, (const float*)(ws + WS_SLAB_O), NS_O); } SEAM(pb + 9);
        if (IN(pb + 10)) {
            FRESH();
            pg8::Gemm g{H, (const bf16*)(ws + WSET + WS_WUP), M, DFF, DM, DM, DM}; pg8::StaticOrder S; S.init(M, DFF, DM, F.G, F.bx, 4);
            pg8::EpiUp E{U, F.lds + EPI_OFF}; pg8::gemm_phase(F.lds, g, S, E);
            if (l + 1 < DEPTH) { const int nlast = ((M / 256) * (DFF / 256)) % F.G;
                if (nlast != 0 && F.bx >= nlast) pre_weights(F, Ap, l + 1, ws + WSET_NEXT, (F.bx - nlast) * 8 + F.wave, (F.G - nlast) * 8, WCUT1, WCUT2); }
        } SEAM(pb + 10);
        if (IN(pb + 11)) {
            FRESH();
            { pg8::Gemm g{U, (const bf16*)(ws + WSET + WS_WDN), M, DM, DFF, DFF, DFF}; pg8::CombinedOrder S; S.init(MP, DM, DFF, NS_DN, F.G, F.bx);
              pg8::EpiResidSplit E{X, (float*)(ws + WS_SLAB_DN), MP / 256, DFF / NS_DN, F.lds + EPI_OFF}; pg8::gemm_phase(F.lds, g, S, E); }
            if (l + 1 < DEPTH) { const int n1 = ((M / 256) * (NIN / 256)) % F.G, n2 = ((M / 256) * (DFF / 256)) % F.G;
                pre_weights(F, Ap, l + 1, ws + WSET_NEXT, F.gw, F.NGW, n1 != 0 ? (n2 != 0 ? WCUT2 : WCUT1) : 0, 1 << 30); }
        } SEAM(pb + 11);
    #undef IN
#undef SEAM
#undef FRESH
}

__global__ void __launch_bounds__(512, 2) fwd(Args args) {
    extern __shared__ __attribute__((aligned(16))) unsigned char lds_raw[];
    Frame F;
    F.lds = (LAS unsigned char*)lds_raw;
    F.tid = threadIdx.x; F.lane = F.tid & 63; F.wave = __builtin_amdgcn_readfirstlane(F.tid >> 6);
    F.G = gridDim.x; { const int bx = blockIdx.x; F.vcu = (F.G % 8 == 0) ? (bx % 8) * (F.G / 8) + bx / 8 : bx; }
    F.gw = F.vcu * 8 + F.wave; F.NGW = F.G * 8;
    F.out = args.out; F.ws = args.ws;
    unsigned char* ws = args.ws;
    volatile LAS unsigned* MISC = (volatile LAS unsigned*)(F.lds + MISC_OFF);
    for (int u = F.tid; u < (LDS_BYTES - LDSCTL_OFF) / 4; u += 512) ((LAS unsigned*)(F.lds + LDSCTL_OFF))[u] = 0u;
    __syncthreads();
    XcdBarrier bar; bar.bar = (unsigned*)(ws + WS_CTL) + CW_BAR; bar.x = 0; bar.st = nullptr;
    if (args.use_bar) bar = xcd_barrier_post((unsigned*)(ws + WS_CTL) + CW_BAR, MISC + 8);
    const int lo = args.ph_lo, hi = args.ph_hi;
    layer_body<0>(F, (LAS unsigned char*)lds_raw, MISC, lo, hi);
    layer_body<1>(F, (LAS unsigned char*)lds_raw, MISC, lo, hi);
    layer_body<2>(F, (LAS unsigned char*)lds_raw, MISC, lo, hi);
    layer_body<3>(F, (LAS unsigned char*)lds_raw, MISC, lo, hi);
    if (lo <= NPH * DEPTH && NPH * DEPTH < hi) {
        ArgsP Ap = fresh_args(); F.tid = fresh_tid(); F.lane = F.tid & 63; F.ws = Ap->ws; F.out = Ap->out;
        final_combine(F, (const float*)(F.ws + WS_SLAB_DN), NS_DN);
    }
}

extern "C" void kernel_launch(void* const* d_in, const int* in_sizes, int n_in, void* d_out, int out_size, void* d_ws, size_t ws_size, hipStream_t stream) {
    static int grid = 0;
    if (grid == 0) {
        if (n_in != 31 || (size_t)out_size != OUT_END || ws_size < WS_END) { fprintf(stderr, "kernel_launch: shape mismatch (n_in %d, out %d, ws %zu)\n", n_in, out_size, ws_size); grid = -1; return; }
        int dev = 0, cus = 0;
        if (hipGetDevice(&dev) != hipSuccess || hipDeviceGetAttribute(&cus, hipDeviceAttributeMultiprocessorCount, dev) != hipSuccess) { grid = -1; return; }
        if (hipFuncSetAttribute((const void*)fwd, hipFuncAttributeMaxDynamicSharedMemorySize, LDS_BYTES) != hipSuccess) { fprintf(stderr, "kernel_launch: hipFuncSetAttribute failed\n"); grid = -1; return; }
        int per_cu = 0;
        if (hipOccupancyMaxActiveBlocksPerMultiprocessor(&per_cu, (const void*)fwd, 512, LDS_BYTES) != hipSuccess || per_cu < 1) fprintf(stderr, "kernel_launch: occupancy query reports %d\n", per_cu);
        (void)hipGetLastError();
        grid = cus;
    }
    if (grid < 0) return;
    (void)hipMemsetAsync((char*)d_ws + WS_CTL, 0, CTL_ZERO_BYTES, stream);
    Args a{};
    for (int i = 0; i < 31; ++i) a.in[i] = (const float*)d_in[i];
    a.out = (float*)d_out; a.ws = (unsigned char*)d_ws; a.pad = 0;
#if MK_SPLIT
    for (int p = 0; p < NPHASES; ++p) { a.ph_lo = p; a.ph_hi = p + 1; a.use_bar = 0; hipLaunchKernelGGL(fwd, dim3(grid), dim3(512), LDS_BYTES, stream, a); }
#else
    a.ph_lo = 0; a.ph_hi = NPHASES; a.use_bar = 1; hipLaunchKernelGGL(fwd, dim3(grid), dim3(512), LDS_BYTES, stream, a);
#endif
}
```
